# Optimizing an MI355X kernel written in HIP

```python
import math
import jax, jax.numpy as jnp
from jax import lax
import numpy as np

D_MODEL = 1024
BATCH = 8
SEQ = 4096
DEPTH = 4

MEM_LEN = 256
CONV_WIDTH = D_MODEL // 2
CONV_KERNEL = 31
SSM_WIDTH = D_MODEL // 2
SSM_GROUP = 16
SSM_GROUPS = SSM_WIDTH // SSM_GROUP
SSM_STATE = 64
XATTN_HEADS = 4
XATTN_HEAD_DIM = D_MODEL // XATTN_HEADS
D_FF = 2816
N_EXPERTS = 8
TOP_K = 2
D_FF_EXPERT = 3584
N_MOE = DEPTH // 2
N_DENSE = DEPTH - N_MOE
IN_COLS = 2 * CONV_WIDTH + SSM_WIDTH + 2 * D_MODEL
RMS_EPS = 1e-6
LN_EPS = 1e-5
DT_MIN = 1e-3
DT_MAX = 1e-1

kernel_name = "hybrid_conv_s5_xattn_moe_trunk"


def rmsnorm(x, g):
    xf = x.astype(jnp.float32)
    y = xf * lax.rsqrt(jnp.mean(xf * xf, axis=-1, keepdims=True) + RMS_EPS)
    return (y * g.astype(jnp.float32)).astype(x.dtype)


def layernorm(x, g, b):
    xf = x.astype(jnp.float32)
    mu = jnp.mean(xf, axis=-1, keepdims=True)
    xc = xf - mu
    y = xc * lax.rsqrt(jnp.mean(xc * xc, axis=-1, keepdims=True) + LN_EPS)
    return (y * g.astype(jnp.float32) + b.astype(jnp.float32)).astype(x.dtype)


def causal_depthwise_conv(u, w, b):
    c = u.shape[-1]
    y = lax.conv_general_dilated(
        u, w[:, None, :].astype(u.dtype), window_strides=(1,),
        padding=[(CONV_KERNEL - 1, 0)],
        dimension_numbers=("NWC", "WIO", "NWC"),
        feature_group_count=c)
    return y + b.astype(u.dtype)


def conv_branch(u_glu, conv_w, conv_b, ln_g, ln_b, w_pw):
    a, gate = jnp.split(u_glu, 2, axis=-1)
    u = a * jax.nn.sigmoid(gate)
    u = causal_depthwise_conv(u, conv_w, conv_b)
    u = jax.nn.silu(layernorm(u, ln_g, ln_b))
    return u @ w_pw


def ssm_branch(u, lam_re, lam_im, log_dt, b_re, b_im, c_re, c_im, d_skip, w_glu):
    dtype = u.dtype
    bsz, s, _ = u.shape
    uf = u.astype(jnp.float32).reshape(bsz, s, SSM_GROUPS, SSM_GROUP)
    lr = lam_re.astype(jnp.float32)
    li = lam_im.astype(jnp.float32)
    dt = jnp.exp(log_dt.astype(jnp.float32))[:, None]
    mag = jnp.exp(lr * dt)
    ar = mag * jnp.cos(li * dt)
    ai = mag * jnp.sin(li * dt)
    den = lr * lr + li * li
    xr = ar - 1.0
    kr = (xr * lr + ai * li) / den
    ki = (ai * lr - xr * li) / den
    br = b_re.astype(jnp.float32)
    bi = b_im.astype(jnp.float32)
    bbar_r = kr[..., None] * br - ki[..., None] * bi
    bbar_i = kr[..., None] * bi + ki[..., None] * br
    bu_r = jnp.einsum("bsgh,gph->bsgp", uf, bbar_r)
    bu_i = jnp.einsum("bsgh,gph->bsgp", uf, bbar_i)
    a_r = jnp.broadcast_to(ar[None, None], (1, s, SSM_GROUPS, SSM_STATE))
    a_i = jnp.broadcast_to(ai[None, None], (1, s, SSM_GROUPS, SSM_STATE))

    def combine(e1, e2):
        a1r, a1i, b1r, b1i = e1
        a2r, a2i, b2r, b2i = e2
        return (a2r * a1r - a2i * a1i,
                a2r * a1i + a2i * a1r,
                a2r * b1r - a2i * b1i + b2r,
                a2r * b1i + a2i * b1r + b2i)

    _, _, h_r, h_i = lax.associative_scan(combine, (a_r, a_i, bu_r, bu_i), axis=1)
    y = (jnp.einsum("bsgp,ghp->bsgh", h_r, c_re.astype(jnp.float32))
         - jnp.einsum("bsgp,ghp->bsgh", h_i, c_im.astype(jnp.float32))
         + d_skip.astype(jnp.float32) * uf)
    y = jax.nn.gelu(y).reshape(bsz, s, SSM_WIDTH).astype(dtype)
    za, zg = jnp.split(y @ w_glu, 2, axis=-1)
    return za * jax.nn.sigmoid(zg)


def cross_attention(hn, mem_n, w_q, w_kv, w_o):
    bsz, s, _ = hn.shape
    m = mem_n.shape[1]
    q = (hn @ w_q).reshape(bsz, s, XATTN_HEADS, XATTN_HEAD_DIM)
    k, v = jnp.split(mem_n @ w_kv, 2, axis=-1)
    k = k.reshape(bsz, m, XATTN_HEADS, XATTN_HEAD_DIM)
    v = v.reshape(bsz, m, XATTN_HEADS, XATTN_HEAD_DIM)
    scores = jnp.einsum("bshd,bmhd->bhsm", q, k).astype(jnp.float32) / math.sqrt(XATTN_HEAD_DIM)
    p = jax.nn.softmax(scores, axis=-1).astype(v.dtype)
    o = jnp.einsum("bhsm,bmhd->bshd", p, v).reshape(bsz, s, D_MODEL)
    return o @ w_o


def swiglu(x, w_gate_up, w_down):
    g, u = jnp.split(x @ w_gate_up, 2, axis=-1)
    return (jax.nn.silu(g) * u) @ w_down


def moe_swiglu(x, router_w, router_b, w_gate_up, w_down):
    bsz, s, d = x.shape
    t = x.reshape(bsz * s, d)
    logits = (t @ router_w).astype(jnp.float32) + router_b.astype(jnp.float32)
    top_vals, top_idx = lax.top_k(logits, TOP_K)
    top_w = jax.nn.softmax(top_vals, axis=-1)
    gates = jnp.sum(jax.nn.one_hot(top_idx, N_EXPERTS, dtype=jnp.float32) * top_w[..., None], axis=1)
    out = jnp.zeros((bsz * s, d), jnp.float32)
    for e in range(N_EXPERTS):
        out = out + gates[:, e:e + 1] * swiglu(t, w_gate_up[e], w_down[e]).astype(jnp.float32)
    return out.astype(x.dtype).reshape(bsz, s, d)


def setup_inputs(seed: int = 0) -> dict:
    key = jax.random.key(seed)
    ks = iter(jax.random.split(key, 40))
    f32 = jnp.float32
    L = DEPTH

    def nrm(shape, scale):
        return jax.random.normal(next(ks), shape, f32) * scale

    def gain(shape):
        return 1.0 + 0.02 * jax.random.normal(next(ks), shape, f32)

    lam_im0 = jnp.pi * jnp.arange(SSM_STATE, dtype=f32)
    return {
        "x": nrm((BATCH, SEQ, D_MODEL), 1.0),
        "mem": nrm((BATCH, MEM_LEN, D_MODEL), 1.0),
        "mem_norm_g": gain((D_MODEL,)),
        "norm_mix_g": gain((L, D_MODEL)),
        "w_in": nrm((L, D_MODEL, IN_COLS), D_MODEL ** -0.5),
        "conv_w": nrm((L, CONV_KERNEL, CONV_WIDTH), CONV_KERNEL ** -0.5),
        "conv_b": nrm((L, CONV_WIDTH), 0.02),
        "conv_ln_g": gain((L, CONV_WIDTH)),
        "conv_ln_b": nrm((L, CONV_WIDTH), 0.02),
        "w_conv_pw": nrm((L, CONV_WIDTH, D_MODEL), CONV_WIDTH ** -0.5),
        "ssm_lambda_re": -0.5 + nrm((L, SSM_GROUPS, SSM_STATE), 0.01),
        "ssm_lambda_im": lam_im0 + nrm((L, SSM_GROUPS, SSM_STATE), 0.01),
        "ssm_log_dt": jax.random.uniform(next(ks), (L, SSM_GROUPS), f32,
                                         math.log(DT_MIN), math.log(DT_MAX)),
        "ssm_b_re": nrm((L, SSM_GROUPS, SSM_STATE, SSM_GROUP), (2 * SSM_GROUP) ** -0.5),
        "ssm_b_im": nrm((L, SSM_GROUPS, SSM_STATE, SSM_GROUP), (2 * SSM_GROUP) ** -0.5),
        "ssm_c_re": nrm((L, SSM_GROUPS, SSM_GROUP, SSM_STATE), SSM_STATE ** -0.5),
        "ssm_c_im": nrm((L, SSM_GROUPS, SSM_GROUP, SSM_STATE), SSM_STATE ** -0.5),
        "ssm_d": nrm((L, SSM_GROUPS, SSM_GROUP), 1.0),
        "w_ssm_glu": nrm((L, SSM_WIDTH, 2 * D_MODEL), SSM_WIDTH ** -0.5),
        "w_out": nrm((L, D_MODEL, D_MODEL), D_MODEL ** -0.5),
        "norm_xattn_g": gain((L, D_MODEL)),
        "w_q": nrm((L, D_MODEL, D_MODEL), D_MODEL ** -0.5),
        "w_kv": nrm((L, D_MODEL, 2 * D_MODEL), D_MODEL ** -0.5),
        "w_o": nrm((L, D_MODEL, D_MODEL), D_MODEL ** -0.5),
        "norm_ffn_g": gain((L, D_MODEL)),
        "ffn_w_gate_up": nrm((N_DENSE, D_MODEL, 2 * D_FF), D_MODEL ** -0.5),
        "ffn_w_down": nrm((N_DENSE, D_FF, D_MODEL), D_FF ** -0.5),
        "router_w": nrm((N_MOE, D_MODEL, N_EXPERTS), D_MODEL ** -0.5),
        "router_b": nrm((N_MOE, N_EXPERTS), 0.01),
        "moe_w_gate_up": nrm((N_MOE, N_EXPERTS, D_MODEL, 2 * D_FF_EXPERT), D_MODEL ** -0.5),
        "moe_w_down": nrm((N_MOE, N_EXPERTS, D_FF_EXPERT, D_MODEL), D_FF_EXPERT ** -0.5),
        "final_norm_g": gain((D_MODEL,)),
    }


def reference(x, mem, mem_norm_g, norm_mix_g, w_in, conv_w, conv_b, conv_ln_g, conv_ln_b,
              w_conv_pw, ssm_lambda_re, ssm_lambda_im, ssm_log_dt, ssm_b_re, ssm_b_im,
              ssm_c_re, ssm_c_im, ssm_d, w_ssm_glu, w_out, norm_xattn_g, w_q, w_kv, w_o,
              norm_ffn_g, ffn_w_gate_up, ffn_w_down, router_w, router_b, moe_w_gate_up,
              moe_w_down, final_norm_g):
    mem_n = rmsnorm(mem, mem_norm_g)
    c0 = 2 * CONV_WIDTH
    c1 = c0 + SSM_WIDTH
    h = x
    for i in range(DEPTH):
        hn = rmsnorm(h, norm_mix_g[i])
        proj = hn @ w_in[i]
        u_conv = proj[..., :c0]
        u_ssm = proj[..., c0:c1]
        g_a, g_b = jnp.split(jax.nn.sigmoid(proj[..., c1:]), 2, axis=-1)
        y_a = conv_branch(u_conv, conv_w[i], conv_b[i], conv_ln_g[i], conv_ln_b[i], w_conv_pw[i])
        y_b = ssm_branch(u_ssm, ssm_lambda_re[i], ssm_lambda_im[i], ssm_log_dt[i],
                         ssm_b_re[i], ssm_b_im[i], ssm_c_re[i], ssm_c_im[i], ssm_d[i],
                         w_ssm_glu[i])
        h = h + (g_a * y_a + g_b * y_b) @ w_out[i]
        h = h + cross_attention(rmsnorm(h, norm_xattn_g[i]), mem_n, w_q[i], w_kv[i], w_o[i])
        hn = rmsnorm(h, norm_ffn_g[i])
        j = i // 2
        if i % 2 == 0:
            h = h + swiglu(hn, ffn_w_gate_up[j], ffn_w_down[j])
        else:
            h = h + moe_swiglu(hn, router_w[j], router_b[j], moe_w_gate_up[j], moe_w_down[j])
    return rmsnorm(h, final_norm_g)
```

```cpp
#include <hip/hip_runtime.h>
#include <cstdio>
#include <cstdint>

#ifndef MK_ONE_LAUNCH
#define MK_ONE_LAUNCH 1
#endif

#define GAS __attribute__((address_space(1)))
#define LAS __attribute__((address_space(3)))
typedef unsigned short bf16_t;
typedef short bf16x8 __attribute__((ext_vector_type(8)));
typedef float f32x4 __attribute__((ext_vector_type(4)));
typedef float f32x2 __attribute__((ext_vector_type(2)));
typedef float f32x16 __attribute__((ext_vector_type(16)));
typedef unsigned u32x4 __attribute__((ext_vector_type(4)));
typedef unsigned u32x2 __attribute__((ext_vector_type(2)));
typedef __bf16 bf2_t __attribute__((ext_vector_type(2)));

constexpr int D = 1024, BATCH = 8, SEQ = 4096, T = BATCH * SEQ, DEPTH = 4, MEM = 256, NMEM = BATCH * MEM;
constexpr int CW = 512, CK = 31, SW = 512, SG = 16, NG = 32, SP = 64, HEADS = 4, HD = 256;
constexpr int DFF = 2816, NE = 8, DFE = 3584, INC = 3584;
constexpr int NSLOT = 2 * T + NE * 256;
constexpr float RMS_EPS = 1e-6f, LN_EPS = 1e-5f;

constexpr size_t MiB = 1u << 20;
constexpr size_t WS_CTL = 0, CTL_BYTES = 1 * MiB;
constexpr size_t WS_A16 = 1 * MiB;
constexpr size_t WS_META = 2 * MiB;
constexpr size_t WS_STATS = 4 * MiB;
constexpr size_t WS_MEMN = 10 * MiB, WS_KMAT = 14 * MiB, WS_VT = 30 * MiB, WS_H = 46 * MiB;
constexpr size_t WS_WIN = 110 * MiB, WS_WPW = 138 * MiB, WS_WGLU = 142 * MiB, WS_WOUT = 150 * MiB, WS_WQ = 158 * MiB, WS_WKV = 166 * MiB, WS_WO = 182 * MiB;
constexpr size_t WS_WFGU = 190 * MiB, WS_WFD = 212 * MiB, WS_WMGU = 224 * MiB, WS_WMD = 448 * MiB, WS_WST = 560 * MiB, WS_TW = 576 * MiB;
constexpr size_t WS_R = 600 * MiB;
constexpr size_t WS_UCONV = WS_R, WS_XU = WS_R + 32 * MiB, WS_GATES = WS_R + 80 * MiB, WS_UC = WS_R + 208 * MiB, WS_YS = WS_R + 240 * MiB;
constexpr size_t WS_MB = WS_R + 272 * MiB, WS_MERGED = WS_R + 336 * MiB, WS_Q = WS_R + 400 * MiB, WS_AO = WS_R + 464 * MiB;
constexpr size_t WS_H8 = WS_R + 300 * MiB;
constexpr size_t WS_ACT = WS_R, WS_HS = WS_R + 462 * MiB, WS_YE = WS_R + 594 * MiB, WS_END = WS_R + 726 * MiB;
static_assert((size_t)NSLOT * DFE * 2 <= 462 * MiB && (size_t)NSLOT * D * 2 <= 132 * MiB, "moe buffers");
constexpr size_t MT_TOKE = 0, MT_TOKW = 128 * 1024, MT_TOKR = 384 * 1024, MT_TOKSLOT = 512 * 1024, MT_RSCALE = 768 * 1024, MT_GWT = 1088 * 1024, MT_WGCNT = 1408 * 1024, MT_PEXP = 1424 * 1024;
constexpr int CW_PTOTAL = 16, CW_PBASE = 32;
constexpr int CW_BAR = 4096;

constexpr int LDS_AUX = 131072;
constexpr int LDS_MISC = 131072 + 8192;
constexpr int LDS_BYTES = 147456;

#ifndef F8_MOE_MASK
#define F8_MOE_MASK 0xA
#endif
#define F8_MOE(l) (((F8_MOE_MASK >> (l)) & 1) != 0)
#ifndef F8_QO
#define F8_QO 1
#endif
#ifndef F8_GATES
#define F8_GATES 1
#endif
#ifndef F8_DENSE_MASK
#define F8_DENSE_MASK 0x4
#endif
#define F8_DENSE(l) (((F8_DENSE_MASK >> (l)) & 1) != 0)
__device__ __forceinline__ unsigned pk2(float lo, float hi) { f32x2 v = {lo, hi}; bf2_t r = __builtin_convertvector(v, bf2_t); return __builtin_bit_cast(unsigned, r); }
__device__ __forceinline__ float bflo(unsigned u) { return __uint_as_float(u << 16); }
__device__ __forceinline__ float bfhi(unsigned u) { return __uint_as_float(u & 0xffff0000u); }
__device__ __forceinline__ float fast_rcp(float x) { return __builtin_amdgcn_rcpf(x); }
__device__ __forceinline__ float fast_exp2(float x) { return __builtin_amdgcn_exp2f(x); }
__device__ __forceinline__ float sigmoidf_(float x) { return fast_rcp(1.0f + fast_exp2(-1.44269504f * x)); }
__device__ __forceinline__ float siluf_(float x) { return x * sigmoidf_(x); }
__device__ __forceinline__ float gelu_tanh_(float x) { const float z = 0.7978845608f * (x + 0.044715f * x * x * x); return x * fast_rcp(1.0f + fast_exp2(-2.88539008f * z)); }
__device__ __forceinline__ float wave_sum(float v) {
#pragma unroll
    for (int o = 1; o < 64; o <<= 1) v += __shfl_xor(v, o);
    return v;
}
__device__ __forceinline__ float row_rstd(const float* stats, int row) {
    const f32x4 a = *(const f32x4*)(stats + (size_t)row * 4);
    return __builtin_amdgcn_rsqf(((a[0] + a[1]) + (a[2] + a[3])) * (1.0f / D) + RMS_EPS);
}
__device__ __forceinline__ unsigned pk4_fp8(float a, float b, float c, float d) { int w = 0; w = __builtin_amdgcn_cvt_pk_fp8_f32(a, b, w, false); w = __builtin_amdgcn_cvt_pk_fp8_f32(c, d, w, true); return (unsigned)w; }
constexpr float F8_WGU_SCALE = 32.f, F8_WD_SCALE = 64.f, F8_ACT_SCALE = 4.f, F8_WQ_SCALE = 512.f, F8_WO_SCALE = 32.f, F8_AO_SCALE = 8.f;
#define LDS_WAIT() asm volatile("s_waitcnt lgkmcnt(0)" ::: "memory")
#define VM_WAIT() asm volatile("s_waitcnt vmcnt(0)" ::: "memory")

namespace pg8 {
constexpr int BM = 256, BK = 64, HALF = 128, HTB = HALF * BK * 2, STAGE_BYTES = 8 * HTB, NXCD = 8, WGM = 4;
__host__ __device__ __forceinline__ int lds_byte(int r, int c) { const int st = (r >> 4) * 2 + (c >> 5), rr = r & 15, cc = c & 31, ob = rr * 64 + cc * 2; return st * 1024 + (ob ^ (((ob >> 9) & 1) << 5)); }
__host__ __device__ __forceinline__ void stage_rc(int b, int& R, int& C) { const int st = b / 1024, sb = b % 1024, swz = sb ^ (((sb >> 9) & 1) << 5); R = (st >> 1) * 16 + swz / 64; C = (st & 1) * 32 + (swz % 64) / 2; }
__host__ __device__ __forceinline__ int perm32(int rho) { const int n = rho >> 4, i = rho & 15; return 8 * (i >> 2) + 4 * n + (i & 3); }

struct Unit { int pm, pn, tag; const char* A; const char* B; };

struct StaticOrder {
    int nM, nN, nwg, G, c;
    __device__ __forceinline__ void init(int nM_, int nN_, int G_, int c_) { nM = nM_; nN = nN_; nwg = nM * nN; G = G_; c = c_; }
    __device__ __forceinline__ bool next(int i, int& pm, int& pn) const {
        const long L = (long)i * G + c; if (L >= nwg) return false;
        int wgid = (int)L; { const int q = nwg / NXCD, r = nwg % NXCD, xcd = wgid % NXCD, off = wgid / NXCD; wgid = (xcd < r ? xcd * (q + 1) : r * (q + 1) + (xcd - r) * q) + off; }
        const int nig = WGM * nN, gid = wgid / nig, fm = gid * WGM, gsz = (nM - fm) < WGM ? (nM - fm) : WGM;
        pm = fm + ((wgid % nig) % gsz); pn = (wgid % nig) / gsz; return true;
    }
};
struct SchedStd {
    StaticOrder o; const char* A; const char* B; size_t sA, sB;
    __device__ __forceinline__ bool next(int i, Unit& u) const { int pm, pn; if (!o.next(i, pm, pn)) return false; u.pm = pm; u.pn = pn; u.tag = 0; u.A = A + (size_t)pm * sA; u.B = B + (size_t)pn * sB; return true; }
    __device__ __forceinline__ void a_ready(const Unit&) const {}
    __device__ __forceinline__ void done(const Unit&) const {}
};
struct SchedOne {
    Unit u0;
    __device__ __forceinline__ bool next(int i, Unit& u) const { if (i) return false; u = u0; return true; }
    __device__ __forceinline__ void a_ready(const Unit&) const {}
    __device__ __forceinline__ void done(const Unit&) const {}
};

template <class Epi, class Sched, bool ALIGN_EPI, bool SP2, bool F8 = false>
__device__ __forceinline__ void gemm_phase(LAS unsigned char* lds, const int K, const int lda, const int ldb, const Sched& S, const Epi& E, const char* wsb) {
    int tid_ = threadIdx.x; asm volatile("" : "+v"(tid_));
    const int tid = tid_, wid = __builtin_amdgcn_readfirstlane(tid >> 6), lane = tid & 63, wr = wid >> 2, wc = wid & 3, fr = lane & 15, fq = lane >> 4;
    constexpr int ES = F8 ? 1 : 2;
    const int nt = K * ES / (BK * 2);
    unsigned voffA[2], voffB[2];
#pragma unroll
    for (int i = 0; i < 2; ++i) { int R, C; stage_rc(tid * 16 + i * 8192, R, C); const int Rb = Epi::PERM ? ((R & ~31) + perm32(R & 31)) : R;
        voffA[i] = (unsigned)(R * lda * ES + C * 2); voffB[i] = (unsigned)(Rb * ldb * ES + C * 2); }
    const unsigned kstep = (unsigned)(BK * 2);
    const unsigned hstepA = (unsigned)(HALF * lda * ES), hstepB = (unsigned)(HALF * ldb * ES);
    const __amdgpu_buffer_rsrc_t rs = __builtin_amdgcn_make_buffer_rsrc((void*)wsb, (short)0, 0x7fffffff, 0x00020000);
    const unsigned ldsw = (unsigned)wid * 1024u;
    const int aoff = lds_byte(wr * 64 + fr, fq * 8), boff = lds_byte(wc * 32 + fr, fq * 8);
#define PG8_SA(b, h) (((b) * 2 + (h)) * HTB)
#define PG8_SB(b, h) ((4 + (b) * 2 + (h)) * HTB)
#define PG8_STAGE(bufoff, goff, voff) do { _Pragma("unroll") for (int _i = 0; _i < 2; ++_i) \
        __builtin_amdgcn_raw_ptr_buffer_load_lds(rs, (LAS unsigned*)(lds + (bufoff) + ldsw + _i * 8192), 16, (voff)[_i], (int)(goff), 0, 0); } while (0)
#define PG8_LD16(off) (*(const LAS bf16x8*)(lds + (off)))
#define PG8_CAT(x, y) __builtin_shufflevector(__builtin_bit_cast(i32x4_, (x)), __builtin_bit_cast(i32x4_, (y)), 0, 1, 2, 3, 4, 5, 6, 7)
#define PG8_LDA(dst, b, h) do { _Pragma("unroll") for (int m = 0; m < 4; ++m) { if constexpr (F8) dst##8[m] = PG8_CAT(PG8_LD16(PG8_SA(b, h) + aoff + m * 2048), PG8_LD16(PG8_SA(b, h) + aoff + m * 2048 + 1024)); \
        else { _Pragma("unroll") for (int k = 0; k < 2; ++k) dst[m][k] = PG8_LD16(PG8_SA(b, h) + aoff + m * 2048 + k * 1024); } } } while (0)
#define PG8_LDB(dst, b, h) do { _Pragma("unroll") for (int n = 0; n < 2; ++n) { if constexpr (F8) dst##8[n] = PG8_CAT(PG8_LD16(PG8_SB(b, h) + boff + n * 2048), PG8_LD16(PG8_SB(b, h) + boff + n * 2048 + 1024)); \
        else { _Pragma("unroll") for (int k = 0; k < 2; ++k) dst[n][k] = PG8_LD16(PG8_SB(b, h) + boff + n * 2048 + k * 1024); } } } while (0)
#define PG8_MMA(ai, bj, Af, Bf) do { __builtin_amdgcn_s_setprio(1); \
        if constexpr (F8) {   \
            asm volatile("s_nop 1\n\t" \
                "v_mfma_f32_16x16x128_f8f6f4 %0, %8, %10, %0\n\tv_mfma_f32_16x16x128_f8f6f4 %1, %9, %10, %1\n\t" \
                "v_mfma_f32_16x16x128_f8f6f4 %2, %8, %11, %2\n\tv_mfma_f32_16x16x128_f8f6f4 %3, %9, %11, %3\n\t" \
                "v_mfma_f32_16x16x128_f8f6f4 %4, %8, %12, %4\n\tv_mfma_f32_16x16x128_f8f6f4 %5, %9, %12, %5\n\t" \
                "v_mfma_f32_16x16x128_f8f6f4 %6, %8, %13, %6\n\tv_mfma_f32_16x16x128_f8f6f4 %7, %9, %13, %7" \
                : "+v"(acc[ai][bj][0][0]), "+v"(acc[ai][bj][0][1]), "+v"(acc[ai][bj][1][0]), "+v"(acc[ai][bj][1][1]), "+v"(acc[ai][bj][2][0]), "+v"(acc[ai][bj][2][1]), "+v"(acc[ai][bj][3][0]), "+v"(acc[ai][bj][3][1]) \
                : "v"(Bf##8[0]), "v"(Bf##8[1]), "v"(Af##8[0]), "v"(Af##8[1]), "v"(Af##8[2]), "v"(Af##8[3])); } \
        else { _Pragma("unroll") for (int m = 0; m < 4; ++m) _Pragma("unroll") for (int n = 0; n < 2; ++n) _Pragma("unroll") for (int k = 0; k < 2; ++k) acc[ai][bj][m][n] = __builtin_amdgcn_mfma_f32_16x16x32_bf16(Bf[n][k], Af[m][k], acc[ai][bj][m][n], 0, 0, 0); } \
        __builtin_amdgcn_s_setprio(0); } while (0)
#define PG8_WAIT_V(n) asm volatile("s_waitcnt vmcnt(" #n ")" ::: "memory")
#define PG8_WAIT_L(n) asm volatile("s_waitcnt lgkmcnt(" #n ")" ::: "memory")
#define PG8_BAR __builtin_amdgcn_s_barrier()
#define PG8_SCHED __builtin_amdgcn_sched_barrier(0)
    Unit cur, nxt; int ui = 0;
    if (!S.next(0, cur)) return;
    f32x4 acc[2][2][4][2];
#pragma unroll
    for (int a = 0; a < 2; ++a)
#pragma unroll
        for (int b = 0; b < 2; ++b)
#pragma unroll
            for (int m = 0; m < 4; ++m)
#pragma unroll
                for (int n = 0; n < 2; ++n) acc[a][b][m][n] = (f32x4){0.f, 0.f, 0.f, 0.f};
    typedef int i32x4_ __attribute__((ext_vector_type(4))); typedef int i32x8_ __attribute__((ext_vector_type(8)));
    bf16x8 At[4][2], B0[2][2], B1[2][2]; i32x8_ At8[4], B08[2], B18[2];
    unsigned cA = (unsigned)(cur.A - wsb), cB = (unsigned)(cur.B - wsb);
    S.a_ready(cur);
    if constexpr (SP2) {
        PG8_STAGE(PG8_SB(0, 0), cB, voffB); PG8_STAGE(PG8_SB(0, 1), cB + hstepB, voffB); PG8_STAGE(PG8_SA(0, 0), cA, voffA); PG8_STAGE(PG8_SA(0, 1), cA + hstepA, voffA);
        if (wr == 1) PG8_BAR;
        PG8_WAIT_V(2); PG8_BAR;
        PG8_STAGE(PG8_SB(1, 0), cB + kstep, voffB); PG8_STAGE(PG8_SA(1, 0), cA + kstep, voffA); PG8_STAGE(PG8_SB(1, 1), cB + hstepB + kstep, voffB);
        PG8_WAIT_V(6); PG8_BAR;
    } else {
        PG8_STAGE(PG8_SB(0, 0), cB, voffB); PG8_STAGE(PG8_SA(0, 0), cA, voffA); PG8_STAGE(PG8_SB(0, 1), cB + hstepB, voffB); PG8_STAGE(PG8_SA(0, 1), cA + hstepA, voffA);
        if (wr == 1) PG8_BAR;
        PG8_WAIT_V(4); PG8_BAR;
        PG8_STAGE(PG8_SB(1, 0), cB + kstep, voffB); PG8_STAGE(PG8_SA(1, 0), cA + kstep, voffA); PG8_STAGE(PG8_SB(1, 1), cB + hstepB + kstep, voffB);
        PG8_WAIT_V(6); PG8_BAR;
    }
    for (;;) {
        const bool has_next = S.next(ui + 1, nxt);
        const unsigned nA = has_next ? (unsigned)(nxt.A - wsb) : cA, nB = has_next ? (unsigned)(nxt.B - wsb) : cB;
        for (int t = 0; t < nt; t += 2) {
            const bool last = (t == nt - 2);
            const unsigned a1 = cA + (unsigned)(t + 1) * kstep;
            const unsigned a2 = last ? nA : cA + (unsigned)(t + 2) * kstep, b2 = last ? nB : cB + (unsigned)(t + 2) * kstep;
            const unsigned a3 = a2 + kstep, b3 = b2 + kstep;
            if (last && has_next) S.a_ready(nxt);
            if constexpr (SP2) {
            PG8_LDB(B0, 0, 0); PG8_LDB(B1, 0, 1); PG8_SCHED; PG8_LDA(At, 0, 0); PG8_STAGE(PG8_SA(1, 1), a1 + hstepA, voffA);
            PG8_WAIT_V(8); PG8_WAIT_L(0); PG8_BAR; PG8_MMA(0, 0, At, B0); PG8_MMA(0, 1, At, B1); PG8_BAR; PG8_SCHED;
            PG8_LDA(At, 0, 1); PG8_STAGE(PG8_SB(0, 0), b2, voffB); PG8_STAGE(PG8_SB(0, 1), b2 + hstepB, voffB); PG8_STAGE(PG8_SA(0, 0), a2, voffA);
            PG8_WAIT_V(8); PG8_WAIT_L(0); PG8_BAR; PG8_MMA(1, 0, At, B0); PG8_MMA(1, 1, At, B1); PG8_BAR; PG8_SCHED;
            PG8_LDB(B0, 1, 0); PG8_LDB(B1, 1, 1); PG8_SCHED; PG8_LDA(At, 1, 0); PG8_STAGE(PG8_SA(0, 1), a2 + hstepA, voffA);
            PG8_WAIT_V(8); PG8_WAIT_L(0); PG8_BAR; PG8_MMA(0, 0, At, B0); PG8_MMA(0, 1, At, B1); PG8_BAR; PG8_SCHED;
            PG8_LDA(At, 1, 1); PG8_STAGE(PG8_SB(1, 0), b3, voffB); PG8_STAGE(PG8_SB(1, 1), b3 + hstepB, voffB); PG8_STAGE(PG8_SA(1, 0), a3, voffA);
            PG8_WAIT_V(8); PG8_WAIT_L(0); PG8_BAR; PG8_MMA(1, 0, At, B0); PG8_MMA(1, 1, At, B1); PG8_BAR; PG8_SCHED;
            } else {
            PG8_LDB(B0, 0, 0); PG8_SCHED; PG8_LDA(At, 0, 0); PG8_STAGE(PG8_SA(1, 1), a1 + hstepA, voffA);
            PG8_WAIT_L(8); PG8_BAR; PG8_WAIT_L(0); PG8_MMA(0, 0, At, B0); PG8_BAR; PG8_SCHED;
            PG8_LDB(B1, 0, 1); PG8_STAGE(PG8_SB(0, 0), b2, voffB);
            PG8_BAR; PG8_WAIT_L(0); PG8_MMA(0, 1, At, B1); PG8_BAR;
            PG8_LDA(At, 0, 1); PG8_STAGE(PG8_SA(0, 0), a2, voffA);
            PG8_BAR; PG8_WAIT_L(0); PG8_MMA(1, 0, At, B0); PG8_BAR; PG8_SCHED;
            PG8_STAGE(PG8_SB(0, 1), b2 + hstepB, voffB);
            PG8_WAIT_V(6); PG8_BAR; PG8_MMA(1, 1, At, B1); PG8_BAR;
            PG8_LDB(B0, 1, 0); PG8_SCHED; PG8_LDA(At, 1, 0); PG8_STAGE(PG8_SA(0, 1), a2 + hstepA, voffA);
            PG8_WAIT_L(8); PG8_BAR; PG8_WAIT_L(0); PG8_MMA(0, 0, At, B0); PG8_BAR; PG8_SCHED;
            PG8_LDB(B1, 1, 1); PG8_STAGE(PG8_SB(1, 0), b3, voffB);
            PG8_BAR; PG8_WAIT_L(0); PG8_MMA(0, 1, At, B1); PG8_BAR;
            PG8_LDA(At, 1, 1); PG8_STAGE(PG8_SA(1, 0), a3, voffA);
            PG8_BAR; PG8_WAIT_L(0); PG8_MMA(1, 0, At, B0); PG8_BAR; PG8_SCHED;
            PG8_STAGE(PG8_SB(1, 1), b3 + hstepB, voffB);
            PG8_WAIT_V(6); PG8_BAR; PG8_MMA(1, 1, At, B1); PG8_BAR;
            }
        }
        if constexpr (F8) asm volatile("s_nop 15\n\ts_nop 7" ::: "memory");
        if constexpr (ALIGN_EPI) { if (wr == 0) PG8_BAR; }
        if constexpr (!Epi::AFTER_DRAIN) { int fr2 = fr, fq2 = fq; asm volatile("" : "+v"(fr2), "+v"(fq2));
            E(acc, cur, wr, wc, fr2, fq2); S.done(cur); }
        if (!has_next) break;
#pragma unroll
        for (int a = 0; a < 2; ++a)
#pragma unroll
            for (int b = 0; b < 2; ++b)
#pragma unroll
                for (int m = 0; m < 4; ++m)
#pragma unroll
                    for (int n = 0; n < 2; ++n) acc[a][b][m][n] = (f32x4){0.f, 0.f, 0.f, 0.f};
        cur = nxt; cA = nA; cB = nB; ++ui;
        if constexpr (ALIGN_EPI) { if (wr == 1) PG8_BAR; }
    }
    PG8_WAIT_V(0);
    if constexpr (!ALIGN_EPI) { if (wr == 0) PG8_BAR; }
    PG8_BAR;
    if constexpr (Epi::AFTER_DRAIN) { int fr2 = fr, fq2 = fq, lane2 = lane; asm volatile("" : "+v"(fr2), "+v"(fq2), "+v"(lane2)); E.fused(acc, cur, wr, wc, fr2, fq2, lds, wid, lane2); S.done(cur); }
#undef PG8_SA
#undef PG8_SB
#undef PG8_STAGE
#undef PG8_LDA
#undef PG8_LD16
#undef PG8_CAT
#undef PG8_LDB
#undef PG8_MMA
#undef PG8_WAIT_V
#undef PG8_WAIT_L
#undef PG8_BAR
#undef PG8_SCHED
}
}
using pg8::Unit;
typedef const f32x4 (&AccRef)[2][2][4][2];

__device__ __forceinline__ u32x4 pack8(const f32x4 a, const f32x4 b) { u32x4 w; w.x = pk2(a[0], a[1]); w.y = pk2(a[2], a[3]); w.z = pk2(b[0], b[1]); w.w = pk2(b[2], b[3]); return w; }
__device__ __forceinline__ void unpack8(const u32x4 w, f32x4& a, f32x4& b) { a = (f32x4){bflo(w.x), bfhi(w.x), bflo(w.y), bfhi(w.y)}; b = (f32x4){bflo(w.z), bfhi(w.z), bflo(w.w), bfhi(w.w)}; }

struct EpiInproj {
    static constexpr bool PERM = true, AFTER_DRAIN = false;
    const float* stats; bf16_t* uconv; bf16_t* xu; bf16_t* gates;
    __device__ __forceinline__ void operator()(AccRef acc, const Unit& u, int wr, int wc, int fr, int fq) const {
        float rr[2][4];
#pragma unroll
        for (int ai = 0; ai < 2; ++ai)
#pragma unroll
            for (int m = 0; m < 4; ++m) rr[ai][m] = row_rstd(stats, u.pm * 256 + ai * 128 + wr * 64 + m * 16 + fr);
#pragma unroll
        for (int ai = 0; ai < 2; ++ai)
#pragma unroll
            for (int m = 0; m < 4; ++m) {
                const int row = u.pm * 256 + ai * 128 + wr * 64 + m * 16 + fr;
                const float r = rr[ai][m];
                if (u.pn < 4) {
                    f32x4 v[2];
#pragma unroll
                    for (int n = 0; n < 2; ++n)
#pragma unroll
                        for (int i = 0; i < 4; ++i) v[n][i] = (acc[ai][0][m][n][i] * r) * sigmoidf_(acc[ai][1][m][n][i] * r);
                    *(u32x4*)(uconv + (size_t)row * CW + u.pn * 128 + wc * 32 + fq * 8) = pack8(v[0], v[1]);
                } else if (u.pn < 6) {
                    const int b = row >> 12, t = row & 4095;
#pragma unroll
                    for (int bj = 0; bj < 2; ++bj) {
                        const int ch = (u.pn - 4) * 256 + bj * 128 + wc * 32 + fq * 8, g = ch >> 4, h0 = ch & 15;
                        const size_t off = ((size_t)((b * NG + g) * 256 + (t >> 4))) * 384 + (t & 15) * 16 + h0;
                        *(u32x4*)(xu + off) = pack8(acc[ai][bj][m][0] * r, acc[ai][bj][m][1] * r);
                    }
                } else {
#pragma unroll
                    for (int bj = 0; bj < 2; ++bj) {
                        f32x4 v[2];
#pragma unroll
                        for (int n = 0; n < 2; ++n)
#pragma unroll
                            for (int i = 0; i < 4; ++i) v[n][i] = sigmoidf_(acc[ai][bj][m][n][i] * r);
                        *(u32x4*)(gates + (size_t)row * 2048 + (u.pn - 6) * 256 + bj * 128 + wc * 32 + fq * 8) = pack8(v[0], v[1]);
                    }
                }
            }
    }
};
struct EpiGates {
    static constexpr bool PERM = true, AFTER_DRAIN = false;
    const float* stats; bf16_t* gates; float sc;
    __device__ __forceinline__ void operator()(AccRef acc, const Unit& u, int wr, int wc, int fr, int fq) const {
        float rr[2][4];
#pragma unroll
        for (int ai = 0; ai < 2; ++ai)
#pragma unroll
            for (int m = 0; m < 4; ++m) rr[ai][m] = row_rstd(stats, u.pm * 256 + ai * 128 + wr * 64 + m * 16 + fr) * sc;
#pragma unroll
        for (int ai = 0; ai < 2; ++ai)
#pragma unroll
            for (int m = 0; m < 4; ++m) {
                const int row = u.pm * 256 + ai * 128 + wr * 64 + m * 16 + fr; const float r = rr[ai][m];
#pragma unroll
                for (int bj = 0; bj < 2; ++bj) {
                    f32x4 v[2];
#pragma unroll
                    for (int n = 0; n < 2; ++n)
#pragma unroll
                        for (int i = 0; i < 4; ++i) v[n][i] = sigmoidf_(acc[ai][bj][m][n][i] * r);
                    *(u32x4*)(gates + (size_t)row * 2048 + u.pn * 256 + bj * 128 + wc * 32 + fq * 8) = pack8(v[0], v[1]);
                }
            }
    }
};
struct EpiZ {
    static constexpr bool PERM = true, AFTER_DRAIN = false;
    const bf16_t* gates; bf16_t* mb;
    __device__ __forceinline__ void operator()(AccRef acc, const Unit& u, int wr, int wc, int fr, int fq) const {
        const int oc = u.pn * 128 + wc * 32 + fq * 8;
        u32x4 gv[2][4];
#pragma unroll
        for (int ai = 0; ai < 2; ++ai)
#pragma unroll
            for (int m = 0; m < 4; ++m) gv[ai][m] = *(const u32x4*)(gates + (size_t)(u.pm * 256 + ai * 128 + wr * 64 + m * 16 + fr) * 2048 + 1024 + oc);
#pragma unroll
        for (int ai = 0; ai < 2; ++ai)
#pragma unroll
            for (int m = 0; m < 4; ++m) {
                const int row = u.pm * 256 + ai * 128 + wr * 64 + m * 16 + fr;
                f32x4 g0, g1; unpack8(gv[ai][m], g0, g1);
                f32x4 v[2];
#pragma unroll
                for (int i = 0; i < 4; ++i) { v[0][i] = g0[i] * acc[ai][0][m][0][i] * sigmoidf_(acc[ai][1][m][0][i]); v[1][i] = g1[i] * acc[ai][0][m][1][i] * sigmoidf_(acc[ai][1][m][1][i]); }
                *(u32x4*)(mb + (size_t)row * D + oc) = pack8(v[0], v[1]);
            }
    }
};
struct EpiPw {
    static constexpr bool PERM = true, AFTER_DRAIN = false;
    const bf16_t* gates; const bf16_t* mb; bf16_t* merged;
    __device__ __forceinline__ void operator()(AccRef acc, const Unit& u, int wr, int wc, int fr, int fq) const {
#pragma unroll
        for (int ai = 0; ai < 2; ++ai) {
            u32x4 gv[4][2], mv[4][2];
#pragma unroll
            for (int m = 0; m < 4; ++m)
#pragma unroll
                for (int bj = 0; bj < 2; ++bj) { const int row = u.pm * 256 + ai * 128 + wr * 64 + m * 16 + fr, c = u.pn * 256 + bj * 128 + wc * 32 + fq * 8;
                    gv[m][bj] = *(const u32x4*)(gates + (size_t)row * 2048 + c); mv[m][bj] = *(const u32x4*)(mb + (size_t)row * D + c); }
#pragma unroll
            for (int m = 0; m < 4; ++m)
#pragma unroll
                for (int bj = 0; bj < 2; ++bj) { const int row = u.pm * 256 + ai * 128 + wr * 64 + m * 16 + fr, c = u.pn * 256 + bj * 128 + wc * 32 + fq * 8;
                    f32x4 g0, g1, m0, m1; unpack8(gv[m][bj], g0, g1); unpack8(mv[m][bj], m0, m1);
                    *(u32x4*)(merged + (size_t)row * D + c) = pack8(g0 * acc[ai][bj][m][0] + m0, g1 * acc[ai][bj][m][1] + m1); }
        }
    }
};
struct EpiZPW {
    static constexpr bool PERM = true, AFTER_DRAIN = false;
    EpiZ ez; EpiPw ep;
    __device__ __forceinline__ void operator()(AccRef acc, const Unit& u, int wr, int wc, int fr, int fq) const {
        if (u.tag == 0) ez(acc, u, wr, wc, fr, fq);
        else { asm volatile("s_waitcnt vmcnt(0)" ::: "memory"); ep(acc, u, wr, wc, fr, fq); }
    }
};
struct SchedZPW {
    pg8::StaticOrder o; const char* ys; const char* uc; const char* wglu; const char* wpw;
    __device__ __forceinline__ bool next(int i, Unit& u) const { const int gi = i / 3, sub = i - gi * 3; int pm, pn; if (!o.next(gi, pm, pn)) return false;
        u.pm = pm;
        if (sub < 2) { u.pn = 2 * pn + sub; u.tag = 0; u.A = ys + (size_t)pm * 256 * SW * 2; u.B = wglu + (size_t)u.pn * 256 * SW * 2; }
        else { u.pn = pn; u.tag = 1; u.A = uc + (size_t)pm * 256 * CW * 2; u.B = wpw + (size_t)pn * 256 * CW * 2; }
        return true; }
    __device__ __forceinline__ void a_ready(const Unit&) const {}
    __device__ __forceinline__ void done(const Unit&) const {}
};
template <bool H8OUT = false, bool SCALED = false> struct EpiRes {
    static constexpr bool PERM = true, AFTER_DRAIN = false;
    bf16_t* h; float* stats; bf16_t* hdst; unsigned char* h8; LAS unsigned char* lds;
    __device__ __forceinline__ void operator()(AccRef acc, const Unit& u, int wr, int wc, int fr, int fq) const {
        LAS float* X = (LAS float*)(lds + LDS_AUX);
#pragma unroll
        for (int ai = 0; ai < 2; ++ai) {
            u32x4 hv[4][2];
#pragma unroll
            for (int m = 0; m < 4; ++m)
#pragma unroll
                for (int bj = 0; bj < 2; ++bj) hv[m][bj] = *(const u32x4*)(h + (size_t)(u.pm * 256 + ai * 128 + wr * 64 + m * 16 + fr) * D + u.pn * 256 + bj * 128 + wc * 32 + fq * 8);
#pragma unroll
            for (int m = 0; m < 4; ++m) {
                const int row = u.pm * 256 + ai * 128 + wr * 64 + m * 16 + fr; float ss = 0.f;
#pragma unroll
                for (int bj = 0; bj < 2; ++bj) {
                    const size_t eo = (size_t)row * D + u.pn * 256 + bj * 128 + wc * 32 + fq * 8;
                    f32x4 h0, h1; unpack8(hv[m][bj], h0, h1);
                    constexpr float asc = SCALED ? 1.0f / (F8_WD_SCALE * F8_ACT_SCALE) : 1.0f;
                    h0 = h0 + acc[ai][bj][m][0] * asc; h1 = h1 + acc[ai][bj][m][1] * asc;
                    ss += (h0[0] * h0[0] + h0[1] * h0[1]) + (h0[2] * h0[2] + h0[3] * h0[3]) + (h1[0] * h1[0] + h1[1] * h1[1]) + (h1[2] * h1[2] + h1[3] * h1[3]);
                    *(u32x4*)(hdst + eo) = pack8(h0, h1);
                    if (H8OUT) { u32x2 w8; w8.x = pk4_fp8(h0[0], h0[1], h0[2], h0[3]); w8.y = pk4_fp8(h1[0], h1[1], h1[2], h1[3]); *(u32x2*)(h8 + eo) = w8; }
                }
                ss += __shfl_xor(ss, 16); ss += __shfl_xor(ss, 32);
                if (fq == 0) X[(ai * 128 + wr * 64 + m * 16 + fr) * 4 + wc] = ss;
            }
        }
        LDS_WAIT(); __builtin_amdgcn_s_barrier(); asm volatile("" ::: "memory");
        const int lane = fq * 16 + fr, wid = wr * 4 + wc;
        if (lane < 32) { const int rl = wid * 32 + lane; const f32x4 v = *(const LAS f32x4*)(X + rl * 4); stats[(size_t)(u.pm * 256 + rl) * 4 + u.pn] = (v[0] + v[1]) + (v[2] + v[3]); }
    }
};
struct EpiQ {
    static constexpr bool PERM = true, AFTER_DRAIN = false;
    const float* stats; bf16_t* q; float sc;
    __device__ __forceinline__ void operator()(AccRef acc, const Unit& u, int wr, int wc, int fr, int fq) const {
        float rr[2][4];
#pragma unroll
        for (int ai = 0; ai < 2; ++ai)
#pragma unroll
            for (int m = 0; m < 4; ++m) rr[ai][m] = row_rstd(stats, u.pm * 256 + ai * 128 + wr * 64 + m * 16 + fr) * sc;
#pragma unroll
        for (int ai = 0; ai < 2; ++ai)
#pragma unroll
            for (int m = 0; m < 4; ++m) {
                const int row = u.pm * 256 + ai * 128 + wr * 64 + m * 16 + fr; const float r = rr[ai][m];
#pragma unroll
                for (int bj = 0; bj < 2; ++bj)
                    *(u32x4*)(q + (size_t)row * D + u.pn * 256 + bj * 128 + wc * 32 + fq * 8) = pack8(acc[ai][bj][m][0] * r, acc[ai][bj][m][1] * r);
            }
    }
};
template <bool MOE, bool F8 = false> struct EpiGU {
    static constexpr bool PERM = true, AFTER_DRAIN = false;
    const float* stats;
    const float* gwt;
    bf16_t* act; int ldc;
    __device__ __forceinline__ void operator()(AccRef acc, const Unit& u, int wr, int wc, int fr, int fq) const {
        float rr[2][4], gg[2][4];
#pragma unroll
        for (int ai = 0; ai < 2; ++ai)
#pragma unroll
            for (int m = 0; m < 4; ++m) { const int row = u.pm * 256 + ai * 128 + wr * 64 + m * 16 + fr; gg[ai][m] = 1.f; if (MOE) { rr[ai][m] = stats[row]; gg[ai][m] = gwt[row]; } else rr[ai][m] = row_rstd(stats, row); }
#pragma unroll
        for (int ai = 0; ai < 2; ++ai)
#pragma unroll
            for (int m = 0; m < 4; ++m) {
                const int row = u.pm * 256 + ai * 128 + wr * 64 + m * 16 + fr;
                float r = rr[ai][m], gw = gg[ai][m];
                if (F8) { r *= 1.0f / F8_WGU_SCALE; gw *= F8_ACT_SCALE; }
                f32x4 v[2];
#pragma unroll
                for (int n = 0; n < 2; ++n)
#pragma unroll
                    for (int i = 0; i < 4; ++i) v[n][i] = siluf_(acc[ai][0][m][n][i] * r) * (acc[ai][1][m][n][i] * r) * gw;
                if (F8) { u32x2 w8; w8.x = pk4_fp8(v[0][0], v[0][1], v[0][2], v[0][3]); w8.y = pk4_fp8(v[1][0], v[1][1], v[1][2], v[1][3]); *(u32x2*)((unsigned char*)act + (size_t)row * ldc + u.pn * 128 + wc * 32 + fq * 8) = w8; }
                else *(u32x4*)(act + (size_t)row * ldc + u.pn * 128 + wc * 32 + fq * 8) = pack8(v[0], v[1]);
            }
    }
};
struct EpiPlain {
    static constexpr bool PERM = true, AFTER_DRAIN = false;
    bf16_t* o0; bf16_t* o1; int ld0, ld1; size_t ls0, ls1; float osc = 1.f;
    __device__ __forceinline__ void operator()(AccRef acc, const Unit& u, int wr, int wc, int fr, int fq) const {
        const int which = u.tag & 1, layer = u.tag >> 1; bf16_t* o = which ? o1 + (size_t)layer * ls1 : o0 + (size_t)layer * ls0; const int ld = which ? ld1 : ld0;
#pragma unroll
        for (int ai = 0; ai < 2; ++ai)
#pragma unroll
            for (int m = 0; m < 4; ++m) {
                const int row = u.pm * 256 + ai * 128 + wr * 64 + m * 16 + fr;
#pragma unroll
                for (int bj = 0; bj < 2; ++bj)
                    *(u32x4*)(o + (size_t)row * ld + u.pn * 256 + bj * 128 + wc * 32 + fq * 8) = pack8(acc[ai][bj][m][0] * osc, acc[ai][bj][m][1] * osc);
            }
    }
};
struct EpiSsm1 {
    static constexpr bool PERM = true, AFTER_DRAIN = true;
    const float* a16;
    bf16_t* xu;
    __device__ __forceinline__ void fused(AccRef acc, const Unit& u, int wr, int wc, int fr, int fq, LAS unsigned char* lds, int wid, int lane) const {
        LAS float* S = (LAS float*)lds;
#pragma unroll
        for (int ai = 0; ai < 2; ++ai)
#pragma unroll
            for (int m = 0; m < 4; ++m) {
                const int row = ai * 128 + wr * 64 + m * 16 + fr;
#pragma unroll
                for (int n = 0; n < 2; ++n) *(LAS f32x4*)(S + row * 128 + wc * 32 + fq * 8 + n * 4) = acc[ai][0][m][n];
            }
        LDS_WAIT(); __builtin_amdgcn_s_barrier(); asm volatile("" ::: "memory");
        LAS f32x2* Sp = (LAS f32x2*)lds; LAS f32x2* E = (LAS f32x2*)(lds + LDS_AUX);
        const int p = lane, seg = wid;
        const f32x2 a = *(const f32x2*)(a16 + 2 * p);
        f32x2 x = {0.f, 0.f};
        for (int c = seg * 32; c < seg * 32 + 32; ++c) { const f32x2 s = Sp[c * 64 + p]; Sp[c * 64 + p] = x; x = (f32x2){a.x * x.x - a.y * x.y + s.x, a.x * x.y + a.y * x.x + s.y}; }
        E[seg * 64 + p] = x;
        LDS_WAIT(); __builtin_amdgcn_s_barrier(); asm volatile("" ::: "memory");
        f32x2 a512 = a;
#pragma unroll
        for (int i = 0; i < 5; ++i) a512 = (f32x2){a512.x * a512.x - a512.y * a512.y, 2.f * a512.x * a512.y};
        f32x2 z = {0.f, 0.f};
        for (int j = 0; j < seg; ++j) { const f32x2 e = E[j * 64 + p]; z = (f32x2){a512.x * z.x - a512.y * z.y + e.x, a512.x * z.y + a512.y * z.x + e.y}; }
        for (int c = seg * 32; c < seg * 32 + 32; ++c) { const f32x2 hl = Sp[c * 64 + p];
            *(unsigned*)(xu + (size_t)c * 384 + 256 + 2 * p) = pk2(hl.x + z.x, hl.y + z.y);
            z = (f32x2){a.x * z.x - a.y * z.y, a.x * z.y + a.y * z.x}; }
    }
};
struct EpiSsm2 {
    static constexpr bool PERM = true, AFTER_DRAIN = false;
    bf16_t* ys; int b, g;
    __device__ __forceinline__ void operator()(AccRef acc, const Unit& u, int wr, int wc, int fr, int fq) const {
#pragma unroll
        for (int ai = 0; ai < 2; ++ai)
#pragma unroll
            for (int m = 0; m < 4; ++m) {
                const int c = ai * 128 + wr * 64 + m * 16 + fr;
#pragma unroll
                for (int bj = 0; bj < 2; ++bj) {
                    const int j = bj * 8 + wc * 2 + (fq >> 1), h0 = (fq & 1) * 8;
                    f32x4 v[2];
#pragma unroll
                    for (int n = 0; n < 2; ++n)
#pragma unroll
                        for (int i = 0; i < 4; ++i) v[n][i] = gelu_tanh_(acc[ai][bj][m][n][i]);
                    *(u32x4*)(ys + ((size_t)b * SEQ + c * 16 + j) * SW + g * 16 + h0) = pack8(v[0], v[1]);
                }
            }
    }
};

#define XB_TMO      128
#define XB_XCNT(j)  (256  + 64 * (j))
#define XB_XSUB(j)  (1280 + 64 * (j))
#define XB_XGEN(j)  (2304 + 64 * (j))
#define XB_TOP      3328
#define XB_TOPGEN   3392
#define XCD_BAR_WORDS 3456
#define XB_SPIN_CAP (1u << 18)
__device__ __forceinline__ unsigned xb_ld(unsigned* p)              { return __hip_atomic_load(p, __ATOMIC_RELAXED, __HIP_MEMORY_SCOPE_AGENT); }
__device__ __forceinline__ unsigned xb_add(unsigned* p, unsigned v) { return __hip_atomic_fetch_add(p, v, __ATOMIC_RELAXED, __HIP_MEMORY_SCOPE_AGENT); }
__device__ __forceinline__ unsigned xb_xcc_id() { return (unsigned)__builtin_amdgcn_s_getreg((3 << 11) | 20) & 0xFu; }
#define XB_SPIN(cond, bar) do { unsigned _sp = 0; while (cond) { __builtin_amdgcn_s_sleep(1); \
    if ((++_sp & 255u) == 0u) { if (xb_ld(&(bar)[XB_TMO])) break; if (_sp > XB_SPIN_CAP) { atomicAdd(&(bar)[XB_TMO], 1u); break; } } } } while (0)
struct XcdBarrier { unsigned* bar; unsigned x; volatile LAS unsigned* st; };
__device__ __forceinline__ XcdBarrier xcd_barrier_post(unsigned* bar, volatile LAS unsigned* st) {
    XcdBarrier b; b.bar = bar; b.x = xb_xcc_id(); b.st = st;
    if (threadIdx.x == 0) (void)xb_add(&bar[XB_XCNT(b.x)], 1u);
    return b;
}
__device__ __forceinline__ void xcd_barrier_complete(unsigned* bar, unsigned x, unsigned& nloc, unsigned& nx) {
    const unsigned G = gridDim.x * gridDim.y * gridDim.z;
    unsigned sum, cnt, mine, sp = 0u;
    for (;;) {
        sum = 0u; cnt = 0u; mine = 0u;
#pragma unroll
        for (unsigned j = 0; j < 16; ++j) { const unsigned c = xb_ld(&bar[XB_XCNT(j)]); sum += c; cnt += (c > 0u) ? 1u : 0u; mine = (j == x) ? c : mine; }
        if (sum == G) break;
        __builtin_amdgcn_s_sleep(1);
        if ((++sp & 255u) == 0u) { if (xb_ld(&bar[XB_TMO])) break; if (sp > XB_SPIN_CAP) { atomicAdd(&bar[XB_TMO], 1u); break; } }
    }
    nloc = mine > 0u ? mine : 1u; nx = cnt > 0u ? cnt : 1u;
}
__device__ __forceinline__ void xcd_barrier(const XcdBarrier& b) {
    asm volatile("s_waitcnt vmcnt(0)" ::: "memory");
    __syncthreads();
    if (threadIdx.x == 0) {
        unsigned* bar = b.bar;
        __builtin_amdgcn_s_waitcnt(0);
        unsigned nloc = b.st[0], nx = b.st[1];
        if (nloc == 0u) { xcd_barrier_complete(bar, b.x, nloc, nx); b.st[0] = nloc; b.st[1] = nx; }
        const unsigned old = xb_add(&bar[XB_XSUB(b.x)], 1u);
        const unsigned gen = old / nloc;
        if (old + 1u == (gen + 1u) * nloc) {
            __builtin_amdgcn_fence(__ATOMIC_RELEASE, "agent");
            asm volatile("s_waitcnt vmcnt(0)" ::: "memory");
            const unsigned og = xb_add(&bar[XB_TOP], 1u);
            const unsigned tg = og / nx;
            if (og + 1u == (tg + 1u) * nx) xb_add(&bar[XB_TOPGEN], 1u);
            else XB_SPIN(xb_ld(&bar[XB_TOPGEN]) == tg, bar);
            __builtin_amdgcn_fence(__ATOMIC_ACQUIRE, "agent");
            xb_add(&bar[XB_XGEN(b.x)], 1u);
            asm volatile("s_waitcnt vmcnt(0)" ::: "memory");
        } else {
            XB_SPIN(xb_ld(&bar[XB_XGEN(b.x)]) == gen, bar);
            __builtin_amdgcn_fence(__ATOMIC_ACQUIRE, "agent");
            asm volatile("s_waitcnt vmcnt(0)" ::: "memory");
        }
    }
    __syncthreads();
}

struct Args {
    const float* in[32];
    float* out; unsigned char* ws;
    int ph_lo, ph_hi;
};
enum { I_X = 0, I_MEM, I_MEMG, I_NMIXG, I_WIN, I_CONVW, I_CONVB, I_LNG, I_LNB, I_WPW, I_LRE, I_LIM, I_LOGDT, I_BRE, I_BIM, I_CRE, I_CIM, I_DSKIP, I_WGLU, I_WOUT,
       I_NXG, I_WQ, I_WKV, I_WO, I_NFG, I_FGU, I_FD, I_RW, I_RB, I_MGU, I_MD, I_FINALG };

struct Frame {
    LAS unsigned char* lds; int tid, lane, wave, c, G;
    unsigned char* ws; const float* const* in; float* out;
};
template <class Tp> __device__ __forceinline__ Tp* wsp(const Frame& F, size_t off) { return (Tp*)(F.ws + off); }

template <bool F8 = false>
__device__ __forceinline__ void xpose_matrix(const Frame& F, const float* W, int K, int Nsrc, int N, bf16_t* WT, int permlimit, int halfN, const float* gk, float sc, unsigned& item_base) {
    LAS float* scr = (LAS float*)(F.lds + F.wave * 16640);
    const int lane = F.lane, NGW = F.G * 8, gw = F.c * 8 + F.wave;
    const int nblk = N / 64, items = (K / 64) * nblk;
    int first = (int)(((unsigned)gw + (unsigned)NGW - (item_base % (unsigned)NGW)) % (unsigned)NGW);
    item_base = (item_base + (unsigned)items) % (unsigned)NGW;
    const int kr = lane >> 4, nc = (lane & 15) * 4;
    for (int it = first; it < items; it += NGW) {
        const int kb = it / nblk, nb = it % nblk, k0 = 64 * kb, n0 = 64 * nb;
        const int c0 = (n0 < permlimit) ? (((n0 >> 7) & 1) * halfN + (n0 >> 8) * 128 + (n0 & 127)) : n0;
        f32x4 v[16];
#pragma unroll
        for (int i = 0; i < 16; ++i) v[i] = *(const f32x4*)(W + (size_t)(k0 + 4 * i + kr) * Nsrc + c0 + nc);
#pragma unroll
        for (int i = 0; i < 16; ++i) { const float g = gk ? gk[k0 + 4 * i + kr] * sc : sc; LAS float* d = scr + (4 * i + kr) * 65 + nc;
            d[0] = v[i][0] * g; d[1] = v[i][1] * g; d[2] = v[i][2] * g; d[3] = v[i][3] * g; }
        LDS_WAIT(); asm volatile("" ::: "memory");
        const int c = lane & 7;
#pragma unroll
        for (int j = 0; j < 8; ++j) { const int n = (lane >> 3) + 8 * j; const LAS float* s = scr + (8 * c) * 65 + n;
            u32x4 o; o.x = pk2(s[0 * 65], s[1 * 65]); o.y = pk2(s[2 * 65], s[3 * 65]); o.z = pk2(s[4 * 65], s[5 * 65]); o.w = pk2(s[6 * 65], s[7 * 65]);
            if (F8) { u32x2 o8; o8.x = pk4_fp8(s[0 * 65], s[1 * 65], s[2 * 65], s[3 * 65]); o8.y = pk4_fp8(s[4 * 65], s[5 * 65], s[6 * 65], s[7 * 65]); *(u32x2*)((unsigned char*)WT + (size_t)(n0 + n) * K + k0 + 8 * c) = o8; }
            else *(u32x4*)(WT + (size_t)(n0 + n) * K + k0 + 8 * c) = o; }
        LDS_WAIT(); asm volatile("" ::: "memory");
    }
}
__device__ __forceinline__ void ssm_tables(const Frame& F, int layer, int g) {
    LAS float* L = (LAS float*)F.lds;
    LAS float* AP = L;
    LAS float* BB = L + 17 * 128;
    LAS float* CC = BB + 2048;
    LAS float* KI = CC + 2048;
    const int tid = F.tid;
    const float* lre = F.in[I_LRE] + (size_t)(layer * NG + g) * SP; const float* lim = F.in[I_LIM] + (size_t)(layer * NG + g) * SP;
    const float dt = expf(F.in[I_LOGDT][layer * NG + g]);
    __syncthreads();
    for (int i = tid; i < 17 * 64; i += 512) { const int n = i >> 6, p = i & 63; const float mag = expf((float)n * lre[p] * dt), th = (float)n * (lim[p] * dt); AP[i * 2] = mag * cosf(th); AP[i * 2 + 1] = mag * sinf(th); }
    {
        const float* bre = F.in[I_BRE] + (size_t)(layer * NG + g) * SP * SG; const float* bim = F.in[I_BIM] + (size_t)(layer * NG + g) * SP * SG;
        for (int i = tid; i < 1024; i += 512) { const int p = i >> 4; const float lr = lre[p], li = lim[p];
            const float mag = expf(lr * dt), ar = mag * cosf(li * dt), aim = mag * sinf(li * dt), den = lr * lr + li * li, xr = ar - 1.0f;
            const float kr = (xr * lr + aim * li) / den, ki = (aim * lr - xr * li) / den, br = bre[i], bi = bim[i];
            BB[i * 2] = kr * br - ki * bi; BB[i * 2 + 1] = kr * bi + ki * br; }
        const float* cre = F.in[I_CRE] + (size_t)(layer * NG + g) * SG * SP; const float* cim = F.in[I_CIM] + (size_t)(layer * NG + g) * SG * SP;
        for (int i = tid; i < 1024; i += 512) { CC[i * 2] = cre[i]; CC[i * 2 + 1] = cim[i]; }
    }
    __syncthreads();
    for (int i = tid; i < 4096; i += 512) { const int tau = i >> 8, hp = (i >> 4) & 15, h = i & 15; float s = 0.f;
        for (int p = 0; p < 64; ++p) { const float ar = AP[(tau * 64 + p) * 2], ai = AP[(tau * 64 + p) * 2 + 1], br = BB[(p * 16 + h) * 2], bi = BB[(p * 16 + h) * 2 + 1];
            const float tr = ar * br - ai * bi, ti = ar * bi + ai * br; s += CC[(hp * 64 + p) * 2] * tr - CC[(hp * 64 + p) * 2 + 1] * ti; }
        if (tau == 0 && hp == h) s += F.in[I_DSKIP][(layer * NG + g) * SG + h];
        KI[i] = s; }
    __syncthreads();
    bf16_t* wst = wsp<bf16_t>(F, WS_WST) + (size_t)(layer * NG + g) * 256 * 256;
    bf16_t* tw = wsp<bf16_t>(F, WS_TW) + (size_t)(layer * NG + g) * 256 * 384;
    for (int i = tid; i < 256 * 128; i += 512) { const int row = i >> 7, cp = (i & 127) * 2; unsigned o = 0u;
        if (row < 128) { const int p = row >> 1, ri = row & 1; float v[2];
#pragma unroll
            for (int e = 0; e < 2; ++e) { const int col = cp + e, s = col >> 4, h = col & 15; const float ar = AP[((15 - s) * 64 + p) * 2], ai = AP[((15 - s) * 64 + p) * 2 + 1], br = BB[(p * 16 + h) * 2], bi = BB[(p * 16 + h) * 2 + 1];
                v[e] = ri ? (ar * bi + ai * br) : (ar * br - ai * bi); }
            o = pk2(v[0], v[1]); }
        *(unsigned*)(wst + (size_t)row * 256 + cp) = o; }
    for (int i = tid; i < 256 * 192; i += 512) { const int row = i / 192, cp = (i % 192) * 2, j = row >> 4, hp = row & 15; float v[2];
#pragma unroll
        for (int e = 0; e < 2; ++e) { const int col = cp + e;
            if (col < 256) { const int s = col >> 4, h = col & 15; v[e] = (j >= s) ? KI[((j - s) * 16 + hp) * 16 + h] : 0.f; }
            else { const int q = col - 256, p = q >> 1, ri = q & 1; const float ar = AP[((j + 1) * 64 + p) * 2], ai = AP[((j + 1) * 64 + p) * 2 + 1], cr = CC[(hp * 64 + p) * 2], ci = CC[(hp * 64 + p) * 2 + 1];
                v[e] = ri ? -(cr * ai + ci * ar) : (cr * ar - ci * ai); } }
        *(unsigned*)(tw + (size_t)row * 384 + cp) = pk2(v[0], v[1]); }
    float* a16 = wsp<float>(F, WS_A16) + (size_t)(layer * NG + g) * 128;
    for (int i = tid; i < 128; i += 512) a16[i] = AP[16 * 128 + i];
    __syncthreads();
}

__device__ __forceinline__ void prologue(const Frame& F) {
    unsigned ib = 0u;
    for (int l = 0; l < DEPTH; ++l) {
        if (F8_GATES) { xpose_matrix(F, F.in[I_WIN] + (size_t)l * D * INC, D, INC, 1536, wsp<bf16_t>(F, WS_WIN) + (size_t)l * INC * D, 1024, 512, F.in[I_NMIXG] + l * D, 1.f, ib);
            xpose_matrix<true>(F, F.in[I_WIN] + (size_t)l * D * INC + 1536, D, INC, 2048, wsp<bf16_t>(F, WS_WIN) + (size_t)l * INC * D + (size_t)1536 * D, 0, 0, F.in[I_NMIXG] + l * D, F8_WGU_SCALE, ib); }
        else xpose_matrix(F, F.in[I_WIN] + (size_t)l * D * INC, D, INC, INC, wsp<bf16_t>(F, WS_WIN) + (size_t)l * INC * D, 1024, 512, F.in[I_NMIXG] + l * D, 1.f, ib);
        xpose_matrix(F, F.in[I_WPW] + (size_t)l * CW * D, CW, D, D, wsp<bf16_t>(F, WS_WPW) + (size_t)l * D * CW, 0, 0, nullptr, 1.f, ib);
        xpose_matrix(F, F.in[I_WGLU] + (size_t)l * SW * 2 * D, SW, 2 * D, 2 * D, wsp<bf16_t>(F, WS_WGLU) + (size_t)l * 2 * D * SW, 2 * D, D, nullptr, 1.f, ib);
        xpose_matrix(F, F.in[I_WOUT] + (size_t)l * D * D, D, D, D, wsp<bf16_t>(F, WS_WOUT) + (size_t)l * D * D, 0, 0, nullptr, 1.f, ib);
        xpose_matrix<F8_QO != 0>(F, F.in[I_WQ] + (size_t)l * D * D, D, D, D, wsp<bf16_t>(F, WS_WQ) + (size_t)l * D * D, 0, 0, F.in[I_NXG] + l * D, F8_QO ? 0.0625f * F8_WQ_SCALE : 0.0625f, ib);
        xpose_matrix(F, F.in[I_WKV] + (size_t)l * D * 2 * D, D, 2 * D, 2 * D, wsp<bf16_t>(F, WS_WKV) + (size_t)l * 2 * D * D, 0, 0, nullptr, 1.f, ib);
        xpose_matrix<F8_QO != 0>(F, F.in[I_WO] + (size_t)l * D * D, D, D, D, wsp<bf16_t>(F, WS_WO) + (size_t)l * D * D, 0, 0, nullptr, F8_QO ? F8_WO_SCALE : 1.f, ib);
    }
    for (int j = 0; j < 2; ++j) {
        if (!F8_DENSE(2 * j)) {
            xpose_matrix(F, F.in[I_FGU] + (size_t)j * D * 2 * DFF, D, 2 * DFF, 2 * DFF, wsp<bf16_t>(F, WS_WFGU) + (size_t)j * 2 * DFF * D, 2 * DFF, DFF, F.in[I_NFG] + (2 * j) * D, 1.f, ib);
            xpose_matrix(F, F.in[I_FD] + (size_t)j * DFF * D, DFF, D, D, wsp<bf16_t>(F, WS_WFD) + (size_t)j * D * DFF, 0, 0, nullptr, 1.f, ib);
        } else {
            xpose_matrix<true>(F, F.in[I_FGU] + (size_t)j * D * 2 * DFF, D, 2 * DFF, 2 * DFF, wsp<bf16_t>(F, WS_WFGU) + (size_t)j * 2 * DFF * D, 2 * DFF, DFF, F.in[I_NFG] + (2 * j) * D, F8_WGU_SCALE, ib);
            xpose_matrix<true>(F, F.in[I_FD] + (size_t)j * DFF * D, DFF, D, D, wsp<bf16_t>(F, WS_WFD) + (size_t)j * D * DFF, 0, 0, nullptr, F8_WD_SCALE, ib);
        }
        for (int e = 0; e < NE; ++e) {
            if (!F8_MOE(2 * j + 1)) {
                xpose_matrix(F, F.in[I_MGU] + (size_t)(j * NE + e) * D * 2 * DFE, D, 2 * DFE, 2 * DFE, wsp<bf16_t>(F, WS_WMGU) + (size_t)(j * NE + e) * 2 * DFE * D, 2 * DFE, DFE, F.in[I_NFG] + (2 * j + 1) * D, 1.f, ib);
                xpose_matrix(F, F.in[I_MD] + (size_t)(j * NE + e) * DFE * D, DFE, D, D, wsp<bf16_t>(F, WS_WMD) + (size_t)(j * NE + e) * D * DFE, 0, 0, nullptr, 1.f, ib);
            } else {
                xpose_matrix<true>(F, F.in[I_MGU] + (size_t)(j * NE + e) * D * 2 * DFE, D, 2 * DFE, 2 * DFE, (bf16_t*)((unsigned char*)wsp<bf16_t>(F, WS_WMGU) + (size_t)j * NE * 2 * DFE * D * 2 + (size_t)e * 2 * DFE * D), 2 * DFE, DFE, F.in[I_NFG] + (2 * j + 1) * D, F8_WGU_SCALE, ib);
                xpose_matrix<true>(F, F.in[I_MD] + (size_t)(j * NE + e) * DFE * D, DFE, D, D, (bf16_t*)((unsigned char*)wsp<bf16_t>(F, WS_WMD) + (size_t)j * NE * D * DFE * 2 + (size_t)e * D * DFE), 0, 0, nullptr, F8_WD_SCALE, ib);
            }
        }
    }
    const int gw = F.c * 8 + F.wave, NGW = F.G * 8, lane = F.lane;
    { const float* gm = F.in[I_MEMG]; bf16_t* mn = wsp<bf16_t>(F, WS_MEMN);
      for (int r = gw; r < NMEM; r += NGW) { const f32x4* xr = (const f32x4*)(F.in[I_MEM] + (size_t)r * D) + lane; f32x4 v[4]; float s = 0.f;
#pragma unroll
          for (int j = 0; j < 4; ++j) { v[j] = xr[64 * j]; s += (v[j][0] * v[j][0] + v[j][1] * v[j][1]) + (v[j][2] * v[j][2] + v[j][3] * v[j][3]); }
          const float rs = __builtin_amdgcn_rsqf(wave_sum(s) * (1.f / D) + RMS_EPS);
#pragma unroll
          for (int j = 0; j < 4; ++j) { const f32x4 gg = ((const f32x4*)gm)[64 * j + lane]; u32x2 o; o.x = pk2(v[j][0] * rs * gg[0], v[j][1] * rs * gg[1]); o.y = pk2(v[j][2] * rs * gg[2], v[j][3] * rs * gg[3]);
              *((u32x2*)(mn + (size_t)r * D) + 64 * j + lane) = o; } } }
    { bf16_t* h = wsp<bf16_t>(F, WS_H); float* st = wsp<float>(F, WS_STATS); unsigned* h8 = wsp<unsigned>(F, WS_H8);
      for (int r = gw; r < T; r += NGW) { const f32x4* xr = (const f32x4*)(F.in[I_X] + (size_t)r * D) + lane; float s = 0.f;
#pragma unroll
          for (int j = 0; j < 4; ++j) { const f32x4 v = xr[64 * j]; s += (v[0] * v[0] + v[1] * v[1]) + (v[2] * v[2] + v[3] * v[3]); u32x2 o; o.x = pk2(v[0], v[1]); o.y = pk2(v[2], v[3]);
              *((u32x2*)(h + (size_t)r * D) + 64 * j + lane) = o; if (F8_GATES) h8[(size_t)r * (D / 4) + 64 * j + lane] = pk4_fp8(v[0], v[1], v[2], v[3]); }
          s = wave_sum(s);
          if (lane < 4) st[(size_t)r * 4 + lane] = (lane == 0) ? s : 0.f; } }
    for (int it = F.c; it < DEPTH * NG; it += F.G) ssm_tables(F, it / NG, it % NG);
}

__device__ __forceinline__ void conv_phase(const Frame& F, int layer) {
    const bf16_t* uin_g = wsp<bf16_t>(F, WS_UCONV); bf16_t* uc = wsp<bf16_t>(F, WS_UC);
    LAS bf16_t* uin = (LAS bf16_t*)F.lds;
    LAS float* yb = (LAS float*)(F.lds + 65536);
    const int tid = F.tid, lane = F.lane, wave = F.wave;
    float w[CK];
#pragma unroll
    for (int k = 0; k < CK; ++k) w[k] = F.in[I_CONVW][(size_t)(layer * CK + k) * CW + tid];
    const float bias = F.in[I_CONVB][layer * CW + tid];
    f32x4 lg0, lg1, lb0, lb1;
    { const f32x4* gp = (const f32x4*)(F.in[I_LNG] + layer * CW + lane * 8); lg0 = gp[0]; lg1 = gp[1]; const f32x4* bp = (const f32x4*)(F.in[I_LNB] + layer * CW + lane * 8); lb0 = bp[0]; lb1 = bp[1]; }
    for (int tile = F.c; tile < T / 32; tile += F.G) {
        const int t0 = tile * 32, p0 = t0 & (SEQ - 1);
        __syncthreads();
#pragma unroll
        for (int it = 0; it < 8; ++it) { const int id = it * 512 + tid;
            if (id < 62 * 64) { const int row = id >> 6, ch = id & 63; u32x4 v = {0u, 0u, 0u, 0u};
                if (p0 - 30 + row >= 0) v = *(const u32x4*)(uin_g + (size_t)(t0 - 30 + row) * CW + ch * 8);
                *(LAS u32x4*)(uin + row * 512 + ch * 8) = v; } }
        __syncthreads();
        float y[32], uu[62];
#pragma unroll
        for (int o = 0; o < 32; ++o) y[o] = bias;
#pragma unroll
        for (int j = 0; j < 62; ++j) uu[j] = __uint_as_float(((unsigned)uin[j * 512 + tid]) << 16);
#pragma unroll
        for (int k = 0; k < CK; ++k)
#pragma unroll
            for (int o = 0; o < 32; ++o) y[o] += w[k] * uu[o + k];
#pragma unroll
        for (int o = 0; o < 32; ++o) yb[o * 512 + tid] = y[o];
        __syncthreads();
#pragma unroll
        for (int q = 0; q < 4; ++q) { const int o = wave + 8 * q; const LAS f32x4* rp = (const LAS f32x4*)(yb + o * 512 + lane * 8); f32x4 a = rp[0], b = rp[1];
            const float mean = wave_sum((a[0] + a[1]) + (a[2] + a[3]) + (b[0] + b[1]) + (b[2] + b[3])) * (1.f / CW);
            a = a - mean; b = b - mean;
            const float var = wave_sum((a[0] * a[0] + a[1] * a[1]) + (a[2] * a[2] + a[3] * a[3]) + (b[0] * b[0] + b[1] * b[1]) + (b[2] * b[2] + b[3] * b[3])) * (1.f / CW);
            const float rs = __builtin_amdgcn_rsqf(var + LN_EPS);
            a = a * rs * lg0 + lb0; b = b * rs * lg1 + lb1;
#pragma unroll
            for (int i = 0; i < 4; ++i) { a[i] = siluf_(a[i]); b[i] = siluf_(b[i]); }
            *(u32x4*)(uc + (size_t)(t0 + o) * CW + lane * 8) = pack8(a, b); }
    }
    __syncthreads();
}

#define MFMA32(a, b, c) __builtin_amdgcn_mfma_f32_32x32x16_bf16((a), (b), (c), 0, 0, 0)
#define ATT_LOAD16(dst, ptr0, stride_bytes) do { unsigned long long _p = (unsigned long long)(ptr0); _Pragma("unroll") for (int it = 0; it < 16; ++it) { dst[it] = *(const GAS u32x4*)_p; _p += (stride_bytes); asm volatile("" : "+v"(_p)); } } while (0)
#define ATT_STORE16(src) do { LAS char* _w0 = (LAS char*)Ks + (tid >> 5) * 528 + (tid & 31) * 16; asm volatile("" : "+v"(_w0)); LAS char* _w1 = _w0 + 8 * 8448; _Pragma("unroll") for (int it = 0; it < 8; ++it) { *(LAS u32x4*)(_w0 + it * 8448) = src[it]; *(LAS u32x4*)(_w1 + it * 8448) = src[it + 8]; } } while (0)
__device__ __forceinline__ void attn_phase(const Frame& F, int layer) {
    const bf16_t* Q = wsp<bf16_t>(F, WS_Q); const bf16_t* Km = wsp<bf16_t>(F, WS_KMAT) + (size_t)layer * NMEM * D; const bf16_t* Vt = wsp<bf16_t>(F, WS_VT) + (size_t)layer * D * NMEM;
    bf16_t* AO = wsp<bf16_t>(F, WS_AO);
    LAS bf16_t* Ks = (LAS bf16_t*)F.lds;
    const int tid = F.tid, lane = F.lane, wave = F.wave, l31 = lane & 31, lh = lane >> 5;
    constexpr int NU = BATCH * HEADS * (SEQ / 256);
    u32x4 Kr[16];
    if (F.c < NU) { const int bh = F.c & 31, b = bh >> 2, hd = bh & 3;
        ATT_LOAD16(Kr, Km + (size_t)(b * MEM + (tid >> 5)) * D + hd * HD + (tid & 31) * 8, 16 * D * 2); }
    for (int unit = F.c; unit < NU; unit += F.G) {
        const int bh = unit & 31, qt = unit >> 5, b = bh >> 2, hd = bh & 3;
        const size_t qrow = (size_t)b * SEQ + qt * 256 + wave * 32 + l31;
        bf16x8 Qf[16];
#pragma unroll
        for (int db = 0; db < 16; ++db) Qf[db] = *(const bf16x8*)(Q + qrow * D + hd * HD + db * 16 + lh * 8);
        __syncthreads();
        ATT_STORE16(Kr);
        ATT_LOAD16(Kr, Vt + (size_t)(hd * HD + (tid >> 5)) * NMEM + b * MEM + (tid & 31) * 8, 16 * NMEM * 2);
        __syncthreads();
        u32x4 sp[8][2];
        float mx = -3.0e38f;
#pragma unroll
        for (int kb = 0; kb < 8; ++kb) {
            f32x16 sc;
#pragma unroll
            for (int i = 0; i < 16; ++i) sc[i] = 0.f;
#pragma unroll
            for (int db = 0; db < 16; ++db) { const bf16x8 a = *(const LAS bf16x8*)(Ks + (kb * 32 + l31) * 264 + db * 16 + lh * 8); sc = MFMA32(a, Qf[db], sc); }
#pragma unroll
            for (int i = 0; i < 16; ++i) mx = fmaxf(mx, sc[i]);
#pragma unroll
            for (int hh = 0; hh < 2; ++hh) { sp[kb][hh].x = pk2(sc[8 * hh + 0], sc[8 * hh + 1]); sp[kb][hh].y = pk2(sc[8 * hh + 2], sc[8 * hh + 3]); sp[kb][hh].z = pk2(sc[8 * hh + 4], sc[8 * hh + 5]); sp[kb][hh].w = pk2(sc[8 * hh + 6], sc[8 * hh + 7]); }
        }
        mx = fmaxf(mx, __shfl_xor(mx, 32));
        float sum = 0.f;
        bf16x8 Pf[16];
#pragma unroll
        for (int kb = 0; kb < 8; ++kb)
#pragma unroll
            for (int hh = 0; hh < 2; ++hh) { f32x4 a, bq; unpack8(sp[kb][hh], a, bq);
#pragma unroll
                for (int i = 0; i < 4; ++i) { a[i] = fast_exp2((a[i] - mx) * 1.44269504f); bq[i] = fast_exp2((bq[i] - mx) * 1.44269504f); sum += a[i] + bq[i]; }
                Pf[kb * 2 + hh] = __builtin_bit_cast(bf16x8, pack8(a, bq)); }
        sum += __shfl_xor(sum, 32);
        const float inv = 1.0f / sum;
        __syncthreads();
        ATT_STORE16(Kr);
        if (unit + F.G < NU) { const int nbh = (unit + F.G) & 31, nb = nbh >> 2, nhd = nbh & 3;
            ATT_LOAD16(Kr, Km + (size_t)(nb * MEM + (tid >> 5)) * D + nhd * HD + (tid & 31) * 8, 16 * D * 2); }
        __syncthreads();
#pragma unroll
        for (int db = 0; db < 8; ++db) {
            f32x16 o;
#pragma unroll
            for (int i = 0; i < 16; ++i) o[i] = 0.f;
#pragma unroll
            for (int kk = 0; kk < 16; ++kk) { const LAS bf16_t* base = Ks + (db * 32 + l31) * 264 + kk * 16 + 4 * lh;
                const u32x2 lo = *(const LAS u32x2*)base, hi = *(const LAS u32x2*)(base + 8);
                u32x4 w; w.x = lo.x; w.y = lo.y; w.z = hi.x; w.w = hi.y;
                o = MFMA32(__builtin_bit_cast(bf16x8, w), Pf[kk], o); }
#pragma unroll
            for (int g4 = 0; g4 < 4; ++g4) {
                if (F8_QO) *(unsigned*)((unsigned char*)AO + qrow * D + hd * HD + db * 32 + 8 * g4 + 4 * lh) = pk4_fp8(o[4 * g4 + 0] * (inv * F8_AO_SCALE), o[4 * g4 + 1] * (inv * F8_AO_SCALE), o[4 * g4 + 2] * (inv * F8_AO_SCALE), o[4 * g4 + 3] * (inv * F8_AO_SCALE));
                else { u32x2 w; w.x = pk2(o[4 * g4 + 0] * inv, o[4 * g4 + 1] * inv); w.y = pk2(o[4 * g4 + 2] * inv, o[4 * g4 + 3] * inv); *(u32x2*)(AO + qrow * D + hd * HD + db * 32 + 8 * g4 + 4 * lh) = w; } }
        }
    }
    __syncthreads();
}

__device__ __forceinline__ void router_phase(const Frame& F, int layer, int j) {
    const bf16_t* h = wsp<bf16_t>(F, WS_H);
    unsigned* toke = (unsigned*)(F.ws + WS_META + MT_TOKE); float* tokw = (float*)(F.ws + WS_META + MT_TOKW); float* tokr = (float*)(F.ws + WS_META + MT_TOKR); int* wgcnt = (int*)(F.ws + WS_META + MT_WGCNT);
    LAS int* cnt = (LAS int*)(F.lds + LDS_AUX);
    const int lane = F.lane, wave = F.wave, tid = F.tid;
    float wr_[16][8];
    { const float* rw = F.in[I_RW] + (size_t)j * D * NE; const float* gg = F.in[I_NFG] + (size_t)layer * D;
#pragma unroll
      for (int kk = 0; kk < 16; ++kk) { const int k = lane * 16 + kk; const f32x4 a = *(const f32x4*)(rw + (size_t)k * NE), b = *(const f32x4*)(rw + (size_t)k * NE + 4); const float g = gg[k];
#pragma unroll
          for (int e = 0; e < 4; ++e) { wr_[kk][e] = a[e] * g; wr_[kk][4 + e] = b[e] * g; } } }
    float rb[8];
#pragma unroll
    for (int e = 0; e < 8; ++e) rb[e] = F.in[I_RB][j * NE + e];
    for (int chunk = F.c; chunk < T / 128; chunk += F.G) {
        __syncthreads();
        if (tid < 8) cnt[tid] = 0;
        __syncthreads();
        for (int i = 0; i < 16; ++i) {
            const int tok = chunk * 128 + wave * 16 + i;
            const u32x4 q0 = *(const u32x4*)(h + (size_t)tok * D + lane * 16), q1 = *(const u32x4*)(h + (size_t)tok * D + lane * 16 + 8);
            float x[16]; { f32x4 a, b, c, d; unpack8(q0, a, b); unpack8(q1, c, d);
#pragma unroll
                for (int e = 0; e < 4; ++e) { x[e] = a[e]; x[4 + e] = b[e]; x[8 + e] = c[e]; x[12 + e] = d[e]; } }
            float ss = 0.f, dt[8];
#pragma unroll
            for (int e = 0; e < 8; ++e) dt[e] = 0.f;
#pragma unroll
            for (int kk = 0; kk < 16; ++kk) { ss += x[kk] * x[kk];
#pragma unroll
                for (int e = 0; e < 8; ++e) dt[e] += x[kk] * wr_[kk][e]; }
            ss = wave_sum(ss);
#pragma unroll
            for (int e = 0; e < 8; ++e) dt[e] = wave_sum(dt[e]);
            const float r = __builtin_amdgcn_rsqf(ss * (1.f / D) + RMS_EPS);
            float v1 = -3.0e38f, v2 = -3.0e38f; int e1 = 0, e2 = 0;
#pragma unroll
            for (int e = 0; e < 8; ++e) { const float lg = dt[e] * r + rb[e]; if (lg > v1) { v2 = v1; e2 = e1; v1 = lg; e1 = e; } else if (lg > v2) { v2 = lg; e2 = e; } }
            const float w1 = 1.0f / (1.0f + __expf(v2 - v1)), w2 = 1.0f - w1;
            if (lane == 0) { toke[tok] = (unsigned)e1 | ((unsigned)e2 << 8); tokw[2 * tok] = w1; tokw[2 * tok + 1] = w2; tokr[tok] = r;
                atomicAdd((int*)&cnt[e1], 1); atomicAdd((int*)&cnt[e2], 1); }
        }
        __syncthreads();
        if (tid < 8) wgcnt[chunk * 8 + tid] = cnt[tid];
    }
    __syncthreads();
}
template <bool F8>
__device__ __forceinline__ void assign_phase(const Frame& F) {
    const bf16_t* h = wsp<bf16_t>(F, WS_H); bf16_t* hs = wsp<bf16_t>(F, WS_HS);
    const unsigned* toke = (const unsigned*)(F.ws + WS_META + MT_TOKE); const float* tokw = (const float*)(F.ws + WS_META + MT_TOKW); const float* tokr = (const float*)(F.ws + WS_META + MT_TOKR);
    int* tokslot = (int*)(F.ws + WS_META + MT_TOKSLOT); float* rscale = (float*)(F.ws + WS_META + MT_RSCALE); float* gwt = (float*)(F.ws + WS_META + MT_GWT);
    const int* wgcnt = (const int*)(F.ws + WS_META + MT_WGCNT); int* pexp = (int*)(F.ws + WS_META + MT_PEXP); unsigned* ctl = (unsigned*)(F.ws + WS_CTL);
    LAS int* cl = (LAS int*)(F.lds);
    LAS int* tot = (LAS int*)(F.lds + 8192);
    LAS int* sl = (LAS int*)(F.lds + 8192 + 256);
    const int tid = F.tid, lane = F.lane, wave = F.wave;
    for (int chunk = F.c; chunk < T / 128; chunk += F.G) {
        __syncthreads();
        for (int i = tid; i < 2048; i += 512) cl[i] = wgcnt[i];
        __syncthreads();
        if (tid < 8) { int s = 0, pre = 0; for (int q = 0; q < 256; ++q) { if (q == chunk) pre = s; s += cl[q * 8 + tid]; } tot[tid] = s; tot[8 + tid] = pre; }
        __syncthreads();
        if (tid == 0) { int base = 0; for (int e = 0; e < 8; ++e) { tot[16 + e] = base; tot[24 + e] = base + tot[8 + e]; base += (tot[e] + 255) & ~255; }
            if (chunk == 0) { ctl[CW_PTOTAL] = (unsigned)(base >> 8); int pp = 0; for (int e = 0; e < 8; ++e) { ctl[CW_PBASE + e] = (unsigned)(tot[16 + e] >> 8); const int np = (tot[e] + 255) >> 8; for (int q = 0; q < np; ++q) pexp[pp++] = e; } } }
        __syncthreads();
        if (chunk == 0) {
            for (int e = 0; e < 8; ++e) { const int lo = tot[16 + e] + tot[e], hi = tot[16 + e] + ((tot[e] + 255) & ~255);
                for (int s = lo + tid; s < hi; s += 512) { rscale[s] = 0.f; gwt[s] = 0.f; } } }
        if (wave == 0) {
            for (int it = 0; it < 2; ++it) { const int li = it * 64 + lane, tok = chunk * 128 + li; const unsigned ee = toke[tok]; const int e1 = ee & 255, e2 = (ee >> 8) & 255; int s1 = 0, s2 = 0;
                const unsigned long long ltmask = (1ull << lane) - 1ull;
#pragma unroll
                for (int e = 0; e < 8; ++e) { const unsigned long long m1 = __ballot(e1 == e), m2 = __ballot(e2 == e); const int off = tot[24 + e];
                    if (e1 == e) s1 = off + __popcll(m1 & ltmask);
                    if (e2 == e) s2 = off + __popcll(m1) + __popcll(m2 & ltmask);
                    __builtin_amdgcn_s_waitcnt(0);
                    if (lane == 0) tot[24 + e] = off + __popcll(m1) + __popcll(m2);
                    __builtin_amdgcn_s_waitcnt(0); }
                sl[li * 2] = s1; sl[li * 2 + 1] = s2; tokslot[2 * tok] = s1; tokslot[2 * tok + 1] = s2;
                const float r = tokr[tok]; rscale[s1] = r; rscale[s2] = r; gwt[s1] = tokw[2 * tok]; gwt[s2] = tokw[2 * tok + 1]; }
        }
        __syncthreads();
        for (int q = wave; q < 256; q += 8) { const int li = q >> 1, tok = chunk * 128 + li, s = sl[q];
            const u32x4 a = *(const u32x4*)(h + (size_t)tok * D + lane * 16), b = *(const u32x4*)(h + (size_t)tok * D + lane * 16 + 8);
            if (F8) { f32x4 x0, x1, x2, x3; unpack8(a, x0, x1); unpack8(b, x2, x3); u32x4 o8; o8.x = pk4_fp8(x0[0], x0[1], x0[2], x0[3]); o8.y = pk4_fp8(x1[0], x1[1], x1[2], x1[3]); o8.z = pk4_fp8(x2[0], x2[1], x2[2], x2[3]); o8.w = pk4_fp8(x3[0], x3[1], x3[2], x3[3]);
                *(u32x4*)((unsigned char*)hs + (size_t)s * D + lane * 16) = o8; }
            else { *(u32x4*)(hs + (size_t)s * D + lane * 16) = a; *(u32x4*)(hs + (size_t)s * D + lane * 16 + 8) = b; } }
    }
    __syncthreads();
}
__device__ __forceinline__ void combine_phase(const Frame& F, bool final_) {
    bf16_t* h = wsp<bf16_t>(F, WS_H); const bf16_t* ye = wsp<bf16_t>(F, WS_YE); const int* tokslot = (const int*)(F.ws + WS_META + MT_TOKSLOT); float* st = wsp<float>(F, WS_STATS);
    const int gw = F.c * 8 + F.wave, NGW = F.G * 8, lane = F.lane;
    for (int tok = gw; tok < T; tok += NGW) {
        const int s1 = tokslot[2 * tok], s2 = tokslot[2 * tok + 1];
        f32x4 x[4], y[4], z[4];
        unpack8(*(const u32x4*)(h + (size_t)tok * D + lane * 16), x[0], x[1]); unpack8(*(const u32x4*)(h + (size_t)tok * D + lane * 16 + 8), x[2], x[3]);
        unpack8(*(const u32x4*)(ye + (size_t)s1 * D + lane * 16), y[0], y[1]); unpack8(*(const u32x4*)(ye + (size_t)s1 * D + lane * 16 + 8), y[2], y[3]);
        unpack8(*(const u32x4*)(ye + (size_t)s2 * D + lane * 16), z[0], z[1]); unpack8(*(const u32x4*)(ye + (size_t)s2 * D + lane * 16 + 8), z[2], z[3]);
        float ss = 0.f;
#pragma unroll
        for (int q = 0; q < 4; ++q) { x[q] = x[q] + y[q] + z[q]; ss += (x[q][0] * x[q][0] + x[q][1] * x[q][1]) + (x[q][2] * x[q][2] + x[q][3] * x[q][3]); }
        ss = wave_sum(ss);
        if (final_) { const float r = __builtin_amdgcn_rsqf(ss * (1.f / D) + RMS_EPS); const f32x4* gp = (const f32x4*)(F.in[I_FINALG] + lane * 16); f32x4* op = (f32x4*)(F.out + (size_t)tok * D + lane * 16);
#pragma unroll
            for (int q = 0; q < 4; ++q) op[q] = x[q] * r * gp[q]; }
        else { *(u32x4*)(h + (size_t)tok * D + lane * 16) = pack8(x[0], x[1]); *(u32x4*)(h + (size_t)tok * D + lane * 16 + 8) = pack8(x[2], x[3]);
            if (F8_GATES) { u32x4 o8; o8.x = pk4_fp8(x[0][0], x[0][1], x[0][2], x[0][3]); o8.y = pk4_fp8(x[1][0], x[1][1], x[1][2], x[1][3]); o8.z = pk4_fp8(x[2][0], x[2][1], x[2][2], x[2][3]); o8.w = pk4_fp8(x[3][0], x[3][1], x[3][2], x[3][3]); *(u32x4*)(F.ws + WS_H8 + (size_t)tok * D + lane * 16) = o8; }
            if (lane < 4) st[(size_t)tok * 4 + lane] = (lane == 0) ? ss : 0.f; }
    }
}

struct SchedKV {
    int G, c; const char* memn; const char* wkv;
    __device__ __forceinline__ bool next(int i, Unit& u) const { const int L = i * G + c; if (L >= 256) return false; const int layer = L >> 6, r = L & 63; const char* w = wkv + (size_t)layer * 2 * D * D * 2;
        if (r < 32) { u.pm = r >> 2; u.pn = r & 3; u.tag = layer * 2; u.A = memn + (size_t)u.pm * 256 * D * 2; u.B = w + (size_t)u.pn * 256 * D * 2; }
        else { const int q = r - 32; u.pm = q >> 3; u.pn = q & 7; u.tag = layer * 2 + 1; u.A = w + (size_t)(D + u.pm * 256) * D * 2; u.B = memn + (size_t)u.pn * 256 * D * 2; }
        return true; }
    __device__ __forceinline__ void a_ready(const Unit&) const {}
    __device__ __forceinline__ void done(const Unit&) const {}
};
struct SchedMoe {
    pg8::StaticOrder o; const char* A; const char* B; size_t sA, sB, sE; int pb1, pb2, pb3, pb4, pb5, pb6, pb7;
    __device__ __forceinline__ void load_bases(const unsigned* ctl) {
        pb1 = __builtin_amdgcn_readfirstlane((int)ctl[CW_PBASE + 1]); pb2 = __builtin_amdgcn_readfirstlane((int)ctl[CW_PBASE + 2]); pb3 = __builtin_amdgcn_readfirstlane((int)ctl[CW_PBASE + 3]); pb4 = __builtin_amdgcn_readfirstlane((int)ctl[CW_PBASE + 4]);
        pb5 = __builtin_amdgcn_readfirstlane((int)ctl[CW_PBASE + 5]); pb6 = __builtin_amdgcn_readfirstlane((int)ctl[CW_PBASE + 6]); pb7 = __builtin_amdgcn_readfirstlane((int)ctl[CW_PBASE + 7]); }
    __device__ __forceinline__ bool next(int i, Unit& u) const { int pm, pn; if (!o.next(i, pm, pn)) return false;
        const int e = (pm >= pb1) + (pm >= pb2) + (pm >= pb3) + (pm >= pb4) + (pm >= pb5) + (pm >= pb6) + (pm >= pb7);
        u.pm = pm; u.pn = pn; u.tag = 0; u.A = A + (size_t)pm * sA; u.B = B + (size_t)e * sE + (size_t)pn * sB; return true; }
    __device__ __forceinline__ void a_ready(const Unit&) const {}
    __device__ __forceinline__ void done(const Unit&) const {}
};

constexpr int NPH_LAYER = 13, PH_LAYER0 = 2, NPHASES = PH_LAYER0 + DEPTH * NPH_LAYER;
extern __shared__ __attribute__((aligned(16))) unsigned char lds_raw[];
struct PA { unsigned char* ws; const float* const* in; float* out; int layer; };
__device__ __forceinline__ unsigned long long uni64(unsigned long long v) { const unsigned lo = __builtin_amdgcn_readfirstlane((unsigned)v), hi = __builtin_amdgcn_readfirstlane((unsigned)(v >> 32)); return ((unsigned long long)hi << 32) | lo; }
__device__ __forceinline__ Frame mkframe(const PA a) {
    Frame P; P.lds = (LAS unsigned char*)lds_raw; P.tid = threadIdx.x; asm volatile("" : "+v"(P.tid)); P.lane = P.tid & 63; P.wave = __builtin_amdgcn_readfirstlane(P.tid >> 6); P.c = blockIdx.x; P.G = gridDim.x;
    P.ws = a.ws; P.in = a.in; P.out = a.out; return P;
}
#define ST_A (wsp<float>(P, WS_STATS))
#define ST_B (wsp<float>(P, WS_STATS) + (size_t)T * 16)
#define ST_C (wsp<float>(P, WS_STATS) + (size_t)T * 32)
#define H_ (wsp<bf16_t>(P, WS_H))
#define PH_HEAD const Frame P = mkframe(a); const int layer = a.layer, c = P.c, G = P.G, jj = layer >> 1; LAS unsigned char* lds = P.lds; (void)layer; (void)c; (void)G; (void)jj; (void)lds;

__device__ __forceinline__ void ph_prologue(const PA a) { PH_HEAD prologue(P); }
__device__ __forceinline__ void ph_kv(const PA a) { PH_HEAD
    SchedKV S{G, c, (const char*)wsp<bf16_t>(P, WS_MEMN), (const char*)wsp<bf16_t>(P, WS_WKV)};
    EpiPlain E{wsp<bf16_t>(P, WS_KMAT), wsp<bf16_t>(P, WS_VT), D, NMEM, (size_t)NMEM * D, (size_t)D * NMEM};
    pg8::gemm_phase<EpiPlain, SchedKV, false, true>(lds, D, D, D, S, E, (const char*)P.ws);
}
__device__ __forceinline__ void ph_inproj(const PA a) { PH_HEAD
    pg8::SchedStd S; S.o.init(T / 256, (F8_GATES ? 1536 : INC) / 256, G, c); S.A = (const char*)H_; S.B = (const char*)(wsp<bf16_t>(P, WS_WIN) + (size_t)layer * INC * D); S.sA = (size_t)256 * D * 2; S.sB = (size_t)256 * D * 2;
    EpiInproj E{ST_A, wsp<bf16_t>(P, WS_UCONV), wsp<bf16_t>(P, WS_XU), wsp<bf16_t>(P, WS_GATES)};
    pg8::gemm_phase<EpiInproj, pg8::SchedStd, true, true>(lds, D, D, D, S, E, (const char*)P.ws);
}
__device__ __forceinline__ void ph_inproj_gates(const PA a) { PH_HEAD
    pg8::SchedStd S; S.o.init(T / 256, 2048 / 256, G, c); S.A = (const char*)wsp<unsigned char>(P, WS_H8); S.B = (const char*)(wsp<bf16_t>(P, WS_WIN) + (size_t)layer * INC * D + (size_t)1536 * D); S.sA = (size_t)256 * D; S.sB = (size_t)256 * D;
    EpiGates E{ST_A, wsp<bf16_t>(P, WS_GATES), 1.0f / F8_WGU_SCALE};
    pg8::gemm_phase<EpiGates, pg8::SchedStd, true, true, true>(lds, D, D, D, S, E, (const char*)P.ws);
}
__device__ __forceinline__ void ph_conv(const PA a) { PH_HEAD conv_phase(P, layer); }
__device__ __forceinline__ void ph_ssm1(const PA a) { PH_HEAD
    if (c < BATCH * NG) {
        const int unit = c, g = (unit & 7) * 4 + ((unit >> 3) & 3), b = unit >> 5, ug = b * NG + g;
        bf16_t* xu = wsp<bf16_t>(P, WS_XU) + (size_t)ug * 256 * 384;
        pg8::SchedOne S; S.u0.pm = 0; S.u0.pn = 0; S.u0.tag = 0; S.u0.A = (const char*)xu; S.u0.B = (const char*)(wsp<bf16_t>(P, WS_WST) + (size_t)(layer * NG + g) * 256 * 256);
        EpiSsm1 E{wsp<float>(P, WS_A16) + (size_t)(layer * NG + g) * 128, xu};
        pg8::gemm_phase<EpiSsm1, pg8::SchedOne, false, true>(lds, 256, 384, 256, S, E, (const char*)P.ws);
        VM_WAIT(); __syncthreads(); __builtin_amdgcn_fence(__ATOMIC_ACQUIRE, "agent"); VM_WAIT(); __syncthreads();
    }
}
__device__ __forceinline__ void ph_ssm2(const PA a) { PH_HEAD
    if (c < BATCH * NG) {
        const int unit = c, g = (unit & 7) * 4 + ((unit >> 3) & 3), b = unit >> 5, ug = b * NG + g;
        bf16_t* xu = wsp<bf16_t>(P, WS_XU) + (size_t)ug * 256 * 384;
        pg8::SchedOne S; S.u0.pm = 0; S.u0.pn = 0; S.u0.tag = 0; S.u0.A = (const char*)xu; S.u0.B = (const char*)(wsp<bf16_t>(P, WS_TW) + (size_t)(layer * NG + g) * 256 * 384);
        EpiSsm2 E{wsp<bf16_t>(P, WS_YS), b, g};
        pg8::gemm_phase<EpiSsm2, pg8::SchedOne, false, true>(lds, 384, 384, 384, S, E, (const char*)P.ws);
        __syncthreads();
    }
}
__device__ __forceinline__ void ph_zpw(const PA a) { PH_HEAD
    SchedZPW S; S.o.init(T / 256, D / 256, G, c); S.ys = (const char*)wsp<bf16_t>(P, WS_YS); S.uc = (const char*)wsp<bf16_t>(P, WS_UC);
    S.wglu = (const char*)(wsp<bf16_t>(P, WS_WGLU) + (size_t)layer * 2 * D * SW); S.wpw = (const char*)(wsp<bf16_t>(P, WS_WPW) + (size_t)layer * D * CW);
    EpiZPW E{EpiZ{wsp<bf16_t>(P, WS_GATES), wsp<bf16_t>(P, WS_MB)}, EpiPw{wsp<bf16_t>(P, WS_GATES), wsp<bf16_t>(P, WS_MB), wsp<bf16_t>(P, WS_MERGED)}};
    pg8::gemm_phase<EpiZPW, SchedZPW, true, true>(lds, SW, SW, SW, S, E, (const char*)P.ws);
}
template <bool H8OUT> __device__ __forceinline__ void ph_res_out(const PA a) { PH_HEAD
    pg8::SchedStd S; S.o.init(T / 256, D / 256, G, c); S.A = (const char*)wsp<bf16_t>(P, WS_MERGED); S.B = (const char*)(wsp<bf16_t>(P, WS_WOUT) + (size_t)layer * D * D); S.sA = (size_t)256 * D * 2; S.sB = (size_t)256 * D * 2;
    EpiRes<H8OUT, false> E{H_, ST_B, H_, wsp<unsigned char>(P, WS_H8), lds};
    pg8::gemm_phase<EpiRes<H8OUT, false>, pg8::SchedStd, true, true>(lds, D, D, D, S, E, (const char*)P.ws);
}
template <bool H8OUT> __device__ __forceinline__ void ph_res_o(const PA a) { PH_HEAD
    constexpr bool F8 = F8_QO != 0; constexpr int ES = F8 ? 1 : 2;
    pg8::SchedStd S; S.o.init(T / 256, D / 256, G, c); S.A = (const char*)wsp<bf16_t>(P, WS_AO); S.B = (const char*)(wsp<bf16_t>(P, WS_WO) + (size_t)layer * D * D); S.sA = (size_t)256 * D * ES; S.sB = (size_t)256 * D * ES;
    EpiRes<H8OUT, F8> E{H_, ST_C, H_, wsp<unsigned char>(P, WS_H8), lds};
    pg8::gemm_phase<EpiRes<H8OUT, F8>, pg8::SchedStd, true, true, F8>(lds, D, D, D, S, E, (const char*)P.ws);
}
struct SchedQ {
    int G, c; const char* h; const char* wq; int es;
    __device__ __forceinline__ bool next(int i, Unit& u) const { const int L = i * G + c; if (L >= BATCH * HEADS * (SEQ / 256)) return false; const int bh = L & 31, qt = L >> 5, b = bh >> 2, hd = bh & 3;
        u.pm = b * 16 + qt; u.pn = hd; u.tag = 0; u.A = h + (size_t)u.pm * 256 * D * es; u.B = wq + (size_t)hd * 256 * D * es; return true; }
    __device__ __forceinline__ void a_ready(const Unit&) const {}
    __device__ __forceinline__ void done(const Unit&) const {}
};
__device__ __forceinline__ void ph_q(const PA a) { PH_HEAD
    constexpr bool F8 = F8_QO != 0;
    SchedQ S{G, c, F8 ? (const char*)wsp<unsigned char>(P, WS_H8) : (const char*)H_, (const char*)(wsp<bf16_t>(P, WS_WQ) + (size_t)layer * D * D), F8 ? 1 : 2};
    EpiQ E{ST_B, wsp<bf16_t>(P, WS_Q), F8 ? 1.0f / F8_WQ_SCALE : 1.0f};
    pg8::gemm_phase<EpiQ, SchedQ, true, true, F8>(lds, D, D, D, S, E, (const char*)P.ws);
    VM_WAIT(); __syncthreads();
}
__device__ __forceinline__ void ph_attn(const PA a) { PH_HEAD attn_phase(P, layer); }
template <bool F8> __device__ __forceinline__ void ph_fgu(const PA a) { PH_HEAD
    constexpr int ES = F8 ? 1 : 2;
    pg8::SchedStd S; S.o.init(T / 256, 2 * DFF / 256, G, c); S.A = F8 ? (const char*)wsp<unsigned char>(P, WS_H8) : (const char*)H_; S.B = (const char*)(wsp<bf16_t>(P, WS_WFGU) + (size_t)jj * 2 * DFF * D); S.sA = (size_t)256 * D * ES; S.sB = (size_t)256 * D * ES;
    EpiGU<false, F8> E{ST_C, nullptr, wsp<bf16_t>(P, WS_ACT), DFF};
    pg8::gemm_phase<EpiGU<false, F8>, pg8::SchedStd, true, true, F8>(lds, D, D, D, S, E, (const char*)P.ws);
}
template <bool F8> __device__ __forceinline__ void ph_fdown(const PA a, const bool dry = false) { PH_HEAD
    constexpr int ES = F8 ? 1 : 2;
    pg8::SchedStd S; S.o.init(T / 256, D / 256, G, c); S.A = (const char*)wsp<bf16_t>(P, WS_ACT); S.B = (const char*)(wsp<bf16_t>(P, WS_WFD) + (size_t)jj * D * DFF); S.sA = (size_t)256 * DFF * ES; S.sB = (size_t)256 * DFF * ES;
    EpiRes<(F8_GATES != 0), F8> E{H_, dry ? wsp<float>(P, WS_UCONV) : ST_A, dry ? wsp<bf16_t>(P, WS_Q) : H_, wsp<unsigned char>(P, WS_H8), lds};
    pg8::gemm_phase<EpiRes<(F8_GATES != 0), F8>, pg8::SchedStd, true, true, F8>(lds, DFF, DFF, DFF, S, E, (const char*)P.ws);
}
__device__ __forceinline__ void ph_router(const PA a) { PH_HEAD router_phase(P, layer, jj); }
template <bool F8> __device__ __forceinline__ void ph_assign(const PA a) { PH_HEAD assign_phase<F8>(P); }
template <bool F8> __device__ __forceinline__ void ph_mgu(const PA a) { PH_HEAD
    constexpr int ES = F8 ? 1 : 2;
    const int ptot = (int)__hip_atomic_load((unsigned*)(P.ws + WS_CTL) + CW_PTOTAL, __ATOMIC_RELAXED, __HIP_MEMORY_SCOPE_AGENT);
    SchedMoe S; S.o.init(__builtin_amdgcn_readfirstlane(ptot), 2 * DFE / 256, G, c); S.A = (const char*)wsp<bf16_t>(P, WS_HS); S.B = (const char*)(wsp<bf16_t>(P, WS_WMGU) + (size_t)jj * NE * 2 * DFE * D);
    S.sA = (size_t)256 * D * ES; S.sB = (size_t)256 * D * ES; S.sE = (size_t)2 * DFE * D * ES; S.load_bases((const unsigned*)(P.ws + WS_CTL));
    EpiGU<true, F8> E{(const float*)(P.ws + WS_META + MT_RSCALE), (const float*)(P.ws + WS_META + MT_GWT), wsp<bf16_t>(P, WS_ACT), DFE};
    pg8::gemm_phase<EpiGU<true, F8>, SchedMoe, true, true, F8>(lds, D, D, D, S, E, (const char*)P.ws);
}
template <bool F8> __device__ __forceinline__ void ph_mdown(const PA a) { PH_HEAD
    constexpr int ES = F8 ? 1 : 2;
    const int ptot = (int)__hip_atomic_load((unsigned*)(P.ws + WS_CTL) + CW_PTOTAL, __ATOMIC_RELAXED, __HIP_MEMORY_SCOPE_AGENT);
    SchedMoe S; S.o.init(__builtin_amdgcn_readfirstlane(ptot), D / 256, G, c); S.A = (const char*)wsp<bf16_t>(P, WS_ACT); S.B = (const char*)(wsp<bf16_t>(P, WS_WMD) + (size_t)jj * NE * D * DFE);
    S.sA = (size_t)256 * DFE * ES; S.sB = (size_t)256 * DFE * ES; S.sE = (size_t)D * DFE * ES; S.load_bases((const unsigned*)(P.ws + WS_CTL));
    EpiPlain E{wsp<bf16_t>(P, WS_YE), wsp<bf16_t>(P, WS_YE), D, D, 0, 0, F8 ? 1.0f / (F8_WD_SCALE * F8_ACT_SCALE) : 1.0f};
    pg8::gemm_phase<EpiPlain, SchedMoe, true, true, F8>(lds, DFE, DFE, DFE, S, E, (const char*)P.ws);
}
__device__ __forceinline__ void ph_combine(const PA a) { PH_HEAD combine_phase(P, layer == DEPTH - 1); }

__global__ void __launch_bounds__(512, 2) fwd(Args args) {
    LAS unsigned char* lds = (LAS unsigned char*)lds_raw;
    volatile LAS unsigned* MISC = (volatile LAS unsigned*)(lds + LDS_MISC);
    if (threadIdx.x < 32) MISC[threadIdx.x] = 0u;
    __syncthreads();
    const int lo = args.ph_lo, hi = args.ph_hi;
    unsigned* barw = (unsigned*)(args.ws + WS_CTL) + CW_BAR;
    XcdBarrier bar; bar.bar = barw; bar.x = 0; bar.st = MISC + 8;
    if (hi - lo > 1) bar = xcd_barrier_post(barw, MISC + 8);
#ifndef PROBE_DUP
#define PROBE_DUP 0
#endif
#define DUPB(b) ((PROBE_DUP >> (b)) & 1)
#define IN(k) (lo <= (k) && (k) < hi)
#define SEAM(k) do { if (IN(k) && IN((k) + 1)) { xcd_barrier(bar); if (DUPB(16)) xcd_barrier(bar); } } while (0)
    PA a; a.ws = args.ws; a.in = args.in; a.out = args.out; a.layer = 0;
    if (IN(0)) { ph_prologue(a); if (DUPB(0)) ph_prologue(a); } SEAM(0);
    if (IN(1)) { ph_kv(a); if (DUPB(1)) ph_kv(a); } SEAM(1);
#define LAYER_BODY(LYR) { \
        constexpr int layer = (LYR), pb = PH_LAYER0 + layer * NPH_LAYER; a.layer = layer; \
        if (IN(pb + 0)) { ph_inproj(a); if (F8_GATES) ph_inproj_gates(a); } SEAM(pb + 0); \
        if (IN(pb + 1)) { ph_conv(a); ph_ssm1(a); ph_ssm2(a); if (DUPB(3)) { ph_conv(a); ph_ssm1(a); ph_ssm2(a); } if (DUPB(11)) ph_conv(a); if (DUPB(12)) { ph_ssm1(a); ph_ssm2(a); } if (DUPB(13)) ph_ssm1(a); } SEAM(pb + 1); \
        if (IN(pb + 2)) { ph_zpw(a); if (DUPB(4)) ph_zpw(a); } SEAM(pb + 2); SEAM(pb + 3); \
        if (IN(pb + 4)) { ph_res_out<(F8_QO != 0)>(a); } SEAM(pb + 4); \
        if (IN(pb + 5)) { ph_q(a); ph_attn(a); if (DUPB(5)) { ph_q(a); ph_attn(a); } } SEAM(pb + 5); SEAM(pb + 6); \
        if (IN(pb + 7)) { ph_res_o<F8_DENSE(layer)>(a); } SEAM(pb + 7); \
        if ((layer & 1) == 0) { \
            if (IN(pb + 8)) { ph_fgu<F8_DENSE(layer)>(a); } SEAM(pb + 8); \
            if (IN(pb + 9)) { ph_fdown<F8_DENSE(layer)>(a); } do { if (IN(pb + 9) && IN(pb + 13)) xcd_barrier(bar); } while (0);     \
        } else { \
            if (IN(pb + 8)) { ph_router(a); if (DUPB(8)) ph_router(a); } SEAM(pb + 8); \
            if (IN(pb + 9)) { ph_assign<F8_MOE(layer)>(a); } SEAM(pb + 9); \
            if (IN(pb + 10)) { ph_mgu<F8_MOE(layer)>(a); } SEAM(pb + 10); \
            if (IN(pb + 11)) { ph_mdown<F8_MOE(layer)>(a); } SEAM(pb + 11); \
            if (IN(pb + 12)) ph_combine(a); SEAM(pb + 12); \
        } }
    LAYER_BODY(0) LAYER_BODY(1) LAYER_BODY(2) LAYER_BODY(3)
#undef LAYER_BODY
#undef IN
#undef SEAM
}

extern "C" void kernel_launch(void* const* d_in, const int* in_sizes, int n_in, void* d_out, int out_size, void* d_ws, size_t ws_size, hipStream_t stream) {
    static int grid = 0;
    if (grid == 0) {
        if (n_in != 32 || out_size != T * D || ws_size < WS_END) { fprintf(stderr, "kernel_launch: unexpected problem (n_in %d out %d ws %zu need %zu)\n", n_in, out_size, ws_size, (size_t)WS_END); grid = -1; return; }
        int dev = 0, cus = 0, per_cu = 0;
        if (hipGetDevice(&dev) != hipSuccess || hipDeviceGetAttribute(&cus, hipDeviceAttributeMultiprocessorCount, dev) != hipSuccess) { grid = -1; return; }
        if (hipFuncSetAttribute((const void*)fwd, hipFuncAttributeMaxDynamicSharedMemorySize, LDS_BYTES) != hipSuccess) { fprintf(stderr, "kernel_launch: hipFuncSetAttribute failed\n"); grid = -1; return; }
        if (hipOccupancyMaxActiveBlocksPerMultiprocessor(&per_cu, (const void*)fwd, 512, LDS_BYTES) != hipSuccess || per_cu < 1) { fprintf(stderr, "kernel_launch: occupancy query says %d\n", per_cu); }
        (void)hipGetLastError();
        grid = cus < 256 ? cus : 256;
    }
    if (grid < 0) return;
    if (hipMemsetAsync((char*)d_ws + WS_CTL, 0, CTL_BYTES, stream) != hipSuccess) return;
    Args a{};
    for (int i = 0; i < 32; ++i) a.in[i] = (const float*)d_in[i];
    a.out = (float*)d_out; a.ws = (unsigned char*)d_ws;
#if MK_ONE_LAUNCH
    a.ph_lo = 0; a.ph_hi = NPHASES;
    hipLaunchKernelGGL(fwd, dim3(grid), dim3(512), LDS_BYTES, stream, a);
#else
    for (int p = 0; p < NPHASES; ++p) {
        if (p >= PH_LAYER0) { const int layer = (p - PH_LAYER0) / NPH_LAYER, k = (p - PH_LAYER0) % NPH_LAYER; if ((layer & 1) == 0 && k >= 10) continue; }
        a.ph_lo = p; a.ph_hi = p + 1;
        hipLaunchKernelGGL(fwd, dim3(grid), dim3(512), LDS_BYTES, stream, a);
    }
#endif
}
```

```cpp
#include <hip/hip_runtime.h>
#include <cstdio>
#include <cstdint>

#ifndef MK_ONE_LAUNCH
#define MK_ONE_LAUNCH 1
#endif

#define GAS __attribute__((address_space(1)))
#define LAS __attribute__((address_space(3)))
typedef unsigned short bf16_t;
typedef short bf16x8 __attribute__((ext_vector_type(8)));
typedef float f32x4 __attribute__((ext_vector_type(4)));
typedef float f32x2 __attribute__((ext_vector_type(2)));
typedef float f32x16 __attribute__((ext_vector_type(16)));
typedef unsigned u32x4 __attribute__((ext_vector_type(4)));
typedef unsigned u32x2 __attribute__((ext_vector_type(2)));
typedef __bf16 bf2_t __attribute__((ext_vector_type(2)));

constexpr int D = 1024, BATCH = 8, SEQ = 4096, T = BATCH * SEQ, DEPTH = 4, MEM = 256, NMEM = BATCH * MEM;
constexpr int CW = 512, CK = 31, SW = 512, SG = 16, NG = 32, SP = 64, HEADS = 4, HD = 256;
constexpr int DFF = 2816, NE = 8, DFE = 3584, INC = 3584;
constexpr int NSLOT = 2 * T + NE * 256;
constexpr float RMS_EPS = 1e-6f, LN_EPS = 1e-5f;

constexpr size_t MiB = 1u << 20;
constexpr size_t WS_CTL = 0, CTL_BYTES = 1 * MiB;
constexpr size_t WS_A16 = 1 * MiB;
constexpr size_t WS_META = 2 * MiB;
constexpr size_t WS_STATS = 4 * MiB;
constexpr size_t WS_MEMN = 10 * MiB, WS_KMAT = 14 * MiB, WS_VT = 30 * MiB, WS_H = 46 * MiB;
constexpr size_t WS_WIN = 110 * MiB, WS_WPW = 138 * MiB, WS_WGLU = 142 * MiB, WS_WOUT = 150 * MiB, WS_WQ = 158 * MiB, WS_WKV = 166 * MiB, WS_WO = 182 * MiB;
constexpr size_t WS_WFGU = 190 * MiB, WS_WFD = 212 * MiB, WS_WMGU = 224 * MiB, WS_WMD = 448 * MiB, WS_WST = 560 * MiB, WS_TW = 576 * MiB;
constexpr size_t WS_R = 600 * MiB;
constexpr size_t WS_UCONV = WS_R, WS_XU = WS_R + 32 * MiB, WS_GATES = WS_R + 80 * MiB, WS_UC = WS_R + 208 * MiB, WS_YS = WS_R + 240 * MiB;
constexpr size_t WS_MB = WS_R + 272 * MiB, WS_MERGED = WS_R + 336 * MiB, WS_Q = WS_R + 400 * MiB, WS_AO = WS_R + 464 * MiB;
constexpr size_t WS_H8 = WS_R + 300 * MiB;
constexpr size_t WS_ACT = WS_R, WS_HS = WS_R + 462 * MiB, WS_YE = WS_R + 594 * MiB, WS_END = WS_R + 726 * MiB;
static_assert((size_t)NSLOT * DFE * 2 <= 462 * MiB && (size_t)NSLOT * D * 2 <= 132 * MiB, "moe buffers");
constexpr size_t MT_TOKE = 0, MT_TOKW = 128 * 1024, MT_TOKR = 384 * 1024, MT_TOKSLOT = 512 * 1024, MT_RSCALE = 768 * 1024, MT_GWT = 1088 * 1024, MT_WGCNT = 1408 * 1024, MT_PEXP = 1424 * 1024;
constexpr int CW_PTOTAL = 16, CW_PBASE = 32;
constexpr int CW_BAR = 4096;

constexpr int LDS_AUX = 131072;
constexpr int LDS_MISC = 131072 + 8192;
constexpr int LDS_BYTES = 147456;

#ifndef F8_MOE_MASK
#define F8_MOE_MASK 0xA
#endif
#define F8_MOE(l) (((F8_MOE_MASK >> (l)) & 1) != 0)
#ifndef F8_QO
#define F8_QO 1
#endif
#ifndef F8_GATES
#define F8_GATES 1
#endif
#ifndef F8_DENSE_MASK
#define F8_DENSE_MASK 0x4
#endif
#define F8_DENSE(l) (((F8_DENSE_MASK >> (l)) & 1) != 0)
__device__ __forceinline__ unsigned pk2(float lo, float hi) { f32x2 v = {lo, hi}; bf2_t r = __builtin_convertvector(v, bf2_t); return __builtin_bit_cast(unsigned, r); }
__device__ __forceinline__ float bflo(unsigned u) { return __uint_as_float(u << 16); }
__device__ __forceinline__ float bfhi(unsigned u) { return __uint_as_float(u & 0xffff0000u); }
__device__ __forceinline__ float fast_rcp(float x) { return __builtin_amdgcn_rcpf(x); }
__device__ __forceinline__ float fast_exp2(float x) { return __builtin_amdgcn_exp2f(x); }
__device__ __forceinline__ float sigmoidf_(float x) { return fast_rcp(1.0f + fast_exp2(-1.44269504f * x)); }
__device__ __forceinline__ float siluf_(float x) { return x * sigmoidf_(x); }
__device__ __forceinline__ float gelu_tanh_(float x) { const float z = 0.7978845608f * (x + 0.044715f * x * x * x); return x * fast_rcp(1.0f + fast_exp2(-2.88539008f * z)); }
__device__ __forceinline__ float wave_sum(float v) {
#pragma unroll
    for (int o = 1; o < 64; o <<= 1) v += __shfl_xor(v, o);
    return v;
}
__device__ __forceinline__ float row_rstd(const float* stats, int row) {
    const f32x4 a = *(const f32x4*)(stats + (size_t)row * 4);
    return __builtin_amdgcn_rsqf(((a[0] + a[1]) + (a[2] + a[3])) * (1.0f / D) + RMS_EPS);
}
__device__ __forceinline__ unsigned pk4_fp8(float a, float b, float c, float d) { int w = 0; w = __builtin_amdgcn_cvt_pk_fp8_f32(a, b, w, false); w = __builtin_amdgcn_cvt_pk_fp8_f32(c, d, w, true); return (unsigned)w; }
constexpr float F8_WGU_SCALE = 32.f, F8_WD_SCALE = 64.f, F8_ACT_SCALE = 4.f, F8_WQ_SCALE = 512.f, F8_WO_SCALE = 32.f, F8_AO_SCALE = 8.f;
#define LDS_WAIT() asm volatile("s_waitcnt lgkmcnt(0)" ::: "memory")
#define VM_WAIT() asm volatile("s_waitcnt vmcnt(0)" ::: "memory")

namespace pg8 {
constexpr int BM = 256, BK = 64, HALF = 128, HTB = HALF * BK * 2, STAGE_BYTES = 8 * HTB, NXCD = 8, WGM = 4;
__host__ __device__ __forceinline__ int lds_byte(int r, int c) { const int st = (r >> 4) * 2 + (c >> 5), rr = r & 15, cc = c & 31, ob = rr * 64 + cc * 2; return st * 1024 + (ob ^ (((ob >> 9) & 1) << 5)); }
__host__ __device__ __forceinline__ void stage_rc(int b, int& R, int& C) { const int st = b / 1024, sb = b % 1024, swz = sb ^ (((sb >> 9) & 1) << 5); R = (st >> 1) * 16 + swz / 64; C = (st & 1) * 32 + (swz % 64) / 2; }
__host__ __device__ __forceinline__ int perm32(int rho) { const int n = rho >> 4, i = rho & 15; return 8 * (i >> 2) + 4 * n + (i & 3); }

struct Unit { int pm, pn, tag; const char* A; const char* B; };

struct StaticOrder {
    int nM, nN, nwg, G, c;
    __device__ __forceinline__ void init(int nM_, int nN_, int G_, int c_) { nM = nM_; nN = nN_; nwg = nM * nN; G = G_; c = c_; }
    __device__ __forceinline__ bool next(int i, int& pm, int& pn) const {
        const long L = (long)i * G + c; if (L >= nwg) return false;
        int wgid = (int)L; { const int q = nwg / NXCD, r = nwg % NXCD, xcd = wgid % NXCD, off = wgid / NXCD; wgid = (xcd < r ? xcd * (q + 1) : r * (q + 1) + (xcd - r) * q) + off; }
        const int nig = WGM * nN, gid = wgid / nig, fm = gid * WGM, gsz = (nM - fm) < WGM ? (nM - fm) : WGM;
        pm = fm + ((wgid % nig) % gsz); pn = (wgid % nig) / gsz; return true;
    }
};
struct SchedStd {
    StaticOrder o; const char* A; const char* B; size_t sA, sB;
    __device__ __forceinline__ bool next(int i, Unit& u) const { int pm, pn; if (!o.next(i, pm, pn)) return false; u.pm = pm; u.pn = pn; u.tag = 0; u.A = A + (size_t)pm * sA; u.B = B + (size_t)pn * sB; return true; }
    __device__ __forceinline__ void a_ready(const Unit&) const {}
    __device__ __forceinline__ void done(const Unit&) const {}
};
struct SchedOne {
    Unit u0;
    __device__ __forceinline__ bool next(int i, Unit& u) const { if (i) return false; u = u0; return true; }
    __device__ __forceinline__ void a_ready(const Unit&) const {}
    __device__ __forceinline__ void done(const Unit&) const {}
};

template <class Epi, class Sched, bool ALIGN_EPI, bool SP2, bool F8 = false>
__device__ __forceinline__ void gemm_phase(LAS unsigned char* lds, const int K, const int lda, const int ldb, const Sched& S, const Epi& E, const char* wsb) {
    int tid_ = threadIdx.x; asm volatile("" : "+v"(tid_));
    const int tid = tid_, wid = __builtin_amdgcn_readfirstlane(tid >> 6), lane = tid & 63, wr = wid >> 2, wc = wid & 3, fr = lane & 15, fq = lane >> 4;
    constexpr int ES = F8 ? 1 : 2;
    const int nt = K * ES / (BK * 2);
    unsigned voffA[2], voffB[2];
#pragma unroll
    for (int i = 0; i < 2; ++i) { int R, C; stage_rc(tid * 16 + i * 8192, R, C); const int Rb = Epi::PERM ? ((R & ~31) + perm32(R & 31)) : R;
        voffA[i] = (unsigned)(R * lda * ES + C * 2); voffB[i] = (unsigned)(Rb * ldb * ES + C * 2); }
    const unsigned kstep = (unsigned)(BK * 2);
    const unsigned hstepA = (unsigned)(HALF * lda * ES), hstepB = (unsigned)(HALF * ldb * ES);
    const __amdgpu_buffer_rsrc_t rs = __builtin_amdgcn_make_buffer_rsrc((void*)wsb, (short)0, 0x7fffffff, 0x00020000);
    const unsigned ldsw = (unsigned)wid * 1024u;
    const int aoff = lds_byte(wr * 64 + fr, fq * 8), boff = lds_byte(wc * 32 + fr, fq * 8);
#define PG8_SA(b, h) (((b) * 2 + (h)) * HTB)
#define PG8_SB(b, h) ((4 + (b) * 2 + (h)) * HTB)
#define PG8_STAGE(bufoff, goff, voff) do { _Pragma("unroll") for (int _i = 0; _i < 2; ++_i) \
        __builtin_amdgcn_raw_ptr_buffer_load_lds(rs, (LAS unsigned*)(lds + (bufoff) + ldsw + _i * 8192), 16, (voff)[_i], (int)(goff), 0, 0); } while (0)
#define PG8_LD16(off) (*(const LAS bf16x8*)(lds + (off)))
#define PG8_CAT(x, y) __builtin_shufflevector(__builtin_bit_cast(i32x4_, (x)), __builtin_bit_cast(i32x4_, (y)), 0, 1, 2, 3, 4, 5, 6, 7)
#define PG8_LDA(dst, b, h) do { _Pragma("unroll") for (int m = 0; m < 4; ++m) { if constexpr (F8) dst##8[m] = PG8_CAT(PG8_LD16(PG8_SA(b, h) + aoff + m * 2048), PG8_LD16(PG8_SA(b, h) + aoff + m * 2048 + 1024)); \
        else { _Pragma("unroll") for (int k = 0; k < 2; ++k) dst[m][k] = PG8_LD16(PG8_SA(b, h) + aoff + m * 2048 + k * 1024); } } } while (0)
#define PG8_LDB(dst, b, h) do { _Pragma("unroll") for (int n = 0; n < 2; ++n) { if constexpr (F8) dst##8[n] = PG8_CAT(PG8_LD16(PG8_SB(b, h) + boff + n * 2048), PG8_LD16(PG8_SB(b, h) + boff + n * 2048 + 1024)); \
        else { _Pragma("unroll") for (int k = 0; k < 2; ++k) dst[n][k] = PG8_LD16(PG8_SB(b, h) + boff + n * 2048 + k * 1024); } } } while (0)
#define PG8_MMA(ai, bj, Af, Bf) do { __builtin_amdgcn_s_setprio(1); \
        if constexpr (F8) {   \
            asm volatile("s_nop 1\n\t" \
                "v_mfma_f32_16x16x128_f8f6f4 %0, %8, %10, %0\n\tv_mfma_f32_16x16x128_f8f6f4 %1, %9, %10, %1\n\t" \
                "v_mfma_f32_16x16x128_f8f6f4 %2, %8, %11, %2\n\tv_mfma_f32_16x16x128_f8f6f4 %3, %9, %11, %3\n\t" \
                "v_mfma_f32_16x16x128_f8f6f4 %4, %8, %12, %4\n\tv_mfma_f32_16x16x128_f8f6f4 %5, %9, %12, %5\n\t" \
                "v_mfma_f32_16x16x128_f8f6f4 %6, %8, %13, %6\n\tv_mfma_f32_16x16x128_f8f6f4 %7, %9, %13, %7" \
                : "+v"(acc[ai][bj][0][0]), "+v"(acc[ai][bj][0][1]), "+v"(acc[ai][bj][1][0]), "+v"(acc[ai][bj][1][1]), "+v"(acc[ai][bj][2][0]), "+v"(acc[ai][bj][2][1]), "+v"(acc[ai][bj][3][0]), "+v"(acc[ai][bj][3][1]) \
                : "v"(Bf##8[0]), "v"(Bf##8[1]), "v"(Af##8[0]), "v"(Af##8[1]), "v"(Af##8[2]), "v"(Af##8[3])); } \
        else { _Pragma("unroll") for (int m = 0; m < 4; ++m) _Pragma("unroll") for (int n = 0; n < 2; ++n) _Pragma("unroll") for (int k = 0; k < 2; ++k) acc[ai][bj][m][n] = __builtin_amdgcn_mfma_f32_16x16x32_bf16(Bf[n][k], Af[m][k], acc[ai][bj][m][n], 0, 0, 0); } \
        __builtin_amdgcn_s_setprio(0); } while (0)
#define PG8_WAIT_V(n) asm volatile("s_waitcnt vmcnt(" #n ")" ::: "memory")
#define PG8_WAIT_L(n) asm volatile("s_waitcnt lgkmcnt(" #n ")" ::: "memory")
#define PG8_BAR __builtin_amdgcn_s_barrier()
#define PG8_SCHED __builtin_amdgcn_sched_barrier(0)
    Unit cur, nxt; int ui = 0;
    if (!S.next(0, cur)) return;
    f32x4 acc[2][2][4][2];
#pragma unroll
    for (int a = 0; a < 2; ++a)
#pragma unroll
        for (int b = 0; b < 2; ++b)
#pragma unroll
            for (int m = 0; m < 4; ++m)
#pragma unroll
                for (int n = 0; n < 2; ++n) acc[a][b][m][n] = (f32x4){0.f, 0.f, 0.f, 0.f};
    typedef int i32x4_ __attribute__((ext_vector_type(4))); typedef int i32x8_ __attribute__((ext_vector_type(8)));
    bf16x8 At[4][2], B0[2][2], B1[2][2]; i32x8_ At8[4], B08[2], B18[2];
    unsigned cA = (unsigned)(cur.A - wsb), cB = (unsigned)(cur.B - wsb);
    S.a_ready(cur);
    if constexpr (SP2) {
        PG8_STAGE(PG8_SB(0, 0), cB, voffB); PG8_STAGE(PG8_SB(0, 1), cB + hstepB, voffB); PG8_STAGE(PG8_SA(0, 0), cA, voffA); PG8_STAGE(PG8_SA(0, 1), cA + hstepA, voffA);
        if (wr == 1) PG8_BAR;
        PG8_WAIT_V(2); PG8_BAR;
        PG8_STAGE(PG8_SB(1, 0), cB + kstep, voffB); PG8_STAGE(PG8_SA(1, 0), cA + kstep, voffA); PG8_STAGE(PG8_SB(1, 1), cB + hstepB + kstep, voffB);
        PG8_WAIT_V(6); PG8_BAR;
    } else {
        PG8_STAGE(PG8_SB(0, 0), cB, voffB); PG8_STAGE(PG8_SA(0, 0), cA, voffA); PG8_STAGE(PG8_SB(0, 1), cB + hstepB, voffB); PG8_STAGE(PG8_SA(0, 1), cA + hstepA, voffA);
        if (wr == 1) PG8_BAR;
        PG8_WAIT_V(4); PG8_BAR;
        PG8_STAGE(PG8_SB(1, 0), cB + kstep, voffB); PG8_STAGE(PG8_SA(1, 0), cA + kstep, voffA); PG8_STAGE(PG8_SB(1, 1), cB + hstepB + kstep, voffB);
        PG8_WAIT_V(6); PG8_BAR;
    }
    for (;;) {
        const bool has_next = S.next(ui + 1, nxt);
        const unsigned nA = has_next ? (unsigned)(nxt.A - wsb) : cA, nB = has_next ? (unsigned)(nxt.B - wsb) : cB;
        for (int t = 0; t < nt; t += 2) {
            const bool last = (t == nt - 2);
            const unsigned a1 = cA + (unsigned)(t + 1) * kstep;
            const unsigned a2 = last ? nA : cA + (unsigned)(t + 2) * kstep, b2 = last ? nB : cB + (unsigned)(t + 2) * kstep;
            const unsigned a3 = a2 + kstep, b3 = b2 + kstep;
            if (last && has_next) S.a_ready(nxt);
            if constexpr (SP2) {
            PG8_LDB(B0, 0, 0); PG8_LDB(B1, 0, 1); PG8_SCHED; PG8_LDA(At, 0, 0); PG8_STAGE(PG8_SA(1, 1), a1 + hstepA, voffA);
            PG8_WAIT_V(8); PG8_WAIT_L(0); PG8_BAR; PG8_MMA(0, 0, At, B0); PG8_MMA(0, 1, At, B1); PG8_BAR; PG8_SCHED;
            PG8_LDA(At, 0, 1); PG8_STAGE(PG8_SB(0, 0), b2, voffB); PG8_STAGE(PG8_SB(0, 1), b2 + hstepB, voffB); PG8_STAGE(PG8_SA(0, 0), a2, voffA);
            PG8_WAIT_V(8); PG8_WAIT_L(0); PG8_BAR; PG8_MMA(1, 0, At, B0); PG8_MMA(1, 1, At, B1); PG8_BAR; PG8_SCHED;
            PG8_LDB(B0, 1, 0); PG8_LDB(B1, 1, 1); PG8_SCHED; PG8_LDA(At, 1, 0); PG8_STAGE(PG8_SA(0, 1), a2 + hstepA, voffA);
            PG8_WAIT_V(8); PG8_WAIT_L(0); PG8_BAR; PG8_MMA(0, 0, At, B0); PG8_MMA(0, 1, At, B1); PG8_BAR; PG8_SCHED;
            PG8_LDA(At, 1, 1); PG8_STAGE(PG8_SB(1, 0), b3, voffB); PG8_STAGE(PG8_SB(1, 1), b3 + hstepB, voffB); PG8_STAGE(PG8_SA(1, 0), a3, voffA);
            PG8_WAIT_V(8); PG8_WAIT_L(0); PG8_BAR; PG8_MMA(1, 0, At, B0); PG8_MMA(1, 1, At, B1); PG8_BAR; PG8_SCHED;
            } else {
            PG8_LDB(B0, 0, 0); PG8_SCHED; PG8_LDA(At, 0, 0); PG8_STAGE(PG8_SA(1, 1), a1 + hstepA, voffA);
            PG8_WAIT_L(8); PG8_BAR; PG8_WAIT_L(0); PG8_MMA(0, 0, At, B0); PG8_BAR; PG8_SCHED;
            PG8_LDB(B1, 0, 1); PG8_STAGE(PG8_SB(0, 0), b2, voffB);
            PG8_BAR; PG8_WAIT_L(0); PG8_MMA(0, 1, At, B1); PG8_BAR;
            PG8_LDA(At, 0, 1); PG8_STAGE(PG8_SA(0, 0), a2, voffA);
            PG8_BAR; PG8_WAIT_L(0); PG8_MMA(1, 0, At, B0); PG8_BAR; PG8_SCHED;
            PG8_STAGE(PG8_SB(0, 1), b2 + hstepB, voffB);
            PG8_WAIT_V(6); PG8_BAR; PG8_MMA(1, 1, At, B1); PG8_BAR;
            PG8_LDB(B0, 1, 0); PG8_SCHED; PG8_LDA(At, 1, 0); PG8_STAGE(PG8_SA(0, 1), a2 + hstepA, voffA);
            PG8_WAIT_L(8); PG8_BAR; PG8_WAIT_L(0); PG8_MMA(0, 0, At, B0); PG8_BAR; PG8_SCHED;
            PG8_LDB(B1, 1, 1); PG8_STAGE(PG8_SB(1, 0), b3, voffB);
            PG8_BAR; PG8_WAIT_L(0); PG8_MMA(0, 1, At, B1); PG8_BAR;
            PG8_LDA(At, 1, 1); PG8_STAGE(PG8_SA(1, 0), a3, voffA);
            PG8_BAR; PG8_WAIT_L(0); PG8_MMA(1, 0, At, B0); PG8_BAR; PG8_SCHED;
            PG8_STAGE(PG8_SB(1, 1), b3 + hstepB, voffB);
            PG8_WAIT_V(6); PG8_BAR; PG8_MMA(1, 1, At, B1); PG8_BAR;
            }
        }
        if constexpr (F8) asm volatile("s_nop 15\n\ts_nop 7" ::: "memory");
        if constexpr (ALIGN_EPI) { if (wr == 0) PG8_BAR; }
        if constexpr (!Epi::AFTER_DRAIN) { int fr2 = fr, fq2 = fq; asm volatile("" : "+v"(fr2), "+v"(fq2));
            E(acc, cur, wr, wc, fr2, fq2); S.done(cur); }
        if (!has_next) break;
#pragma unroll
        for (int a = 0; a < 2; ++a)
#pragma unroll
            for (int b = 0; b < 2; ++b)
#pragma unroll
                for (int m = 0; m < 4; ++m)
#pragma unroll
                    for (int n = 0; n < 2; ++n) acc[a][b][m][n] = (f32x4){0.f, 0.f, 0.f, 0.f};
        cur = nxt; cA = nA; cB = nB; ++ui;
        if constexpr (ALIGN_EPI) { if (wr == 1) PG8_BAR; }
    }
    PG8_WAIT_V(0);
    if constexpr (!ALIGN_EPI) { if (wr == 0) PG8_BAR; }
    PG8_BAR;
    if constexpr (Epi::AFTER_DRAIN) { int fr2 = fr, fq2 = fq, lane2 = lane; asm volatile("" : "+v"(fr2), "+v"(fq2), "+v"(lane2)); E.fused(acc, cur, wr, wc, fr2, fq2, lds, wid, lane2); S.done(cur); }
#undef PG8_SA
#undef PG8_SB
#undef PG8_STAGE
#undef PG8_LDA
#undef PG8_LD16
#undef PG8_CAT
#undef PG8_LDB
#undef PG8_MMA
#undef PG8_WAIT_V
#undef PG8_WAIT_L
#undef PG8_BAR
#undef PG8_SCHED
}
}
using pg8::Unit;
typedef const f32x4 (&AccRef)[2][2][4][2];

__device__ __forceinline__ u32x4 pack8(const f32x4 a, const f32x4 b) { u32x4 w; w.x = pk2(a[0], a[1]); w.y = pk2(a[2], a[3]); w.z = pk2(b[0], b[1]); w.w = pk2(b[2], b[3]); return w; }
__device__ __forceinline__ void unpack8(const u32x4 w, f32x4& a, f32x4& b) { a = (f32x4){bflo(w.x), bfhi(w.x), bflo(w.y), bfhi(w.y)}; b = (f32x4){bflo(w.z), bfhi(w.z), bflo(w.w), bfhi(w.w)}; }

struct EpiInproj {
    static constexpr bool PERM = true, AFTER_DRAIN = false;
    const float* stats; bf16_t* uconv; bf16_t* xu; bf16_t* gates;
    __device__ __forceinline__ void operator()(AccRef acc, const Unit& u, int wr, int wc, int fr, int fq) const {
        float rr[2][4];
#pragma unroll
        for (int ai = 0; ai < 2; ++ai)
#pragma unroll
            for (int m = 0; m < 4; ++m) rr[ai][m] = row_rstd(stats, u.pm * 256 + ai * 128 + wr * 64 + m * 16 + fr);
#pragma unroll
        for (int ai = 0; ai < 2; ++ai)
#pragma unroll
            for (int m = 0; m < 4; ++m) {
                const int row = u.pm * 256 + ai * 128 + wr * 64 + m * 16 + fr;
                const float r = rr[ai][m];
                if (u.pn < 4) {
                    f32x4 v[2];
#pragma unroll
                    for (int n = 0; n < 2; ++n)
#pragma unroll
                        for (int i = 0; i < 4; ++i) v[n][i] = (acc[ai][0][m][n][i] * r) * sigmoidf_(acc[ai][1][m][n][i] * r);
                    *(u32x4*)(uconv + (size_t)row * CW + u.pn * 128 + wc * 32 + fq * 8) = pack8(v[0], v[1]);
                } else if (u.pn < 6) {
                    const int b = row >> 12, t = row & 4095;
#pragma unroll
                    for (int bj = 0; bj < 2; ++bj) {
                        const int ch = (u.pn - 4) * 256 + bj * 128 + wc * 32 + fq * 8, g = ch >> 4, h0 = ch & 15;
                        const size_t off = ((size_t)((b * NG + g) * 256 + (t >> 4))) * 384 + (t & 15) * 16 + h0;
                        *(u32x4*)(xu + off) = pack8(acc[ai][bj][m][0] * r, acc[ai][bj][m][1] * r);
                    }
                } else {
#pragma unroll
                    for (int bj = 0; bj < 2; ++bj) {
                        f32x4 v[2];
#pragma unroll
                        for (int n = 0; n < 2; ++n)
#pragma unroll
                            for (int i = 0; i < 4; ++i) v[n][i] = sigmoidf_(acc[ai][bj][m][n][i] * r);
                        *(u32x4*)(gates + (size_t)row * 2048 + (u.pn - 6) * 256 + bj * 128 + wc * 32 + fq * 8) = pack8(v[0], v[1]);
                    }
                }
            }
    }
};
struct EpiGates {
    static constexpr bool PERM = true, AFTER_DRAIN = false;
    const float* stats; bf16_t* gates; float sc;
    __device__ __forceinline__ void operator()(AccRef acc, const Unit& u, int wr, int wc, int fr, int fq) const {
        float rr[2][4];
#pragma unroll
        for (int ai = 0; ai < 2; ++ai)
#pragma unroll
            for (int m = 0; m < 4; ++m) rr[ai][m] = row_rstd(stats, u.pm * 256 + ai * 128 + wr * 64 + m * 16 + fr) * sc;
#pragma unroll
        for (int ai = 0; ai < 2; ++ai)
#pragma unroll
            for (int m = 0; m < 4; ++m) {
                const int row = u.pm * 256 + ai * 128 + wr * 64 + m * 16 + fr; const float r = rr[ai][m];
#pragma unroll
                for (int bj = 0; bj < 2; ++bj) {
                    f32x4 v[2];
#pragma unroll
                    for (int n = 0; n < 2; ++n)
#pragma unroll
                        for (int i = 0; i < 4; ++i) v[n][i] = sigmoidf_(acc[ai][bj][m][n][i] * r);
                    *(u32x4*)(gates + (size_t)row * 2048 + u.pn * 256 + bj * 128 + wc * 32 + fq * 8) = pack8(v[0], v[1]);
                }
            }
    }
};
struct EpiZ {
    static constexpr bool PERM = true, AFTER_DRAIN = false;
    const bf16_t* gates; bf16_t* mb;
    __device__ __forceinline__ void operator()(AccRef acc, const Unit& u, int wr, int wc, int fr, int fq) const {
        const int oc = u.pn * 128 + wc * 32 + fq * 8;
        u32x4 gv[2][4];
#pragma unroll
        for (int ai = 0; ai < 2; ++ai)
#pragma unroll
            for (int m = 0; m < 4; ++m) gv[ai][m] = *(const u32x4*)(gates + (size_t)(u.pm * 256 + ai * 128 + wr * 64 + m * 16 + fr) * 2048 + 1024 + oc);
#pragma unroll
        for (int ai = 0; ai < 2; ++ai)
#pragma unroll
            for (int m = 0; m < 4; ++m) {
                const int row = u.pm * 256 + ai * 128 + wr * 64 + m * 16 + fr;
                f32x4 g0, g1; unpack8(gv[ai][m], g0, g1);
                f32x4 v[2];
#pragma unroll
                for (int i = 0; i < 4; ++i) { v[0][i] = g0[i] * acc[ai][0][m][0][i] * sigmoidf_(acc[ai][1][m][0][i]); v[1][i] = g1[i] * acc[ai][0][m][1][i] * sigmoidf_(acc[ai][1][m][1][i]); }
                *(u32x4*)(mb + (size_t)row * D + oc) = pack8(v[0], v[1]);
            }
    }
};
struct EpiPw {
    static constexpr bool PERM = true, AFTER_DRAIN = false;
    const bf16_t* gates; const bf16_t* mb; bf16_t* merged;
    __device__ __forceinline__ void operator()(AccRef acc, const Unit& u, int wr, int wc, int fr, int fq) const {
#pragma unroll
        for (int ai = 0; ai < 2; ++ai) {
            u32x4 gv[4][2], mv[4][2];
#pragma unroll
            for (int m = 0; m < 4; ++m)
#pragma unroll
                for (int bj = 0; bj < 2; ++bj) { const int row = u.pm * 256 + ai * 128 + wr * 64 + m * 16 + fr, c = u.pn * 256 + bj * 128 + wc * 32 + fq * 8;
                    gv[m][bj] = *(const u32x4*)(gates + (size_t)row * 2048 + c); mv[m][bj] = *(const u32x4*)(mb + (size_t)row * D + c); }
#pragma unroll
            for (int m = 0; m < 4; ++m)
#pragma unroll
                for (int bj = 0; bj < 2; ++bj) { const int row = u.pm * 256 + ai * 128 + wr * 64 + m * 16 + fr, c = u.pn * 256 + bj * 128 + wc * 32 + fq * 8;
                    f32x4 g0, g1, m0, m1; unpack8(gv[m][bj], g0, g1); unpack8(mv[m][bj], m0, m1);
                    *(u32x4*)(merged + (size_t)row * D + c) = pack8(g0 * acc[ai][bj][m][0] + m0, g1 * acc[ai][bj][m][1] + m1); }
        }
    }
};
struct EpiZPW {
    static constexpr bool PERM = true, AFTER_DRAIN = false;
    EpiZ ez; EpiPw ep;
    __device__ __forceinline__ void operator()(AccRef acc, const Unit& u, int wr, int wc, int fr, int fq) const {
        if (u.tag == 0) ez(acc, u, wr, wc, fr, fq);
        else { asm volatile("s_waitcnt vmcnt(0)" ::: "memory"); ep(acc, u, wr, wc, fr, fq); }
    }
};
struct SchedZPW {
    pg8::StaticOrder o; const char* ys; const char* uc; const char* wglu; const char* wpw;
    __device__ __forceinline__ bool next(int i, Unit& u) const { const int gi = i / 3, sub = i - gi * 3; int pm, pn; if (!o.next(gi, pm, pn)) return false;
        u.pm = pm;
        if (sub < 2) { u.pn = 2 * pn + sub; u.tag = 0; u.A = ys + (size_t)pm * 256 * SW * 2; u.B = wglu + (size_t)u.pn * 256 * SW * 2; }
        else { u.pn = pn; u.tag = 1; u.A = uc + (size_t)pm * 256 * CW * 2; u.B = wpw + (size_t)pn * 256 * CW * 2; }
        return true; }
    __device__ __forceinline__ void a_ready(const Unit&) const {}
    __device__ __forceinline__ void done(const Unit&) const {}
};
template <bool H8OUT = false, bool SCALED = false> struct EpiRes {
    static constexpr bool PERM = true, AFTER_DRAIN = false;
    bf16_t* h; float* stats; bf16_t* hdst; unsigned char* h8; LAS unsigned char* lds;
    __device__ __forceinline__ void operator()(AccRef acc, const Unit& u, int wr, int wc, int fr, int fq) const {
        LAS float* X = (LAS float*)(lds + LDS_AUX);
#pragma unroll
        for (int ai = 0; ai < 2; ++ai) {
            u32x4 hv[4][2];
#pragma unroll
            for (int m = 0; m < 4; ++m)
#pragma unroll
                for (int bj = 0; bj < 2; ++bj) hv[m][bj] = *(const u32x4*)(h + (size_t)(u.pm * 256 + ai * 128 + wr * 64 + m * 16 + fr) * D + u.pn * 256 + bj * 128 + wc * 32 + fq * 8);
#pragma unroll
            for (int m = 0; m < 4; ++m) {
                const int row = u.pm * 256 + ai * 128 + wr * 64 + m * 16 + fr; float ss = 0.f;
#pragma unroll
                for (int bj = 0; bj < 2; ++bj) {
                    const size_t eo = (size_t)row * D + u.pn * 256 + bj * 128 + wc * 32 + fq * 8;
                    f32x4 h0, h1; unpack8(hv[m][bj], h0, h1);
                    constexpr float asc = SCALED ? 1.0f / (F8_WD_SCALE * F8_ACT_SCALE) : 1.0f;
                    h0 = h0 + acc[ai][bj][m][0] * asc; h1 = h1 + acc[ai][bj][m][1] * asc;
                    ss += (h0[0] * h0[0] + h0[1] * h0[1]) + (h0[2] * h0[2] + h0[3] * h0[3]) + (h1[0] * h1[0] + h1[1] * h1[1]) + (h1[2] * h1[2] + h1[3] * h1[3]);
                    *(u32x4*)(hdst + eo) = pack8(h0, h1);
                    if (H8OUT) { u32x2 w8; w8.x = pk4_fp8(h0[0], h0[1], h0[2], h0[3]); w8.y = pk4_fp8(h1[0], h1[1], h1[2], h1[3]); *(u32x2*)(h8 + eo) = w8; }
                }
                ss += __shfl_xor(ss, 16); ss += __shfl_xor(ss, 32);
                if (fq == 0) X[(ai * 128 + wr * 64 + m * 16 + fr) * 4 + wc] = ss;
            }
        }
        LDS_WAIT(); __builtin_amdgcn_s_barrier(); asm volatile("" ::: "memory");
        const int lane = fq * 16 + fr, wid = wr * 4 + wc;
        if (lane < 32) { const int rl = wid * 32 + lane; const f32x4 v = *(const LAS f32x4*)(X + rl * 4); stats[(size_t)(u.pm * 256 + rl) * 4 + u.pn] = (v[0] + v[1]) + (v[2] + v[3]); }
    }
};
struct EpiQ {
    static constexpr bool PERM = true, AFTER_DRAIN = false;
    const float* stats; bf16_t* q; float sc;
    __device__ __forceinline__ void operator()(AccRef acc, const Unit& u, int wr, int wc, int fr, int fq) const {
        float rr[2][4];
#pragma unroll
        for (int ai = 0; ai < 2; ++ai)
#pragma unroll
            for (int m = 0; m < 4; ++m) rr[ai][m] = row_rstd(stats, u.pm * 256 + ai * 128 + wr * 64 + m * 16 + fr) * sc;
#pragma unroll
        for (int ai = 0; ai < 2; ++ai)
#pragma unroll
            for (int m = 0; m < 4; ++m) {
                const int row = u.pm * 256 + ai * 128 + wr * 64 + m * 16 + fr; const float r = rr[ai][m];
#pragma unroll
                for (int bj = 0; bj < 2; ++bj)
                    *(u32x4*)(q + (size_t)row * D + u.pn * 256 + bj * 128 + wc * 32 + fq * 8) = pack8(acc[ai][bj][m][0] * r, acc[ai][bj][m][1] * r);
            }
    }
};
template <bool MOE, bool F8 = false> struct EpiGU {
    static constexpr bool PERM = true, AFTER_DRAIN = false;
    const float* stats;
    const float* gwt;
    bf16_t* act; int ldc;
    __device__ __forceinline__ void operator()(AccRef acc, const Unit& u, int wr, int wc, int fr, int fq) const {
        float rr[2][4], gg[2][4];
#pragma unroll
        for (int ai = 0; ai < 2; ++ai)
#pragma unroll
            for (int m = 0; m < 4; ++m) { const int row = u.pm * 256 + ai * 128 + wr * 64 + m * 16 + fr; gg[ai][m] = 1.f; if (MOE) { rr[ai][m] = stats[row]; gg[ai][m] = gwt[row]; } else rr[ai][m] = row_rstd(stats, row); }
#pragma unroll
        for (int ai = 0; ai < 2; ++ai)
#pragma unroll
            for (int m = 0; m < 4; ++m) {
                const int row = u.pm * 256 + ai * 128 + wr * 64 + m * 16 + fr;
                float r = rr[ai][m], gw = gg[ai][m];
                if (F8) { r *= 1.0f / F8_WGU_SCALE; gw *= F8_ACT_SCALE; }
                f32x4 v[2];
#pragma unroll
                for (int n = 0; n < 2; ++n)
#pragma unroll
                    for (int i = 0; i < 4; ++i) v[n][i] = siluf_(acc[ai][0][m][n][i] * r) * (acc[ai][1][m][n][i] * r) * gw;
                if (F8) { u32x2 w8; w8.x = pk4_fp8(v[0][0], v[0][1], v[0][2], v[0][3]); w8.y = pk4_fp8(v[1][0], v[1][1], v[1][2], v[1][3]); *(u32x2*)((unsigned char*)act + (size_t)row * ldc + u.pn * 128 + wc * 32 + fq * 8) = w8; }
                else *(u32x4*)(act + (size_t)row * ldc + u.pn * 128 + wc * 32 + fq * 8) = pack8(v[0], v[1]);
            }
    }
};
struct EpiPlain {
    static constexpr bool PERM = true, AFTER_DRAIN = false;
    bf16_t* o0; bf16_t* o1; int ld0, ld1; size_t ls0, ls1; float osc = 1.f;
    __device__ __forceinline__ void operator()(AccRef acc, const Unit& u, int wr, int wc, int fr, int fq) const {
        const int which = u.tag & 1, layer = u.tag >> 1; bf16_t* o = which ? o1 + (size_t)layer * ls1 : o0 + (size_t)layer * ls0; const int ld = which ? ld1 : ld0;
#pragma unroll
        for (int ai = 0; ai < 2; ++ai)
#pragma unroll
            for (int m = 0; m < 4; ++m) {
                const int row = u.pm * 256 + ai * 128 + wr * 64 + m * 16 + fr;
#pragma unroll
                for (int bj = 0; bj < 2; ++bj)
                    *(u32x4*)(o + (size_t)row * ld + u.pn * 256 + bj * 128 + wc * 32 + fq * 8) = pack8(acc[ai][bj][m][0] * osc, acc[ai][bj][m][1] * osc);
            }
    }
};
struct EpiSsm1 {
    static constexpr bool PERM = true, AFTER_DRAIN = true;
    const float* a16;
    bf16_t* xu;
    __device__ __forceinline__ void fused(AccRef acc, const Unit& u, int wr, int wc, int fr, int fq, LAS unsigned char* lds, int wid, int lane) const {
        LAS float* S = (LAS float*)lds;
#pragma unroll
        for (int ai = 0; ai < 2; ++ai)
#pragma unroll
            for (int m = 0; m < 4; ++m) {
                const int row = ai * 128 + wr * 64 + m * 16 + fr;
#pragma unroll
                for (int n = 0; n < 2; ++n) *(LAS f32x4*)(S + row * 128 + wc * 32 + fq * 8 + n * 4) = acc[ai][0][m][n];
            }
        LDS_WAIT(); __builtin_amdgcn_s_barrier(); asm volatile("" ::: "memory");
        LAS f32x2* Sp = (LAS f32x2*)lds; LAS f32x2* E = (LAS f32x2*)(lds + LDS_AUX);
        const int p = lane, seg = wid;
        const f32x2 a = *(const f32x2*)(a16 + 2 * p);
        f32x2 x = {0.f, 0.f};
        for (int c = seg * 32; c < seg * 32 + 32; ++c) { const f32x2 s = Sp[c * 64 + p]; Sp[c * 64 + p] = x; x = (f32x2){a.x * x.x - a.y * x.y + s.x, a.x * x.y + a.y * x.x + s.y}; }
        E[seg * 64 + p] = x;
        LDS_WAIT(); __builtin_amdgcn_s_barrier(); asm volatile("" ::: "memory");
        f32x2 a512 = a;
#pragma unroll
        for (int i = 0; i < 5; ++i) a512 = (f32x2){a512.x * a512.x - a512.y * a512.y, 2.f * a512.x * a512.y};
        f32x2 z = {0.f, 0.f};
        for (int j = 0; j < seg; ++j) { const f32x2 e = E[j * 64 + p]; z = (f32x2){a512.x * z.x - a512.y * z.y + e.x, a512.x * z.y + a512.y * z.x + e.y}; }
        for (int c = seg * 32; c < seg * 32 + 32; ++c) { const f32x2 hl = Sp[c * 64 + p];
            *(unsigned*)(xu + (size_t)c * 384 + 256 + 2 * p) = pk2(hl.x + z.x, hl.y + z.y);
            z = (f32x2){a.x * z.x - a.y * z.y, a.x * z.y + a.y * z.x}; }
    }
};
struct EpiSsm2 {
    static constexpr bool PERM = true, AFTER_DRAIN = false;
    bf16_t* ys; int b, g;
    __device__ __forceinline__ void operator()(AccRef acc, const Unit& u, int wr, int wc, int fr, int fq) const {
#pragma unroll
        for (int ai = 0; ai < 2; ++ai)
#pragma unroll
            for (int m = 0; m < 4; ++m) {
                const int c = ai * 128 + wr * 64 + m * 16 + fr;
#pragma unroll
                for (int bj = 0; bj < 2; ++bj) {
                    const int j = bj * 8 + wc * 2 + (fq >> 1), h0 = (fq & 1) * 8;
                    f32x4 v[2];
#pragma unroll
                    for (int n = 0; n < 2; ++n)
#pragma unroll
                        for (int i = 0; i < 4; ++i) v[n][i] = gelu_tanh_(acc[ai][bj][m][n][i]);
                    *(u32x4*)(ys + ((size_t)b * SEQ + c * 16 + j) * SW + g * 16 + h0) = pack8(v[0], v[1]);
                }
            }
    }
};

#define XB_TMO      128
#define XB_XCNT(j)  (256  + 64 * (j))
#define XB_XSUB(j)  (1280 + 64 * (j))
#define XB_XGEN(j)  (2304 + 64 * (j))
#define XB_TOP      3328
#define XB_TOPGEN   3392
#define XCD_BAR_WORDS 3456
#define XB_SPIN_CAP (1u << 18)
__device__ __forceinline__ unsigned xb_ld(unsigned* p)              { return __hip_atomic_load(p, __ATOMIC_RELAXED, __HIP_MEMORY_SCOPE_AGENT); }
__device__ __forceinline__ unsigned xb_add(unsigned* p, unsigned v) { return __hip_atomic_fetch_add(p, v, __ATOMIC_RELAXED, __HIP_MEMORY_SCOPE_AGENT); }
__device__ __forceinline__ unsigned xb_xcc_id() { return (unsigned)__builtin_amdgcn_s_getreg((3 << 11) | 20) & 0xFu; }
#define XB_SPIN(cond, bar) do { unsigned _sp = 0; while (cond) { __builtin_amdgcn_s_sleep(1); \
    if ((++_sp & 255u) == 0u) { if (xb_ld(&(bar)[XB_TMO])) break; if (_sp > XB_SPIN_CAP) { atomicAdd(&(bar)[XB_TMO], 1u); break; } } } } while (0)
struct XcdBarrier { unsigned* bar; unsigned x; volatile LAS unsigned* st; };
__device__ __forceinline__ XcdBarrier xcd_barrier_post(unsigned* bar, volatile LAS unsigned* st) {
    XcdBarrier b; b.bar = bar; b.x = xb_xcc_id(); b.st = st;
    if (threadIdx.x == 0) (void)xb_add(&bar[XB_XCNT(b.x)], 1u);
    return b;
}
__device__ __forceinline__ void xcd_barrier_complete(unsigned* bar, unsigned x, unsigned& nloc, unsigned& nx) {
    const unsigned G = gridDim.x * gridDim.y * gridDim.z;
    unsigned sum, cnt, mine, sp = 0u;
    for (;;) {
        sum = 0u; cnt = 0u; mine = 0u;
#pragma unroll
        for (unsigned j = 0; j < 16; ++j) { const unsigned c = xb_ld(&bar[XB_XCNT(j)]); sum += c; cnt += (c > 0u) ? 1u : 0u; mine = (j == x) ? c : mine; }
        if (sum == G) break;
        __builtin_amdgcn_s_sleep(1);
        if ((++sp & 255u) == 0u) { if (xb_ld(&bar[XB_TMO])) break; if (sp > XB_SPIN_CAP) { atomicAdd(&bar[XB_TMO], 1u); break; } }
    }
    nloc = mine > 0u ? mine : 1u; nx = cnt > 0u ? cnt : 1u;
}
__device__ __forceinline__ void xcd_barrier(const XcdBarrier& b) {
    asm volatile("s_waitcnt vmcnt(0)" ::: "memory");
    __syncthreads();
    if (threadIdx.x == 0) {
        unsigned* bar = b.bar;
        __builtin_amdgcn_s_waitcnt(0);
        unsigned nloc = b.st[0], nx = b.st[1];
        if (nloc == 0u) { xcd_barrier_complete(bar, b.x, nloc, nx); b.st[0] = nloc; b.st[1] = nx; }
        const unsigned old = xb_add(&bar[XB_XSUB(b.x)], 1u);
        const unsigned gen = old / nloc;
        if (old + 1u == (gen + 1u) * nloc) {
            __builtin_amdgcn_fence(__ATOMIC_RELEASE, "agent");
            asm volatile("s_waitcnt vmcnt(0)" ::: "memory");
            const unsigned og = xb_add(&bar[XB_TOP], 1u);
            const unsigned tg = og / nx;
            if (og + 1u == (tg + 1u) * nx) xb_add(&bar[XB_TOPGEN], 1u);
            else XB_SPIN(xb_ld(&bar[XB_TOPGEN]) == tg, bar);
            __builtin_amdgcn_fence(__ATOMIC_ACQUIRE, "agent");
            xb_add(&bar[XB_XGEN(b.x)], 1u);
            asm volatile("s_waitcnt vmcnt(0)" ::: "memory");
        } else {
            XB_SPIN(xb_ld(&bar[XB_XGEN(b.x)]) == gen, bar);
            __builtin_amdgcn_fence(__ATOMIC_ACQUIRE, "agent");
            asm volatile("s_waitcnt vmcnt(0)" ::: "memory");
        }
    }
    __syncthreads();
}

struct Args {
    const float* in[32];
    float* out; unsigned char* ws;
    int ph_lo, ph_hi;
};
enum { I_X = 0, I_MEM, I_MEMG, I_NMIXG, I_WIN, I_CONVW, I_CONVB, I_LNG, I_LNB, I_WPW, I_LRE, I_LIM, I_LOGDT, I_BRE, I_BIM, I_CRE, I_CIM, I_DSKIP, I_WGLU, I_WOUT,
       I_NXG, I_WQ, I_WKV, I_WO, I_NFG, I_FGU, I_FD, I_RW, I_RB, I_MGU, I_MD, I_FINALG };

struct Frame {
    LAS unsigned char* lds; int tid, lane, wave, c, G;
    unsigned char* ws; const float* const* in; float* out;
};
template <class Tp> __device__ __forceinline__ Tp* wsp(const Frame& F, size_t off) { return (Tp*)(F.ws + off); }

template <bool F8 = false>
__device__ __forceinline__ void xpose_matrix(const Frame& F, const float* W, int K, int Nsrc, int N, bf16_t* WT, int permlimit, int halfN, const float* gk, float sc, unsigned& item_base) {
    LAS float* scr = (LAS float*)(F.lds + F.wave * 16640);
    const int lane = F.lane, NGW = F.G * 8, gw = F.c * 8 + F.wave;
    const int nblk = N / 64, items = (K / 64) * nblk;
    int first = (int)(((unsigned)gw + (unsigned)NGW - (item_base % (unsigned)NGW)) % (unsigned)NGW);
    item_base = (item_base + (unsigned)items) % (unsigned)NGW;
    const int kr = lane >> 4, nc = (lane & 15) * 4;
    for (int it = first; it < items; it += NGW) {
        const int kb = it / nblk, nb = it % nblk, k0 = 64 * kb, n0 = 64 * nb;
        const int c0 = (n0 < permlimit) ? (((n0 >> 7) & 1) * halfN + (n0 >> 8) * 128 + (n0 & 127)) : n0;
        f32x4 v[16];
#pragma unroll
        for (int i = 0; i < 16; ++i) v[i] = *(const f32x4*)(W + (size_t)(k0 + 4 * i + kr) * Nsrc + c0 + nc);
#pragma unroll
        for (int i = 0; i < 16; ++i) { const float g = gk ? gk[k0 + 4 * i + kr] * sc : sc; LAS float* d = scr + (4 * i + kr) * 65 + nc;
            d[0] = v[i][0] * g; d[1] = v[i][1] * g; d[2] = v[i][2] * g; d[3] = v[i][3] * g; }
        LDS_WAIT(); asm volatile("" ::: "memory");
        const int c = lane & 7;
#pragma unroll
        for (int j = 0; j < 8; ++j) { const int n = (lane >> 3) + 8 * j; const LAS float* s = scr + (8 * c) * 65 + n;
            u32x4 o; o.x = pk2(s[0 * 65], s[1 * 65]); o.y = pk2(s[2 * 65], s[3 * 65]); o.z = pk2(s[4 * 65], s[5 * 65]); o.w = pk2(s[6 * 65], s[7 * 65]);
            if (F8) { u32x2 o8; o8.x = pk4_fp8(s[0 * 65], s[1 * 65], s[2 * 65], s[3 * 65]); o8.y = pk4_fp8(s[4 * 65], s[5 * 65], s[6 * 65], s[7 * 65]); *(u32x2*)((unsigned char*)WT + (size_t)(n0 + n) * K + k0 + 8 * c) = o8; }
            else *(u32x4*)(WT + (size_t)(n0 + n) * K + k0 + 8 * c) = o; }
        LDS_WAIT(); asm volatile("" ::: "memory");
    }
}
struct XDesc { unsigned long long src, dst, gk; int K, Nsrc, nblk, permlimit, halfN, f8; float sc; unsigned base; unsigned pad[2]; };
static_assert(sizeof(XDesc) == 64, "XDesc is four 16-byte words");
static_assert(MK_ONE_LAUNCH == 1, "deferred weights are converted inside the grid barriers of the one-launch kernel");
static_assert(F8_GATES && F8_QO && F8_MOE_MASK == 0xA && F8_DENSE_MASK == 0x4, "the deferred-conversion table below is written for this precision configuration");
constexpr int LDS_BGTAB = LDS_MISC + 256, BG_NMAT = 55;
static_assert(LDS_BGTAB + (BG_NMAT + 1) * 64 <= LDS_BYTES, "descriptor table inside the LDS allocation");
constexpr int MI_LCUR = 16, MI_SEQ = 17, MI_THR = 18  , MI_MCUR = 24  ;
__device__ __forceinline__ void xd_store(LAS XDesc* p, const XDesc& v) { const u32x4* q = (const u32x4*)&v; LAS u32x4* d = (LAS u32x4*)p; d[0] = q[0]; d[1] = q[1]; d[2] = q[2]; d[3] = q[3]; }
__device__ __forceinline__ XDesc xd_load(const LAS XDesc* p) { const LAS u32x4* d = (const LAS u32x4*)p; u32x4 q[4] = {d[0], d[1], d[2], d[3]}; return __builtin_bit_cast(XDesc, q); }
__device__ __forceinline__ unsigned xd_base(const LAS XDesc* p) { return ((const volatile LAS unsigned*)p)[13]; }
__device__ __forceinline__ void xpose_item(const Frame& F, const XDesc& d, int it) {
    LAS float* scr = (LAS float*)(F.lds + F.wave * 16640);
    const int lane = F.lane, kr = lane >> 4, nc = (lane & 15) * 4;
    const float* W = (const float*)d.src; const float* gk = (const float*)d.gk; const int K = d.K, Nsrc = d.Nsrc;
    const int kb = it / d.nblk, nb = it - kb * d.nblk, k0 = 64 * kb, n0 = 64 * nb;
    const int c0 = (n0 < d.permlimit) ? (((n0 >> 7) & 1) * d.halfN + (n0 >> 8) * 128 + (n0 & 127)) : n0;
#pragma unroll
    for (int hh = 0; hh < 2; ++hh) {
        f32x4 v[8];
#pragma unroll
        for (int i = 0; i < 8; ++i) v[i] = *(const f32x4*)(W + (size_t)(k0 + 4 * (8 * hh + i) + kr) * Nsrc + c0 + nc);
#pragma unroll
        for (int i = 0; i < 8; ++i) { const float g = gk ? gk[k0 + 4 * (8 * hh + i) + kr] * d.sc : d.sc; LAS float* q = scr + (4 * (8 * hh + i) + kr) * 65 + nc;
            q[0] = v[i][0] * g; q[1] = v[i][1] * g; q[2] = v[i][2] * g; q[3] = v[i][3] * g; }
    }
    LDS_WAIT(); asm volatile("" ::: "memory");
    const int c = lane & 7;
#pragma unroll
    for (int j = 0; j < 8; ++j) { const int n = (lane >> 3) + 8 * j; const LAS float* s = scr + (8 * c) * 65 + n;
        if (d.f8) { u32x2 o8; o8.x = pk4_fp8(s[0 * 65], s[1 * 65], s[2 * 65], s[3 * 65]); o8.y = pk4_fp8(s[4 * 65], s[5 * 65], s[6 * 65], s[7 * 65]); *(u32x2*)((unsigned char*)d.dst + (size_t)(n0 + n) * K + k0 + 8 * c) = o8; }
        else { u32x4 o; o.x = pk2(s[0 * 65], s[1 * 65]); o.y = pk2(s[2 * 65], s[3 * 65]); o.z = pk2(s[4 * 65], s[5 * 65]); o.w = pk2(s[6 * 65], s[7 * 65]); *(u32x4*)((bf16_t*)d.dst + (size_t)(n0 + n) * K + k0 + 8 * c) = o; } }
    LDS_WAIT(); asm volatile("" ::: "memory");
}
__device__ __forceinline__ bool bg_try(const Frame& F, unsigned limit) {
    volatile LAS unsigned* MISC = (volatile LAS unsigned*)(F.lds + LDS_MISC);
    LAS unsigned* lcur = (LAS unsigned*)(F.lds + LDS_MISC) + MI_LCUR;
    unsigned k = 0u; if (F.lane == 0) k = __hip_atomic_fetch_add(lcur, 1u, __ATOMIC_RELAXED, __HIP_MEMORY_SCOPE_WORKGROUP);
    k = (unsigned)__builtin_amdgcn_readfirstlane((int)k);
    const unsigned g = k * (unsigned)F.G + (unsigned)F.c;
    if (g >= limit) { if (F.lane == 0) __hip_atomic_fetch_sub(lcur, 1u, __ATOMIC_RELAXED, __HIP_MEMORY_SCOPE_WORKGROUP); return false; }
    const LAS XDesc* tab = (const LAS XDesc*)(F.lds + LDS_BGTAB);
    int m = (int)MISC[MI_MCUR + F.wave];
    while (g >= xd_base(tab + m + 1)) ++m;
    if (F.lane == 0) MISC[MI_MCUR + F.wave] = (unsigned)m;
    const XDesc d = xd_load(tab + m);
    xpose_item(F, d, (int)(g - d.base));
    return true;
}
__device__ __forceinline__ void bg_drain(const Frame& F, int which) {
    const unsigned limit = ((volatile LAS unsigned*)(F.lds + LDS_MISC))[MI_THR + which];
    while (bg_try(F, limit)) {}
}
__device__ __forceinline__ void ssm_tables(const Frame& F, int layer, int g) {
    LAS float* L = (LAS float*)F.lds;
    LAS float* AP = L;
    LAS float* BB = L + 17 * 128;
    LAS float* CC = BB + 2048;
    LAS float* KI = CC + 2048;
    const int tid = F.tid;
    const float* lre = F.in[I_LRE] + (size_t)(layer * NG + g) * SP; const float* lim = F.in[I_LIM] + (size_t)(layer * NG + g) * SP;
    const float dt = expf(F.in[I_LOGDT][layer * NG + g]);
    __syncthreads();
    for (int i = tid; i < 17 * 64; i += 512) { const int n = i >> 6, p = i & 63; const float mag = expf((float)n * lre[p] * dt), th = (float)n * (lim[p] * dt); AP[i * 2] = mag * cosf(th); AP[i * 2 + 1] = mag * sinf(th); }
    {
        const float* bre = F.in[I_BRE] + (size_t)(layer * NG + g) * SP * SG; const float* bim = F.in[I_BIM] + (size_t)(layer * NG + g) * SP * SG;
        for (int i = tid; i < 1024; i += 512) { const int p = i >> 4; const float lr = lre[p], li = lim[p];
            const float mag = expf(lr * dt), ar = mag * cosf(li * dt), aim = mag * sinf(li * dt), den = lr * lr + li * li, xr = ar - 1.0f;
            const float kr = (xr * lr + aim * li) / den, ki = (aim * lr - xr * li) / den, br = bre[i], bi = bim[i];
            BB[i * 2] = kr * br - ki * bi; BB[i * 2 + 1] = kr * bi + ki * br; }
        const float* cre = F.in[I_CRE] + (size_t)(layer * NG + g) * SG * SP; const float* cim = F.in[I_CIM] + (size_t)(layer * NG + g) * SG * SP;
        for (int i = tid; i < 1024; i += 512) { CC[i * 2] = cre[i]; CC[i * 2 + 1] = cim[i]; }
    }
    __syncthreads();
    for (int i = tid; i < 4096; i += 512) { const int tau = i >> 8, hp = (i >> 4) & 15, h = i & 15; float s = 0.f;
        for (int p = 0; p < 64; ++p) { const float ar = AP[(tau * 64 + p) * 2], ai = AP[(tau * 64 + p) * 2 + 1], br = BB[(p * 16 + h) * 2], bi = BB[(p * 16 + h) * 2 + 1];
            const float tr = ar * br - ai * bi, ti = ar * bi + ai * br; s += CC[(hp * 64 + p) * 2] * tr - CC[(hp * 64 + p) * 2 + 1] * ti; }
        if (tau == 0 && hp == h) s += F.in[I_DSKIP][(layer * NG + g) * SG + h];
        KI[i] = s; }
    __syncthreads();
    bf16_t* wst = wsp<bf16_t>(F, WS_WST) + (size_t)(layer * NG + g) * 256 * 256;
    bf16_t* tw = wsp<bf16_t>(F, WS_TW) + (size_t)(layer * NG + g) * 256 * 384;
    for (int i = tid; i < 256 * 128; i += 512) { const int row = i >> 7, cp = (i & 127) * 2; unsigned o = 0u;
        if (row < 128) { const int p = row >> 1, ri = row & 1; float v[2];
#pragma unroll
            for (int e = 0; e < 2; ++e) { const int col = cp + e, s = col >> 4, h = col & 15; const float ar = AP[((15 - s) * 64 + p) * 2], ai = AP[((15 - s) * 64 + p) * 2 + 1], br = BB[(p * 16 + h) * 2], bi = BB[(p * 16 + h) * 2 + 1];
                v[e] = ri ? (ar * bi + ai * br) : (ar * br - ai * bi); }
            o = pk2(v[0], v[1]); }
        *(unsigned*)(wst + (size_t)row * 256 + cp) = o; }
    for (int i = tid; i < 256 * 192; i += 512) { const int row = i / 192, cp = (i % 192) * 2, j = row >> 4, hp = row & 15; float v[2];
#pragma unroll
        for (int e = 0; e < 2; ++e) { const int col = cp + e;
            if (col < 256) { const int s = col >> 4, h = col & 15; v[e] = (j >= s) ? KI[((j - s) * 16 + hp) * 16 + h] : 0.f; }
            else { const int q = col - 256, p = q >> 1, ri = q & 1; const float ar = AP[((j + 1) * 64 + p) * 2], ai = AP[((j + 1) * 64 + p) * 2 + 1], cr = CC[(hp * 64 + p) * 2], ci = CC[(hp * 64 + p) * 2 + 1];
                v[e] = ri ? -(cr * ai + ci * ar) : (cr * ar - ci * ai); } }
        *(unsigned*)(tw + (size_t)row * 384 + cp) = pk2(v[0], v[1]); }
    float* a16 = wsp<float>(F, WS_A16) + (size_t)(layer * NG + g) * 128;
    for (int i = tid; i < 128; i += 512) a16[i] = AP[16 * 128 + i];
    __syncthreads();
}

__device__ __forceinline__ void prologue(const Frame& F) {
    if (F.tid == 0) {
        LAS XDesc* tab = (LAS XDesc*)(F.lds + LDS_BGTAB); volatile LAS unsigned* MISC = (volatile LAS unsigned*)(F.lds + LDS_MISC);
        int n = 0; unsigned base = 0u;
#define XQ_ADD(SRC, K_, NSRC_, N_, DST, PERML, HALFN, GK, SC, F8_) do { XDesc xd_; xd_.src = (unsigned long long)(SRC); xd_.dst = (unsigned long long)(DST); xd_.gk = (unsigned long long)(GK); xd_.K = (K_); xd_.Nsrc = (NSRC_); xd_.nblk = (N_) / 64; \
        xd_.permlimit = (PERML); xd_.halfN = (HALFN); xd_.f8 = (F8_) ? 1 : 0; xd_.sc = (SC); xd_.base = base; xd_.pad[0] = 0u; xd_.pad[1] = 0u; xd_store(tab + n, xd_); base += (unsigned)(((K_) / 64) * ((N_) / 64)); ++n; } while (0)
#define XQ_MIXER(l) do { \
        XQ_ADD(F.in[I_WIN] + (size_t)(l) * D * INC, D, INC, 1536, wsp<bf16_t>(F, WS_WIN) + (size_t)(l) * INC * D, 1024, 512, F.in[I_NMIXG] + (l) * D, 1.f, false); \
        XQ_ADD(F.in[I_WIN] + (size_t)(l) * D * INC + 1536, D, INC, 2048, wsp<bf16_t>(F, WS_WIN) + (size_t)(l) * INC * D + (size_t)1536 * D, 0, 0, F.in[I_NMIXG] + (l) * D, F8_WGU_SCALE, true); \
        XQ_ADD(F.in[I_WPW] + (size_t)(l) * CW * D, CW, D, D, wsp<bf16_t>(F, WS_WPW) + (size_t)(l) * D * CW, 0, 0, (const float*)nullptr, 1.f, false); \
        XQ_ADD(F.in[I_WGLU] + (size_t)(l) * SW * 2 * D, SW, 2 * D, 2 * D, wsp<bf16_t>(F, WS_WGLU) + (size_t)(l) * 2 * D * SW, 2 * D, D, (const float*)nullptr, 1.f, false); \
        XQ_ADD(F.in[I_WOUT] + (size_t)(l) * D * D, D, D, D, wsp<bf16_t>(F, WS_WOUT) + (size_t)(l) * D * D, 0, 0, (const float*)nullptr, 1.f, false); \
        XQ_ADD(F.in[I_WQ] + (size_t)(l) * D * D, D, D, D, wsp<bf16_t>(F, WS_WQ) + (size_t)(l) * D * D, 0, 0, F.in[I_NXG] + (l) * D, 0.0625f * F8_WQ_SCALE, true); \
        XQ_ADD(F.in[I_WO] + (size_t)(l) * D * D, D, D, D, wsp<bf16_t>(F, WS_WO) + (size_t)(l) * D * D, 0, 0, (const float*)nullptr, F8_WO_SCALE, true); } while (0)
#define XQ_MOE(j) do { for (int e = 0; e < NE; ++e) { \
        XQ_ADD(F.in[I_MGU] + (size_t)((j) * NE + e) * D * 2 * DFE, D, 2 * DFE, 2 * DFE, (unsigned char*)wsp<bf16_t>(F, WS_WMGU) + (size_t)(j) * NE * 2 * DFE * D * 2 + (size_t)e * 2 * DFE * D, 2 * DFE, DFE, F.in[I_NFG] + (2 * (j) + 1) * D, F8_WGU_SCALE, true); \
        XQ_ADD(F.in[I_MD] + (size_t)((j) * NE + e) * DFE * D, DFE, D, D, (unsigned char*)wsp<bf16_t>(F, WS_WMD) + (size_t)(j) * NE * D * DFE * 2 + (size_t)e * D * DFE, 0, 0, (const float*)nullptr, F8_WD_SCALE, true); } } while (0)
        XQ_MIXER(1); XQ_MOE(0); MISC[MI_THR + 0] = base;
        XQ_MIXER(2);
        XQ_ADD(F.in[I_FGU] + (size_t)1 * D * 2 * DFF, D, 2 * DFF, 2 * DFF, wsp<bf16_t>(F, WS_WFGU) + (size_t)1 * 2 * DFF * D, 2 * DFF, DFF, F.in[I_NFG] + 2 * D, F8_WGU_SCALE, true);
        XQ_ADD(F.in[I_FD] + (size_t)1 * DFF * D, DFF, D, D, wsp<bf16_t>(F, WS_WFD) + (size_t)1 * D * DFF, 0, 0, (const float*)nullptr, F8_WD_SCALE, true);
        MISC[MI_THR + 1] = base;
        XQ_MIXER(3); XQ_MOE(1); MISC[MI_THR + 2] = base;
        XDesc sent{}; sent.base = base; xd_store(tab + n, sent);
#undef XQ_MOE
#undef XQ_MIXER
#undef XQ_ADD
    }
    unsigned ib = 0u;
    {
        const int l = 0;
        xpose_matrix(F, F.in[I_WIN] + (size_t)l * D * INC, D, INC, 1536, wsp<bf16_t>(F, WS_WIN) + (size_t)l * INC * D, 1024, 512, F.in[I_NMIXG] + l * D, 1.f, ib);
        xpose_matrix<true>(F, F.in[I_WIN] + (size_t)l * D * INC + 1536, D, INC, 2048, wsp<bf16_t>(F, WS_WIN) + (size_t)l * INC * D + (size_t)1536 * D, 0, 0, F.in[I_NMIXG] + l * D, F8_WGU_SCALE, ib);
        xpose_matrix(F, F.in[I_WPW] + (size_t)l * CW * D, CW, D, D, wsp<bf16_t>(F, WS_WPW) + (size_t)l * D * CW, 0, 0, nullptr, 1.f, ib);
        xpose_matrix(F, F.in[I_WGLU] + (size_t)l * SW * 2 * D, SW, 2 * D, 2 * D, wsp<bf16_t>(F, WS_WGLU) + (size_t)l * 2 * D * SW, 2 * D, D, nullptr, 1.f, ib);
        xpose_matrix(F, F.in[I_WOUT] + (size_t)l * D * D, D, D, D, wsp<bf16_t>(F, WS_WOUT) + (size_t)l * D * D, 0, 0, nullptr, 1.f, ib);
        xpose_matrix<true>(F, F.in[I_WQ] + (size_t)l * D * D, D, D, D, wsp<bf16_t>(F, WS_WQ) + (size_t)l * D * D, 0, 0, F.in[I_NXG] + l * D, 0.0625f * F8_WQ_SCALE, ib);
        xpose_matrix<true>(F, F.in[I_WO] + (size_t)l * D * D, D, D, D, wsp<bf16_t>(F, WS_WO) + (size_t)l * D * D, 0, 0, nullptr, F8_WO_SCALE, ib);
    }
    for (int l = 0; l < DEPTH; ++l) xpose_matrix(F, F.in[I_WKV] + (size_t)l * D * 2 * D, D, 2 * D, 2 * D, wsp<bf16_t>(F, WS_WKV) + (size_t)l * 2 * D * D, 0, 0, nullptr, 1.f, ib);
    xpose_matrix(F, F.in[I_FGU], D, 2 * DFF, 2 * DFF, wsp<bf16_t>(F, WS_WFGU), 2 * DFF, DFF, F.in[I_NFG], 1.f, ib);
    xpose_matrix(F, F.in[I_FD], DFF, D, D, wsp<bf16_t>(F, WS_WFD), 0, 0, nullptr, 1.f, ib);
    const int gw = F.c * 8 + F.wave, NGW = F.G * 8, lane = F.lane;
    { const float* gm = F.in[I_MEMG]; bf16_t* mn = wsp<bf16_t>(F, WS_MEMN);
      for (int r = gw; r < NMEM; r += NGW) { const f32x4* xr = (const f32x4*)(F.in[I_MEM] + (size_t)r * D) + lane; f32x4 v[4]; float s = 0.f;
#pragma unroll
          for (int j = 0; j < 4; ++j) { v[j] = xr[64 * j]; s += (v[j][0] * v[j][0] + v[j][1] * v[j][1]) + (v[j][2] * v[j][2] + v[j][3] * v[j][3]); }
          const float rs = __builtin_amdgcn_rsqf(wave_sum(s) * (1.f / D) + RMS_EPS);
#pragma unroll
          for (int j = 0; j < 4; ++j) { const f32x4 gg = ((const f32x4*)gm)[64 * j + lane]; u32x2 o; o.x = pk2(v[j][0] * rs * gg[0], v[j][1] * rs * gg[1]); o.y = pk2(v[j][2] * rs * gg[2], v[j][3] * rs * gg[3]);
              *((u32x2*)(mn + (size_t)r * D) + 64 * j + lane) = o; } } }
    { bf16_t* h = wsp<bf16_t>(F, WS_H); float* st = wsp<float>(F, WS_STATS); unsigned* h8 = wsp<unsigned>(F, WS_H8);
      for (int r = gw; r < T; r += NGW) { const f32x4* xr = (const f32x4*)(F.in[I_X] + (size_t)r * D) + lane; float s = 0.f;
#pragma unroll
          for (int j = 0; j < 4; ++j) { const f32x4 v = xr[64 * j]; s += (v[0] * v[0] + v[1] * v[1]) + (v[2] * v[2] + v[3] * v[3]); u32x2 o; o.x = pk2(v[0], v[1]); o.y = pk2(v[2], v[3]);
              *((u32x2*)(h + (size_t)r * D) + 64 * j + lane) = o; if (F8_GATES) h8[(size_t)r * (D / 4) + 64 * j + lane] = pk4_fp8(v[0], v[1], v[2], v[3]); }
          s = wave_sum(s);
          if (lane < 4) st[(size_t)r * 4 + lane] = (lane == 0) ? s : 0.f; } }
    for (int it = F.c; it < DEPTH * NG; it += F.G) ssm_tables(F, it / NG, it % NG);
}

__device__ __forceinline__ void conv_phase(const Frame& F, int layer) {
    const bf16_t* uin_g = wsp<bf16_t>(F, WS_UCONV); bf16_t* uc = wsp<bf16_t>(F, WS_UC);
    LAS bf16_t* uin = (LAS bf16_t*)F.lds;
    LAS float* yb = (LAS float*)(F.lds + 65536);
    const int tid = F.tid, lane = F.lane, wave = F.wave;
    float w[CK];
#pragma unroll
    for (int k = 0; k < CK; ++k) w[k] = F.in[I_CONVW][(size_t)(layer * CK + k) * CW + tid];
    const float bias = F.in[I_CONVB][layer * CW + tid];
    f32x4 lg0, lg1, lb0, lb1;
    { const f32x4* gp = (const f32x4*)(F.in[I_LNG] + layer * CW + lane * 8); lg0 = gp[0]; lg1 = gp[1]; const f32x4* bp = (const f32x4*)(F.in[I_LNB] + layer * CW + lane * 8); lb0 = bp[0]; lb1 = bp[1]; }
    for (int tile = F.c; tile < T / 32; tile += F.G) {
        const int t0 = tile * 32, p0 = t0 & (SEQ - 1);
        __syncthreads();
#pragma unroll
        for (int it = 0; it < 8; ++it) { const int id = it * 512 + tid;
            if (id < 62 * 64) { const int row = id >> 6, ch = id & 63; u32x4 v = {0u, 0u, 0u, 0u};
                if (p0 - 30 + row >= 0) v = *(const u32x4*)(uin_g + (size_t)(t0 - 30 + row) * CW + ch * 8);
                *(LAS u32x4*)(uin + row * 512 + ch * 8) = v; } }
        __syncthreads();
        float y[32], uu[62];
#pragma unroll
        for (int o = 0; o < 32; ++o) y[o] = bias;
#pragma unroll
        for (int j = 0; j < 62; ++j) uu[j] = __uint_as_float(((unsigned)uin[j * 512 + tid]) << 16);
#pragma unroll
        for (int k = 0; k < CK; ++k)
#pragma unroll
            for (int o = 0; o < 32; ++o) y[o] += w[k] * uu[o + k];
#pragma unroll
        for (int o = 0; o < 32; ++o) yb[o * 512 + tid] = y[o];
        __syncthreads();
#pragma unroll
        for (int q = 0; q < 4; ++q) { const int o = wave + 8 * q; const LAS f32x4* rp = (const LAS f32x4*)(yb + o * 512 + lane * 8); f32x4 a = rp[0], b = rp[1];
            const float mean = wave_sum((a[0] + a[1]) + (a[2] + a[3]) + (b[0] + b[1]) + (b[2] + b[3])) * (1.f / CW);
            a = a - mean; b = b - mean;
            const float var = wave_sum((a[0] * a[0] + a[1] * a[1]) + (a[2] * a[2] + a[3] * a[3]) + (b[0] * b[0] + b[1] * b[1]) + (b[2] * b[2] + b[3] * b[3])) * (1.f / CW);
            const float rs = __builtin_amdgcn_rsqf(var + LN_EPS);
            a = a * rs * lg0 + lb0; b = b * rs * lg1 + lb1;
#pragma unroll
            for (int i = 0; i < 4; ++i) { a[i] = siluf_(a[i]); b[i] = siluf_(b[i]); }
            *(u32x4*)(uc + (size_t)(t0 + o) * CW + lane * 8) = pack8(a, b); }
    }
    __syncthreads();
}

#define MFMA32(a, b, c) __builtin_amdgcn_mfma_f32_32x32x16_bf16((a), (b), (c), 0, 0, 0)
#define ATT_LOAD16(dst, ptr0, stride_bytes) do { unsigned long long _p = (unsigned long long)(ptr0); _Pragma("unroll") for (int it = 0; it < 16; ++it) { dst[it] = *(const GAS u32x4*)_p; _p += (stride_bytes); asm volatile("" : "+v"(_p)); } } while (0)
#define ATT_STORE16(src) do { LAS char* _w0 = (LAS char*)Ks + (tid >> 5) * 528 + (tid & 31) * 16; asm volatile("" : "+v"(_w0)); LAS char* _w1 = _w0 + 8 * 8448; _Pragma("unroll") for (int it = 0; it < 8; ++it) { *(LAS u32x4*)(_w0 + it * 8448) = src[it]; *(LAS u32x4*)(_w1 + it * 8448) = src[it + 8]; } } while (0)
__device__ __forceinline__ void attn_phase(const Frame& F, int layer) {
    const bf16_t* Q = wsp<bf16_t>(F, WS_Q); const bf16_t* Km = wsp<bf16_t>(F, WS_KMAT) + (size_t)layer * NMEM * D; const bf16_t* Vt = wsp<bf16_t>(F, WS_VT) + (size_t)layer * D * NMEM;
    bf16_t* AO = wsp<bf16_t>(F, WS_AO);
    LAS bf16_t* Ks = (LAS bf16_t*)F.lds;
    const int tid = F.tid, lane = F.lane, wave = F.wave, l31 = lane & 31, lh = lane >> 5;
    constexpr int NU = BATCH * HEADS * (SEQ / 256);
    u32x4 Kr[16];
    if (F.c < NU) { const int bh = F.c & 31, b = bh >> 2, hd = bh & 3;
        ATT_LOAD16(Kr, Km + (size_t)(b * MEM + (tid >> 5)) * D + hd * HD + (tid & 31) * 8, 16 * D * 2); }
    for (int unit = F.c; unit < NU; unit += F.G) {
        const int bh = unit & 31, qt = unit >> 5, b = bh >> 2, hd = bh & 3;
        const size_t qrow = (size_t)b * SEQ + qt * 256 + wave * 32 + l31;
        bf16x8 Qf[16];
#pragma unroll
        for (int db = 0; db < 16; ++db) Qf[db] = *(const bf16x8*)(Q + qrow * D + hd * HD + db * 16 + lh * 8);
        __syncthreads();
        ATT_STORE16(Kr);
        ATT_LOAD16(Kr, Vt + (size_t)(hd * HD + (tid >> 5)) * NMEM + b * MEM + (tid & 31) * 8, 16 * NMEM * 2);
        __syncthreads();
        u32x4 sp[8][2];
        float mx = -3.0e38f;
#pragma unroll
        for (int kb = 0; kb < 8; ++kb) {
            f32x16 sc;
#pragma unroll
            for (int i = 0; i < 16; ++i) sc[i] = 0.f;
#pragma unroll
            for (int db = 0; db < 16; ++db) { const bf16x8 a = *(const LAS bf16x8*)(Ks + (kb * 32 + l31) * 264 + db * 16 + lh * 8); sc = MFMA32(a, Qf[db], sc); }
#pragma unroll
            for (int i = 0; i < 16; ++i) mx = fmaxf(mx, sc[i]);
#pragma unroll
            for (int hh = 0; hh < 2; ++hh) { sp[kb][hh].x = pk2(sc[8 * hh + 0], sc[8 * hh + 1]); sp[kb][hh].y = pk2(sc[8 * hh + 2], sc[8 * hh + 3]); sp[kb][hh].z = pk2(sc[8 * hh + 4], sc[8 * hh + 5]); sp[kb][hh].w = pk2(sc[8 * hh + 6], sc[8 * hh + 7]); }
        }
        mx = fmaxf(mx, __shfl_xor(mx, 32));
        float sum = 0.f;
        bf16x8 Pf[16];
#pragma unroll
        for (int kb = 0; kb < 8; ++kb)
#pragma unroll
            for (int hh = 0; hh < 2; ++hh) { f32x4 a, bq; unpack8(sp[kb][hh], a, bq);
#pragma unroll
                for (int i = 0; i < 4; ++i) { a[i] = fast_exp2((a[i] - mx) * 1.44269504f); bq[i] = fast_exp2((bq[i] - mx) * 1.44269504f); sum += a[i] + bq[i]; }
                Pf[kb * 2 + hh] = __builtin_bit_cast(bf16x8, pack8(a, bq)); }
        sum += __shfl_xor(sum, 32);
        const float inv = 1.0f / sum;
        __syncthreads();
        ATT_STORE16(Kr);
        if (unit + F.G < NU) { const int nbh = (unit + F.G) & 31, nb = nbh >> 2, nhd = nbh & 3;
            ATT_LOAD16(Kr, Km + (size_t)(nb * MEM + (tid >> 5)) * D + nhd * HD + (tid & 31) * 8, 16 * D * 2); }
        __syncthreads();
#pragma unroll
        for (int db = 0; db < 8; ++db) {
            f32x16 o;
#pragma unroll
            for (int i = 0; i < 16; ++i) o[i] = 0.f;
#pragma unroll
            for (int kk = 0; kk < 16; ++kk) { const LAS bf16_t* base = Ks + (db * 32 + l31) * 264 + kk * 16 + 4 * lh;
                const u32x2 lo = *(const LAS u32x2*)base, hi = *(const LAS u32x2*)(base + 8);
                u32x4 w; w.x = lo.x; w.y = lo.y; w.z = hi.x; w.w = hi.y;
                o = MFMA32(__builtin_bit_cast(bf16x8, w), Pf[kk], o); }
#pragma unroll
            for (int g4 = 0; g4 < 4; ++g4) {
                if (F8_QO) *(unsigned*)((unsigned char*)AO + qrow * D + hd * HD + db * 32 + 8 * g4 + 4 * lh) = pk4_fp8(o[4 * g4 + 0] * (inv * F8_AO_SCALE), o[4 * g4 + 1] * (inv * F8_AO_SCALE), o[4 * g4 + 2] * (inv * F8_AO_SCALE), o[4 * g4 + 3] * (inv * F8_AO_SCALE));
                else { u32x2 w; w.x = pk2(o[4 * g4 + 0] * inv, o[4 * g4 + 1] * inv); w.y = pk2(o[4 * g4 + 2] * inv, o[4 * g4 + 3] * inv); *(u32x2*)(AO + qrow * D + hd * HD + db * 32 + 8 * g4 + 4 * lh) = w; } }
        }
    }
    __syncthreads();
}

__device__ __forceinline__ void router_phase(const Frame& F, int layer, int j) {
    const bf16_t* h = wsp<bf16_t>(F, WS_H);
    unsigned* toke = (unsigned*)(F.ws + WS_META + MT_TOKE); float* tokw = (float*)(F.ws + WS_META + MT_TOKW); float* tokr = (float*)(F.ws + WS_META + MT_TOKR); int* wgcnt = (int*)(F.ws + WS_META + MT_WGCNT);
    LAS int* cnt = (LAS int*)(F.lds + LDS_AUX);
    const int lane = F.lane, wave = F.wave, tid = F.tid;
    float wr_[16][8];
    { const float* rw = F.in[I_RW] + (size_t)j * D * NE; const float* gg = F.in[I_NFG] + (size_t)layer * D;
#pragma unroll
      for (int kk = 0; kk < 16; ++kk) { const int k = lane * 16 + kk; const f32x4 a = *(const f32x4*)(rw + (size_t)k * NE), b = *(const f32x4*)(rw + (size_t)k * NE + 4); const float g = gg[k];
#pragma unroll
          for (int e = 0; e < 4; ++e) { wr_[kk][e] = a[e] * g; wr_[kk][4 + e] = b[e] * g; } } }
    float rb[8];
#pragma unroll
    for (int e = 0; e < 8; ++e) rb[e] = F.in[I_RB][j * NE + e];
    for (int chunk = F.c; chunk < T / 128; chunk += F.G) {
        __syncthreads();
        if (tid < 8) cnt[tid] = 0;
        __syncthreads();
        for (int i = 0; i < 16; ++i) {
            const int tok = chunk * 128 + wave * 16 + i;
            const u32x4 q0 = *(const u32x4*)(h + (size_t)tok * D + lane * 16), q1 = *(const u32x4*)(h + (size_t)tok * D + lane * 16 + 8);
            float x[16]; { f32x4 a, b, c, d; unpack8(q0, a, b); unpack8(q1, c, d);
#pragma unroll
                for (int e = 0; e < 4; ++e) { x[e] = a[e]; x[4 + e] = b[e]; x[8 + e] = c[e]; x[12 + e] = d[e]; } }
            float ss = 0.f, dt[8];
#pragma unroll
            for (int e = 0; e < 8; ++e) dt[e] = 0.f;
#pragma unroll
            for (int kk = 0; kk < 16; ++kk) { ss += x[kk] * x[kk];
#pragma unroll
                for (int e = 0; e < 8; ++e) dt[e] += x[kk] * wr_[kk][e]; }
            ss = wave_sum(ss);
#pragma unroll
            for (int e = 0; e < 8; ++e) dt[e] = wave_sum(dt[e]);
            const float r = __builtin_amdgcn_rsqf(ss * (1.f / D) + RMS_EPS);
            float v1 = -3.0e38f, v2 = -3.0e38f; int e1 = 0, e2 = 0;
#pragma unroll
            for (int e = 0; e < 8; ++e) { const float lg = dt[e] * r + rb[e]; if (lg > v1) { v2 = v1; e2 = e1; v1 = lg; e1 = e; } else if (lg > v2) { v2 = lg; e2 = e; } }
            const float w1 = 1.0f / (1.0f + __expf(v2 - v1)), w2 = 1.0f - w1;
            if (lane == 0) { toke[tok] = (unsigned)e1 | ((unsigned)e2 << 8); tokw[2 * tok] = w1; tokw[2 * tok + 1] = w2; tokr[tok] = r;
                atomicAdd((int*)&cnt[e1], 1); atomicAdd((int*)&cnt[e2], 1); }
        }
        __syncthreads();
        if (tid < 8) wgcnt[chunk * 8 + tid] = cnt[tid];
    }
    __syncthreads();
}
template <bool F8>
__device__ __forceinline__ void assign_phase(const Frame& F) {
    const bf16_t* h = wsp<bf16_t>(F, WS_H); bf16_t* hs = wsp<bf16_t>(F, WS_HS);
    const unsigned* toke = (const unsigned*)(F.ws + WS_META + MT_TOKE); const float* tokw = (const float*)(F.ws + WS_META + MT_TOKW); const float* tokr = (const float*)(F.ws + WS_META + MT_TOKR);
    int* tokslot = (int*)(F.ws + WS_META + MT_TOKSLOT); float* rscale = (float*)(F.ws + WS_META + MT_RSCALE); float* gwt = (float*)(F.ws + WS_META + MT_GWT);
    const int* wgcnt = (const int*)(F.ws + WS_META + MT_WGCNT); int* pexp = (int*)(F.ws + WS_META + MT_PEXP); unsigned* ctl = (unsigned*)(F.ws + WS_CTL);
    LAS int* cl = (LAS int*)(F.lds);
    LAS int* tot = (LAS int*)(F.lds + 8192);
    LAS int* sl = (LAS int*)(F.lds + 8192 + 256);
    const int tid = F.tid, lane = F.lane, wave = F.wave;
    for (int chunk = F.c; chunk < T / 128; chunk += F.G) {
        __syncthreads();
        for (int i = tid; i < 2048; i += 512) cl[i] = wgcnt[i];
        __syncthreads();
        if (tid < 8) { int s = 0, pre = 0; for (int q = 0; q < 256; ++q) { if (q == chunk) pre = s; s += cl[q * 8 + tid]; } tot[tid] = s; tot[8 + tid] = pre; }
        __syncthreads();
        if (tid == 0) { int base = 0; for (int e = 0; e < 8; ++e) { tot[16 + e] = base; tot[24 + e] = base + tot[8 + e]; base += (tot[e] + 255) & ~255; }
            if (chunk == 0) { ctl[CW_PTOTAL] = (unsigned)(base >> 8); int pp = 0; for (int e = 0; e < 8; ++e) { ctl[CW_PBASE + e] = (unsigned)(tot[16 + e] >> 8); const int np = (tot[e] + 255) >> 8; for (int q = 0; q < np; ++q) pexp[pp++] = e; } } }
        __syncthreads();
        if (chunk == 0) {
            for (int e = 0; e < 8; ++e) { const int lo = tot[16 + e] + tot[e], hi = tot[16 + e] + ((tot[e] + 255) & ~255);
                for (int s = lo + tid; s < hi; s += 512) { rscale[s] = 0.f; gwt[s] = 0.f; } } }
        if (wave == 0) {
            for (int it = 0; it < 2; ++it) { const int li = it * 64 + lane, tok = chunk * 128 + li; const unsigned ee = toke[tok]; const int e1 = ee & 255, e2 = (ee >> 8) & 255; int s1 = 0, s2 = 0;
                const unsigned long long ltmask = (1ull << lane) - 1ull;
#pragma unroll
                for (int e = 0; e < 8; ++e) { const unsigned long long m1 = __ballot(e1 == e), m2 = __ballot(e2 == e); const int off = tot[24 + e];
                    if (e1 == e) s1 = off + __popcll(m1 & ltmask);
                    if (e2 == e) s2 = off + __popcll(m1) + __popcll(m2 & ltmask);
                    __builtin_amdgcn_s_waitcnt(0);
                    if (lane == 0) tot[24 + e] = off + __popcll(m1) + __popcll(m2);
                    __builtin_amdgcn_s_waitcnt(0); }
                sl[li * 2] = s1; sl[li * 2 + 1] = s2; tokslot[2 * tok] = s1; tokslot[2 * tok + 1] = s2;
                const float r = tokr[tok]; rscale[s1] = r; rscale[s2] = r; gwt[s1] = tokw[2 * tok]; gwt[s2] = tokw[2 * tok + 1]; }
        }
        __syncthreads();
        for (int q = wave; q < 256; q += 8) { const int li = q >> 1, tok = chunk * 128 + li, s = sl[q];
            const u32x4 a = *(const u32x4*)(h + (size_t)tok * D + lane * 16), b = *(const u32x4*)(h + (size_t)tok * D + lane * 16 + 8);
            if (F8) { f32x4 x0, x1, x2, x3; unpack8(a, x0, x1); unpack8(b, x2, x3); u32x4 o8; o8.x = pk4_fp8(x0[0], x0[1], x0[2], x0[3]); o8.y = pk4_fp8(x1[0], x1[1], x1[2], x1[3]); o8.z = pk4_fp8(x2[0], x2[1], x2[2], x2[3]); o8.w = pk4_fp8(x3[0], x3[1], x3[2], x3[3]);
                *(u32x4*)((unsigned char*)hs + (size_t)s * D + lane * 16) = o8; }
            else { *(u32x4*)(hs + (size_t)s * D + lane * 16) = a; *(u32x4*)(hs + (size_t)s * D + lane * 16 + 8) = b; } }
    }
    __syncthreads();
}
__device__ __forceinline__ void combine_phase(const Frame& F, bool final_) {
    bf16_t* h = wsp<bf16_t>(F, WS_H); const bf16_t* ye = wsp<bf16_t>(F, WS_YE); const int* tokslot = (const int*)(F.ws + WS_META + MT_TOKSLOT); float* st = wsp<float>(F, WS_STATS);
    const int gw = F.c * 8 + F.wave, NGW = F.G * 8, lane = F.lane;
    for (int tok = gw; tok < T; tok += NGW) {
        const int s1 = tokslot[2 * tok], s2 = tokslot[2 * tok + 1];
        f32x4 x[4], y[4], z[4];
        unpack8(*(const u32x4*)(h + (size_t)tok * D + lane * 16), x[0], x[1]); unpack8(*(const u32x4*)(h + (size_t)tok * D + lane * 16 + 8), x[2], x[3]);
        unpack8(*(const u32x4*)(ye + (size_t)s1 * D + lane * 16), y[0], y[1]); unpack8(*(const u32x4*)(ye + (size_t)s1 * D + lane * 16 + 8), y[2], y[3]);
        unpack8(*(const u32x4*)(ye + (size_t)s2 * D + lane * 16), z[0], z[1]); unpack8(*(const u32x4*)(ye + (size_t)s2 * D + lane * 16 + 8), z[2], z[3]);
        float ss = 0.f;
#pragma unroll
        for (int q = 0; q < 4; ++q) { x[q] = x[q] + y[q] + z[q]; ss += (x[q][0] * x[q][0] + x[q][1] * x[q][1]) + (x[q][2] * x[q][2] + x[q][3] * x[q][3]); }
        ss = wave_sum(ss);
        if (final_) { const float r = __builtin_amdgcn_rsqf(ss * (1.f / D) + RMS_EPS); const f32x4* gp = (const f32x4*)(F.in[I_FINALG] + lane * 16); f32x4* op = (f32x4*)(F.out + (size_t)tok * D + lane * 16);
#pragma unroll
            for (int q = 0; q < 4; ++q) op[q] = x[q] * r * gp[q]; }
        else { *(u32x4*)(h + (size_t)tok * D + lane * 16) = pack8(x[0], x[1]); *(u32x4*)(h + (size_t)tok * D + lane * 16 + 8) = pack8(x[2], x[3]);
            if (F8_GATES) { u32x4 o8; o8.x = pk4_fp8(x[0][0], x[0][1], x[0][2], x[0][3]); o8.y = pk4_fp8(x[1][0], x[1][1], x[1][2], x[1][3]); o8.z = pk4_fp8(x[2][0], x[2][1], x[2][2], x[2][3]); o8.w = pk4_fp8(x[3][0], x[3][1], x[3][2], x[3][3]); *(u32x4*)(F.ws + WS_H8 + (size_t)tok * D + lane * 16) = o8; }
            if (lane < 4) st[(size_t)tok * 4 + lane] = (lane == 0) ? ss : 0.f; }
    }
}

struct SchedKV {
    int G, c; const char* memn; const char* wkv;
    __device__ __forceinline__ bool next(int i, Unit& u) const { const int L = i * G + c; if (L >= 256) return false; const int layer = L >> 6, r = L & 63; const char* w = wkv + (size_t)layer * 2 * D * D * 2;
        if (r < 32) { u.pm = r >> 2; u.pn = r & 3; u.tag = layer * 2; u.A = memn + (size_t)u.pm * 256 * D * 2; u.B = w + (size_t)u.pn * 256 * D * 2; }
        else { const int q = r - 32; u.pm = q >> 3; u.pn = q & 7; u.tag = layer * 2 + 1; u.A = w + (size_t)(D + u.pm * 256) * D * 2; u.B = memn + (size_t)u.pn * 256 * D * 2; }
        return true; }
    __device__ __forceinline__ void a_ready(const Unit&) const {}
    __device__ __forceinline__ void done(const Unit&) const {}
};
struct SchedMoe {
    pg8::StaticOrder o; const char* A; const char* B; size_t sA, sB, sE; int pb1, pb2, pb3, pb4, pb5, pb6, pb7;
    __device__ __forceinline__ void load_bases(const unsigned* ctl) {
        pb1 = __builtin_amdgcn_readfirstlane((int)ctl[CW_PBASE + 1]); pb2 = __builtin_amdgcn_readfirstlane((int)ctl[CW_PBASE + 2]); pb3 = __builtin_amdgcn_readfirstlane((int)ctl[CW_PBASE + 3]); pb4 = __builtin_amdgcn_readfirstlane((int)ctl[CW_PBASE + 4]);
        pb5 = __builtin_amdgcn_readfirstlane((int)ctl[CW_PBASE + 5]); pb6 = __builtin_amdgcn_readfirstlane((int)ctl[CW_PBASE + 6]); pb7 = __builtin_amdgcn_readfirstlane((int)ctl[CW_PBASE + 7]); }
    __device__ __forceinline__ bool next(int i, Unit& u) const { int pm, pn; if (!o.next(i, pm, pn)) return false;
        const int e = (pm >= pb1) + (pm >= pb2) + (pm >= pb3) + (pm >= pb4) + (pm >= pb5) + (pm >= pb6) + (pm >= pb7);
        u.pm = pm; u.pn = pn; u.tag = 0; u.A = A + (size_t)pm * sA; u.B = B + (size_t)e * sE + (size_t)pn * sB; return true; }
    __device__ __forceinline__ void a_ready(const Unit&) const {}
    __device__ __forceinline__ void done(const Unit&) const {}
};

__device__ __forceinline__ void xcd_barrier_bg(const XcdBarrier& b, const Frame& F) {
    volatile LAS unsigned* MISC = (volatile LAS unsigned*)(F.lds + LDS_MISC);
    const unsigned want = MISC[MI_SEQ] + 1u;
    asm volatile("s_waitcnt vmcnt(0)" ::: "memory");
    __syncthreads();
    const unsigned limit = MISC[MI_THR + 2];
    if (F.wave == 0) {
        if (F.tid == 0) {
            unsigned* bar = b.bar;
            __builtin_amdgcn_s_waitcnt(0);
            unsigned nloc = b.st[0], nx = b.st[1];
            if (nloc == 0u) { xcd_barrier_complete(bar, b.x, nloc, nx); b.st[0] = nloc; b.st[1] = nx; }
            const unsigned old = xb_add(&bar[XB_XSUB(b.x)], 1u);
            const unsigned gen = old / nloc;
            if (old + 1u == (gen + 1u) * nloc) {
                __builtin_amdgcn_fence(__ATOMIC_RELEASE, "agent");
                asm volatile("s_waitcnt vmcnt(0)" ::: "memory");
                const unsigned og = xb_add(&bar[XB_TOP], 1u);
                const unsigned tg = og / nx;
                if (og + 1u == (tg + 1u) * nx) xb_add(&bar[XB_TOPGEN], 1u);
                else XB_SPIN(xb_ld(&bar[XB_TOPGEN]) == tg, bar);
                __builtin_amdgcn_fence(__ATOMIC_ACQUIRE, "agent");
                xb_add(&bar[XB_XGEN(b.x)], 1u);
                asm volatile("s_waitcnt vmcnt(0)" ::: "memory");
            } else {
                XB_SPIN(xb_ld(&bar[XB_XGEN(b.x)]) == gen, bar);
                __builtin_amdgcn_fence(__ATOMIC_ACQUIRE, "agent");
                asm volatile("s_waitcnt vmcnt(0)" ::: "memory");
            }
            MISC[MI_SEQ] = want;
        }
    } else {
        while (MISC[MI_SEQ] != want) { if (!bg_try(F, limit)) break; }
    }
    __syncthreads();
}

constexpr int NPH_LAYER = 13, PH_LAYER0 = 2, NPHASES = PH_LAYER0 + DEPTH * NPH_LAYER;
extern __shared__ __attribute__((aligned(16))) unsigned char lds_raw[];
struct PA { unsigned char* ws; const float* const* in; float* out; int layer; };
__device__ __forceinline__ unsigned long long uni64(unsigned long long v) { const unsigned lo = __builtin_amdgcn_readfirstlane((unsigned)v), hi = __builtin_amdgcn_readfirstlane((unsigned)(v >> 32)); return ((unsigned long long)hi << 32) | lo; }
__device__ __forceinline__ Frame mkframe(const PA a) {
    Frame P; P.lds = (LAS unsigned char*)lds_raw; P.tid = threadIdx.x; asm volatile("" : "+v"(P.tid)); P.lane = P.tid & 63; P.wave = __builtin_amdgcn_readfirstlane(P.tid >> 6); P.c = blockIdx.x; P.G = gridDim.x;
    { typedef __attribute__((address_space(4))) const char* kptr_t; kptr_t kp = (kptr_t)__builtin_amdgcn_kernarg_segment_ptr(); asm volatile("" : "+s"(kp));
      P.ws = *(unsigned char* const __attribute__((address_space(4)))*)(kp + __builtin_offsetof(Args, ws)); (void)a.ws; }
    P.in = a.in; P.out = a.out; return P;
}
#define ST_A (wsp<float>(P, WS_STATS))
#define ST_B (wsp<float>(P, WS_STATS) + (size_t)T * 16)
#define ST_C (wsp<float>(P, WS_STATS) + (size_t)T * 32)
#define H_ (wsp<bf16_t>(P, WS_H))
#define PH_HEAD const Frame P = mkframe(a); const int layer = a.layer, c = P.c, G = P.G, jj = layer >> 1; LAS unsigned char* lds = P.lds; (void)layer; (void)c; (void)G; (void)jj; (void)lds;

__device__ __forceinline__ void ph_prologue(const PA a) { PH_HEAD prologue(P); }
__device__ __forceinline__ void ph_kv(const PA a) { PH_HEAD
    SchedKV S{G, c, (const char*)wsp<bf16_t>(P, WS_MEMN), (const char*)wsp<bf16_t>(P, WS_WKV)};
    EpiPlain E{wsp<bf16_t>(P, WS_KMAT), wsp<bf16_t>(P, WS_VT), D, NMEM, (size_t)NMEM * D, (size_t)D * NMEM};
    pg8::gemm_phase<EpiPlain, SchedKV, false, true>(lds, D, D, D, S, E, (const char*)P.ws);
}
__device__ __forceinline__ void ph_inproj(const PA a) { PH_HEAD
    pg8::SchedStd S; S.o.init(T / 256, (F8_GATES ? 1536 : INC) / 256, G, c); S.A = (const char*)H_; S.B = (const char*)(wsp<bf16_t>(P, WS_WIN) + (size_t)layer * INC * D); S.sA = (size_t)256 * D * 2; S.sB = (size_t)256 * D * 2;
    EpiInproj E{ST_A, wsp<bf16_t>(P, WS_UCONV), wsp<bf16_t>(P, WS_XU), wsp<bf16_t>(P, WS_GATES)};
    pg8::gemm_phase<EpiInproj, pg8::SchedStd, true, true>(lds, D, D, D, S, E, (const char*)P.ws);
}
__device__ __forceinline__ void ph_inproj_gates(const PA a) { PH_HEAD
    pg8::SchedStd S; S.o.init(T / 256, 2048 / 256, G, c); S.A = (const char*)wsp<unsigned char>(P, WS_H8); S.B = (const char*)(wsp<bf16_t>(P, WS_WIN) + (size_t)layer * INC * D + (size_t)1536 * D); S.sA = (size_t)256 * D; S.sB = (size_t)256 * D;
    EpiGates E{ST_A, wsp<bf16_t>(P, WS_GATES), 1.0f / F8_WGU_SCALE};
    pg8::gemm_phase<EpiGates, pg8::SchedStd, true, true, true>(lds, D, D, D, S, E, (const char*)P.ws);
}
__device__ __forceinline__ void ph_conv(const PA a) { PH_HEAD conv_phase(P, layer); }
__device__ __forceinline__ void ph_ssm1(const PA a) { PH_HEAD
    if (c < BATCH * NG) {
        const int unit = c, g = (unit & 7) * 4 + ((unit >> 3) & 3), b = unit >> 5, ug = b * NG + g;
        bf16_t* xu = wsp<bf16_t>(P, WS_XU) + (size_t)ug * 256 * 384;
        pg8::SchedOne S; S.u0.pm = 0; S.u0.pn = 0; S.u0.tag = 0; S.u0.A = (const char*)xu; S.u0.B = (const char*)(wsp<bf16_t>(P, WS_WST) + (size_t)(layer * NG + g) * 256 * 256);
        EpiSsm1 E{wsp<float>(P, WS_A16) + (size_t)(layer * NG + g) * 128, xu};
        pg8::gemm_phase<EpiSsm1, pg8::SchedOne, false, true>(lds, 256, 384, 256, S, E, (const char*)P.ws);
        VM_WAIT(); __syncthreads(); __builtin_amdgcn_fence(__ATOMIC_ACQUIRE, "agent"); VM_WAIT(); __syncthreads();
    }
}
__device__ __forceinline__ void ph_ssm2(const PA a) { PH_HEAD
    if (c < BATCH * NG) {
        const int unit = c, g = (unit & 7) * 4 + ((unit >> 3) & 3), b = unit >> 5, ug = b * NG + g;
        bf16_t* xu = wsp<bf16_t>(P, WS_XU) + (size_t)ug * 256 * 384;
        pg8::SchedOne S; S.u0.pm = 0; S.u0.pn = 0; S.u0.tag = 0; S.u0.A = (const char*)xu; S.u0.B = (const char*)(wsp<bf16_t>(P, WS_TW) + (size_t)(layer * NG + g) * 256 * 384);
        EpiSsm2 E{wsp<bf16_t>(P, WS_YS), b, g};
        pg8::gemm_phase<EpiSsm2, pg8::SchedOne, false, true>(lds, 384, 384, 384, S, E, (const char*)P.ws);
        __syncthreads();
    }
}
__device__ __forceinline__ void ph_zpw(const PA a) { PH_HEAD
    SchedZPW S; S.o.init(T / 256, D / 256, G, c); S.ys = (const char*)wsp<bf16_t>(P, WS_YS); S.uc = (const char*)wsp<bf16_t>(P, WS_UC);
    S.wglu = (const char*)(wsp<bf16_t>(P, WS_WGLU) + (size_t)layer * 2 * D * SW); S.wpw = (const char*)(wsp<bf16_t>(P, WS_WPW) + (size_t)layer * D * CW);
    EpiZPW E{EpiZ{wsp<bf16_t>(P, WS_GATES), wsp<bf16_t>(P, WS_MB)}, EpiPw{wsp<bf16_t>(P, WS_GATES), wsp<bf16_t>(P, WS_MB), wsp<bf16_t>(P, WS_MERGED)}};
    pg8::gemm_phase<EpiZPW, SchedZPW, true, true>(lds, SW, SW, SW, S, E, (const char*)P.ws);
}
template <bool H8OUT> __device__ __forceinline__ void ph_res_out(const PA a) { PH_HEAD
    pg8::SchedStd S; S.o.init(T / 256, D / 256, G, c); S.A = (const char*)wsp<bf16_t>(P, WS_MERGED); S.B = (const char*)(wsp<bf16_t>(P, WS_WOUT) + (size_t)layer * D * D); S.sA = (size_t)256 * D * 2; S.sB = (size_t)256 * D * 2;
    EpiRes<H8OUT, false> E{H_, ST_B, H_, wsp<unsigned char>(P, WS_H8), lds};
    pg8::gemm_phase<EpiRes<H8OUT, false>, pg8::SchedStd, true, true>(lds, D, D, D, S, E, (const char*)P.ws);
}
template <bool H8OUT> __device__ __forceinline__ void ph_res_o(const PA a) { PH_HEAD
    constexpr bool F8 = F8_QO != 0; constexpr int ES = F8 ? 1 : 2;
    pg8::SchedStd S; S.o.init(T / 256, D / 256, G, c); S.A = (const char*)wsp<bf16_t>(P, WS_AO); S.B = (const char*)(wsp<bf16_t>(P, WS_WO) + (size_t)layer * D * D); S.sA = (size_t)256 * D * ES; S.sB = (size_t)256 * D * ES;
    EpiRes<H8OUT, F8> E{H_, ST_C, H_, wsp<unsigned char>(P, WS_H8), lds};
    pg8::gemm_phase<EpiRes<H8OUT, F8>, pg8::SchedStd, true, true, F8>(lds, D, D, D, S, E, (const char*)P.ws);
}
struct SchedQ {
    int G, c; const char* h; const char* wq; int es;
    __device__ __forceinline__ bool next(int i, Unit& u) const { const int L = i * G + c; if (L >= BATCH * HEADS * (SEQ / 256)) return false; const int bh = L & 31, qt = L >> 5, b = bh >> 2, hd = bh & 3;
        u.pm = b * 16 + qt; u.pn = hd; u.tag = 0; u.A = h + (size_t)u.pm * 256 * D * es; u.B = wq + (size_t)hd * 256 * D * es; return true; }
    __device__ __forceinline__ void a_ready(const Unit&) const {}
    __device__ __forceinline__ void done(const Unit&) const {}
};
__device__ __forceinline__ void ph_q(const PA a) { PH_HEAD
    constexpr bool F8 = F8_QO != 0;
    SchedQ S{G, c, F8 ? (const char*)wsp<unsigned char>(P, WS_H8) : (const char*)H_, (const char*)(wsp<bf16_t>(P, WS_WQ) + (size_t)layer * D * D), F8 ? 1 : 2};
    EpiQ E{ST_B, wsp<bf16_t>(P, WS_Q), F8 ? 1.0f / F8_WQ_SCALE : 1.0f};
    pg8::gemm_phase<EpiQ, SchedQ, true, true, F8>(lds, D, D, D, S, E, (const char*)P.ws);
    VM_WAIT(); __syncthreads();
}
__device__ __forceinline__ void ph_attn(const PA a) { PH_HEAD attn_phase(P, layer); }
template <bool F8> __device__ __forceinline__ void ph_fgu(const PA a) { PH_HEAD
    constexpr int ES = F8 ? 1 : 2;
    pg8::SchedStd S; S.o.init(T / 256, 2 * DFF / 256, G, c); S.A = F8 ? (const char*)wsp<unsigned char>(P, WS_H8) : (const char*)H_; S.B = (const char*)(wsp<bf16_t>(P, WS_WFGU) + (size_t)jj * 2 * DFF * D); S.sA = (size_t)256 * D * ES; S.sB = (size_t)256 * D * ES;
    EpiGU<false, F8> E{ST_C, nullptr, wsp<bf16_t>(P, WS_ACT), DFF};
    pg8::gemm_phase<EpiGU<false, F8>, pg8::SchedStd, true, true, F8>(lds, D, D, D, S, E, (const char*)P.ws);
}
template <bool F8> __device__ __forceinline__ void ph_fdown(const PA a, const bool dry = false) { PH_HEAD
    constexpr int ES = F8 ? 1 : 2;
    pg8::SchedStd S; S.o.init(T / 256, D / 256, G, c); S.A = (const char*)wsp<bf16_t>(P, WS_ACT); S.B = (const char*)(wsp<bf16_t>(P, WS_WFD) + (size_t)jj * D * DFF); S.sA = (size_t)256 * DFF * ES; S.sB = (size_t)256 * DFF * ES;
    EpiRes<(F8_GATES != 0), F8> E{H_, dry ? wsp<float>(P, WS_UCONV) : ST_A, dry ? wsp<bf16_t>(P, WS_Q) : H_, wsp<unsigned char>(P, WS_H8), lds};
    pg8::gemm_phase<EpiRes<(F8_GATES != 0), F8>, pg8::SchedStd, true, true, F8>(lds, DFF, DFF, DFF, S, E, (const char*)P.ws);
}
__device__ __forceinline__ void ph_router(const PA a) { PH_HEAD router_phase(P, layer, jj); }
template <bool F8> __device__ __forceinline__ void ph_assign(const PA a) { PH_HEAD assign_phase<F8>(P); }
template <bool F8> __device__ __forceinline__ void ph_mgu(const PA a) { PH_HEAD
    constexpr int ES = F8 ? 1 : 2;
    const int ptot = (int)__hip_atomic_load((unsigned*)(P.ws + WS_CTL) + CW_PTOTAL, __ATOMIC_RELAXED, __HIP_MEMORY_SCOPE_AGENT);
    SchedMoe S; S.o.init(__builtin_amdgcn_readfirstlane(ptot), 2 * DFE / 256, G, c); S.A = (const char*)wsp<bf16_t>(P, WS_HS); S.B = (const char*)(wsp<bf16_t>(P, WS_WMGU) + (size_t)jj * NE * 2 * DFE * D);
    S.sA = (size_t)256 * D * ES; S.sB = (size_t)256 * D * ES; S.sE = (size_t)2 * DFE * D * ES; S.load_bases((const unsigned*)(P.ws + WS_CTL));
    EpiGU<true, F8> E{(const float*)(P.ws + WS_META + MT_RSCALE), (const float*)(P.ws + WS_META + MT_GWT), wsp<bf16_t>(P, WS_ACT), DFE};
    pg8::gemm_phase<EpiGU<true, F8>, SchedMoe, true, true, F8>(lds, D, D, D, S, E, (const char*)P.ws);
}
template <bool F8> __device__ __forceinline__ void ph_mdown(const PA a) { PH_HEAD
    constexpr int ES = F8 ? 1 : 2;
    const int ptot = (int)__hip_atomic_load((unsigned*)(P.ws + WS_CTL) + CW_PTOTAL, __ATOMIC_RELAXED, __HIP_MEMORY_SCOPE_AGENT);
    SchedMoe S; S.o.init(__builtin_amdgcn_readfirstlane(ptot), D / 256, G, c); S.A = (const char*)wsp<bf16_t>(P, WS_ACT); S.B = (const char*)(wsp<bf16_t>(P, WS_WMD) + (size_t)jj * NE * D * DFE);
    S.sA = (size_t)256 * DFE * ES; S.sB = (size_t)256 * DFE * ES; S.sE = (size_t)D * DFE * ES; S.load_bases((const unsigned*)(P.ws + WS_CTL));
    EpiPlain E{wsp<bf16_t>(P, WS_YE), wsp<bf16_t>(P, WS_YE), D, D, 0, 0, F8 ? 1.0f / (F8_WD_SCALE * F8_ACT_SCALE) : 1.0f};
    pg8::gemm_phase<EpiPlain, SchedMoe, true, true, F8>(lds, DFE, DFE, DFE, S, E, (const char*)P.ws);
}
__device__ __forceinline__ void ph_combine(const PA a) { PH_HEAD combine_phase(P, layer == DEPTH - 1); }

__global__ void __launch_bounds__(512, 2) fwd(Args args) {
    LAS unsigned char* lds = (LAS unsigned char*)lds_raw;
    volatile LAS unsigned* MISC = (volatile LAS unsigned*)(lds + LDS_MISC);
    if (threadIdx.x < 64) MISC[threadIdx.x] = 0u;
    __syncthreads();
    const int lo = args.ph_lo, hi = args.ph_hi;
    unsigned* barw = (unsigned*)(args.ws + WS_CTL) + CW_BAR;
    XcdBarrier bar; bar.bar = barw; bar.x = 0; bar.st = MISC + 8;
    if (hi - lo > 1) bar = xcd_barrier_post(barw, MISC + 8);
#ifndef PROBE_DUP
#define PROBE_DUP 0
#endif
#define DUPB(b) ((PROBE_DUP >> (b)) & 1)
#define IN(k) (lo <= (k) && (k) < hi)
#define SEAM(k) do { if (IN(k) && IN((k) + 1)) { if ((k) < PH_LAYER0 + 3 * NPH_LAYER - 1) { const Frame BF_ = mkframe(a); xcd_barrier_bg(bar, BF_); } else xcd_barrier(bar); } } while (0)
#define SEAMX(k, kn) do { if (IN(k) && IN(kn)) { if ((k) < PH_LAYER0 + 3 * NPH_LAYER - 1) { const Frame BF_ = mkframe(a); xcd_barrier_bg(bar, BF_); } else xcd_barrier(bar); } } while (0)
    PA a; a.ws = args.ws; a.in = args.in; a.out = args.out; a.layer = 0;
    if (IN(0)) { ph_prologue(a); if (DUPB(0)) ph_prologue(a); } SEAM(0);
    if (IN(1)) { ph_kv(a); if (DUPB(1)) ph_kv(a); } SEAM(1);
#define LAYER_BODY(LYR) { \
        constexpr int layer = (LYR), pb = PH_LAYER0 + layer * NPH_LAYER; a.layer = layer; \
        if (IN(pb + 0)) { ph_inproj(a); if (F8_GATES) ph_inproj_gates(a); } SEAM(pb + 0); \
        if (IN(pb + 1)) { ph_conv(a); ph_ssm1(a); ph_ssm2(a); if (DUPB(3)) { ph_conv(a); ph_ssm1(a); ph_ssm2(a); } if (DUPB(11)) ph_conv(a); if (DUPB(12)) { ph_ssm1(a); ph_ssm2(a); } if (DUPB(13)) ph_ssm1(a); } SEAM(pb + 1); \
        if (IN(pb + 2)) { ph_zpw(a); if (DUPB(4)) ph_zpw(a); } SEAMX(pb + 2, pb + 4); \
        if (IN(pb + 4)) { ph_res_out<(F8_QO != 0)>(a); } SEAM(pb + 4); \
        if (IN(pb + 5)) { ph_q(a); ph_attn(a); if (DUPB(5)) { ph_q(a); ph_attn(a); } } SEAMX(pb + 5, pb + 7); \
        if (IN(pb + 7)) { ph_res_o<F8_DENSE(layer)>(a); } SEAM(pb + 7); \
        if ((layer & 1) == 0) { \
            if (IN(pb + 8)) { ph_fgu<F8_DENSE(layer)>(a); } SEAM(pb + 8); \
            if (IN(pb + 9)) { ph_fdown<F8_DENSE(layer)>(a); if (layer < DEPTH - 1) { const Frame DF_ = mkframe(a); bg_drain(DF_, layer); } } do { if (IN(pb + 9) && IN(pb + 13)) { if ((pb + 12) < PH_LAYER0 + 3 * NPH_LAYER - 1) { const Frame BF_ = mkframe(a); xcd_barrier_bg(bar, BF_); } else xcd_barrier(bar); } } while (0); \
        } else { \
            if (IN(pb + 8)) { ph_router(a); if (DUPB(8)) ph_router(a); } SEAM(pb + 8); \
            if (IN(pb + 9)) { ph_assign<F8_MOE(layer)>(a); } SEAM(pb + 9); \
            if (IN(pb + 10)) { ph_mgu<F8_MOE(layer)>(a); } SEAM(pb + 10); \
            if (IN(pb + 11)) { ph_mdown<F8_MOE(layer)>(a); } SEAM(pb + 11); \
            if (IN(pb + 12)) { ph_combine(a); if (layer < DEPTH - 1) { const Frame DF_ = mkframe(a); bg_drain(DF_, layer); } } SEAM(pb + 12); \
        } }
    LAYER_BODY(0) LAYER_BODY(1) LAYER_BODY(2) LAYER_BODY(3)
#undef LAYER_BODY
#undef IN
#undef SEAM
#undef SEAMX
}

extern "C" void kernel_launch(void* const* d_in, const int* in_sizes, int n_in, void* d_out, int out_size, void* d_ws, size_t ws_size, hipStream_t stream) {
    static int grid = 0;
    if (grid == 0) {
        if (n_in != 32 || out_size != T * D || ws_size < WS_END) { fprintf(stderr, "kernel_launch: unexpected problem (n_in %d out %d ws %zu need %zu)\n", n_in, out_size, ws_size, (size_t)WS_END); grid = -1; return; }
        int dev = 0, cus = 0, per_cu = 0;
        if (hipGetDevice(&dev) != hipSuccess || hipDeviceGetAttribute(&cus, hipDeviceAttributeMultiprocessorCount, dev) != hipSuccess) { grid = -1; return; }
        if (hipFuncSetAttribute((const void*)fwd, hipFuncAttributeMaxDynamicSharedMemorySize, LDS_BYTES) != hipSuccess) { fprintf(stderr, "kernel_launch: hipFuncSetAttribute failed\n"); grid = -1; return; }
        if (hipOccupancyMaxActiveBlocksPerMultiprocessor(&per_cu, (const void*)fwd, 512, LDS_BYTES) != hipSuccess || per_cu < 1) { fprintf(stderr, "kernel_launch: occupancy query says %d\n", per_cu); }
        (void)hipGetLastError();
        grid = cus < 256 ? cus : 256;
    }
    if (grid < 0) return;
    if (hipMemsetAsync((char*)d_ws + WS_CTL, 0, CTL_BYTES, stream) != hipSuccess) return;
    Args a{};
    for (int i = 0; i < 32; ++i) a.in[i] = (const float*)d_in[i];
    a.out = (float*)d_out; a.ws = (unsigned char*)d_ws;
#if MK_ONE_LAUNCH
    a.ph_lo = 0; a.ph_hi = NPHASES;
    hipLaunchKernelGGL(fwd, dim3(grid), dim3(512), LDS_BYTES, stream, a);
#else
    for (int p = 0; p < NPHASES; ++p) {
        if (p >= PH_LAYER0) { const int layer = (p - PH_LAYER0) / NPH_LAYER, k = (p - PH_LAYER0) % NPH_LAYER; if ((layer & 1) == 0 && k >= 10) continue; }
        a.ph_lo = p; a.ph_hi = p + 1;
        hipLaunchKernelGGL(fwd, dim3(grid), dim3(512), LDS_BYTES, stream, a);
    }
#endif
}
```

```cpp
#include <hip/hip_runtime.h>
#include <cstdio>
#include <cstdint>

#ifndef MK_ONE_LAUNCH
#define MK_ONE_LAUNCH 1
#endif

#define GAS __attribute__((address_space(1)))
#define LAS __attribute__((address_space(3)))
typedef unsigned short bf16_t;
typedef short bf16x8 __attribute__((ext_vector_type(8)));
typedef float f32x4 __attribute__((ext_vector_type(4)));
typedef float f32x2 __attribute__((ext_vector_type(2)));
typedef float f32x16 __attribute__((ext_vector_type(16)));
typedef unsigned u32x4 __attribute__((ext_vector_type(4)));
typedef unsigned u32x2 __attribute__((ext_vector_type(2)));
typedef __bf16 bf2_t __attribute__((ext_vector_type(2)));

constexpr int D = 1024, BATCH = 8, SEQ = 4096, T = BATCH * SEQ, DEPTH = 4, MEM = 256, NMEM = BATCH * MEM;
constexpr int CW = 512, CK = 31, SW = 512, SG = 16, NG = 32, SP = 64, HEADS = 4, HD = 256;
constexpr int DFF = 2816, NE = 8, DFE = 3584, INC = 3584;
constexpr int NSLOT = 2 * T + NE * 256;
constexpr float RMS_EPS = 1e-6f, LN_EPS = 1e-5f;

constexpr size_t MiB = 1u << 20;
constexpr size_t WS_CTL = 0, CTL_BYTES = 1 * MiB;
constexpr size_t WS_A16 = 1 * MiB;
constexpr size_t WS_META = 2 * MiB;
constexpr size_t WS_STATS = 4 * MiB;
constexpr size_t WS_MEMN = 10 * MiB, WS_KMAT = 14 * MiB, WS_VT = 30 * MiB, WS_H = 46 * MiB;
constexpr size_t WS_WIN = 110 * MiB, WS_WPW = 138 * MiB, WS_WGLU = 142 * MiB, WS_WOUT = 150 * MiB, WS_WQ = 158 * MiB, WS_WKV = 166 * MiB, WS_WO = 182 * MiB;
constexpr size_t WS_WFGU = 190 * MiB, WS_WFD = 212 * MiB, WS_WMGU = 224 * MiB, WS_WMD = 448 * MiB, WS_WST = 560 * MiB, WS_TW = 576 * MiB;
constexpr size_t WS_R = 600 * MiB;
constexpr size_t WS_UCONV = WS_R, WS_XU = WS_R + 32 * MiB, WS_GATES = WS_R + 80 * MiB, WS_UC = WS_R + 208 * MiB, WS_YS = WS_R + 240 * MiB;
constexpr size_t WS_MB = WS_R + 272 * MiB, WS_MERGED = WS_R + 336 * MiB, WS_Q = WS_R + 400 * MiB, WS_AO = WS_R + 464 * MiB;
constexpr size_t WS_H8 = WS_R + 300 * MiB;
constexpr size_t WS_ACT = WS_R, WS_HS = WS_R + 462 * MiB, WS_YE = WS_R + 594 * MiB, WS_END = WS_R + 726 * MiB;
constexpr size_t WS_MPART = WS_R + 530 * MiB;
static_assert((size_t)NSLOT * DFE * 2 <= 462 * MiB && (size_t)NSLOT * D * 2 <= 132 * MiB, "moe buffers");
constexpr size_t MT_TOKE = 0, MT_TOKW = 128 * 1024, MT_TOKR = 384 * 1024, MT_TOKSLOT = 512 * 1024, MT_RSCALE = 768 * 1024, MT_GWT = 1088 * 1024, MT_WGCNT = 1408 * 1024, MT_PEXP = 1424 * 1024;
constexpr int CW_PTOTAL = 16, CW_PBASE = 32;
constexpr int CW_BAR = 4096;

constexpr int LDS_AUX = 131072;
constexpr int LDS_MISC = 131072 + 8192;
constexpr int LDS_BYTES = 147456;

#ifndef F8_MOE_MASK
#define F8_MOE_MASK 0xA
#endif
#define F8_MOE(l) (((F8_MOE_MASK >> (l)) & 1) != 0)
#ifndef F8_QO
#define F8_QO 1
#endif
#ifndef F8_IN_S
#define F8_IN_S 1
#endif
#ifndef F8_GATES
#define F8_GATES 1
#endif
#ifndef F8_DENSE_MASK
#define F8_DENSE_MASK 0x4
#endif
#define F8_DENSE(l) (((F8_DENSE_MASK >> (l)) & 1) != 0)
__device__ __forceinline__ unsigned pk2(float lo, float hi) { f32x2 v = {lo, hi}; bf2_t r = __builtin_convertvector(v, bf2_t); return __builtin_bit_cast(unsigned, r); }
__device__ __forceinline__ float bflo(unsigned u) { return __uint_as_float(u << 16); }
__device__ __forceinline__ float bfhi(unsigned u) { return __uint_as_float(u & 0xffff0000u); }
__device__ __forceinline__ float fast_rcp(float x) { return __builtin_amdgcn_rcpf(x); }
__device__ __forceinline__ float fast_exp2(float x) { return __builtin_amdgcn_exp2f(x); }
__device__ __forceinline__ float sigmoidf_(float x) { return fast_rcp(1.0f + fast_exp2(-1.44269504f * x)); }
__device__ __forceinline__ float siluf_(float x) { return x * sigmoidf_(x); }
__device__ __forceinline__ float gelu_tanh_(float x) { const float z = 0.7978845608f * (x + 0.044715f * x * x * x); return x * fast_rcp(1.0f + fast_exp2(-2.88539008f * z)); }
__device__ __forceinline__ float wave_sum(float v) {
#pragma unroll
    for (int o = 1; o < 64; o <<= 1) v += __shfl_xor(v, o);
    return v;
}
__device__ __forceinline__ float row_rstd(const float* stats, int row) {
    const f32x4 a = *(const f32x4*)(stats + (size_t)row * 4);
    return __builtin_amdgcn_rsqf(((a[0] + a[1]) + (a[2] + a[3])) * (1.0f / D) + RMS_EPS);
}
__device__ __forceinline__ unsigned pk4_fp8(float a, float b, float c, float d) { int w = 0; w = __builtin_amdgcn_cvt_pk_fp8_f32(a, b, w, false); w = __builtin_amdgcn_cvt_pk_fp8_f32(c, d, w, true); return (unsigned)w; }
constexpr float F8_WGU_SCALE = 32.f, F8_WD_SCALE = 64.f, F8_ACT_SCALE = 4.f, F8_WQ_SCALE = 512.f, F8_WO_SCALE = 32.f, F8_AO_SCALE = 8.f;
#define LDS_WAIT() asm volatile("s_waitcnt lgkmcnt(0)" ::: "memory")
#define VM_WAIT() asm volatile("s_waitcnt vmcnt(0)" ::: "memory")

namespace pg8 {
constexpr int BM = 256, BK = 64, HALF = 128, HTB = HALF * BK * 2, STAGE_BYTES = 8 * HTB, NXCD = 8, WGM = 4;
__host__ __device__ __forceinline__ int lds_byte(int r, int c) { const int st = (r >> 4) * 2 + (c >> 5), rr = r & 15, cc = c & 31, ob = rr * 64 + cc * 2; return st * 1024 + (ob ^ (((ob >> 9) & 1) << 5)); }
__host__ __device__ __forceinline__ void stage_rc(int b, int& R, int& C) { const int st = b / 1024, sb = b % 1024, swz = sb ^ (((sb >> 9) & 1) << 5); R = (st >> 1) * 16 + swz / 64; C = (st & 1) * 32 + (swz % 64) / 2; }
__host__ __device__ __forceinline__ int perm32(int rho) { const int n = rho >> 4, i = rho & 15; return 8 * (i >> 2) + 4 * n + (i & 3); }

struct Unit { int pm, pn, tag; const char* A; const char* B; };

struct StaticOrder {
    int nM, nN, nwg, G, c;
    __device__ __forceinline__ void init(int nM_, int nN_, int G_, int c_) { nM = nM_; nN = nN_; nwg = nM * nN; G = G_; c = c_; }
    __device__ __forceinline__ bool next(int i, int& pm, int& pn) const {
        const long L = (long)i * G + c; if (L >= nwg) return false;
        int wgid = (int)L; { const int q = nwg / NXCD, r = nwg % NXCD, xcd = wgid % NXCD, off = wgid / NXCD; wgid = (xcd < r ? xcd * (q + 1) : r * (q + 1) + (xcd - r) * q) + off; }
        const int nig = WGM * nN, gid = wgid / nig, fm = gid * WGM, gsz = (nM - fm) < WGM ? (nM - fm) : WGM;
        pm = fm + ((wgid % nig) % gsz); pn = (wgid % nig) / gsz; return true;
    }
};
struct SchedStd {
    StaticOrder o; const char* A; const char* B; size_t sA, sB;
    __device__ __forceinline__ bool next(int i, Unit& u) const { int pm, pn; if (!o.next(i, pm, pn)) return false; u.pm = pm; u.pn = pn; u.tag = 0; u.A = A + (size_t)pm * sA; u.B = B + (size_t)pn * sB; return true; }
    __device__ __forceinline__ void a_ready(const Unit&) const {}
    __device__ __forceinline__ void done(const Unit&) const {}
};
struct SchedOne {
    Unit u0;
    __device__ __forceinline__ bool next(int i, Unit& u) const { if (i) return false; u = u0; return true; }
    __device__ __forceinline__ void a_ready(const Unit&) const {}
    __device__ __forceinline__ void done(const Unit&) const {}
};

template <class S_> struct SchedVarK { static constexpr bool v = false; };
template <class Epi, class Sched, bool ALIGN_EPI, bool SP2, bool F8 = false>
__device__ __forceinline__ void gemm_phase(LAS unsigned char* lds, const int K, const int lda, const int ldb, const Sched& S, const Epi& E, const char* wsb, const int tid_in) {
    int tid_ = tid_in; asm volatile("" : "+v"(tid_));
    const int tid = tid_, wid = __builtin_amdgcn_readfirstlane(tid >> 6), lane = tid & 63, wr = wid >> 2, wc = wid & 3, fr = lane & 15, fq = lane >> 4;
    constexpr int ES = F8 ? 1 : 2;
    const int nt = K * ES / (BK * 2);
    unsigned voffA[2], voffB[2];
#pragma unroll
    for (int i = 0; i < 2; ++i) { int R, C; stage_rc(tid * 16 + i * 8192, R, C); const int Rb = Epi::PERM ? ((R & ~31) + perm32(R & 31)) : R;
        voffA[i] = (unsigned)(R * lda * ES + C * 2); voffB[i] = (unsigned)(Rb * ldb * ES + C * 2); }
    const unsigned kstep = (unsigned)(BK * 2);
    const unsigned hstepA = (unsigned)(HALF * lda * ES), hstepB = (unsigned)(HALF * ldb * ES);
    const __amdgpu_buffer_rsrc_t rs = __builtin_amdgcn_make_buffer_rsrc((void*)wsb, (short)0, 0x7fffffff, 0x00020000);
    const unsigned ldsw = (unsigned)wid * 1024u;
    const int aoff = lds_byte(wr * 64 + fr, fq * 8), boff = lds_byte(wc * 32 + fr, fq * 8);
#define PG8_SA(b, h) (((b) * 2 + (h)) * HTB)
#define PG8_SB(b, h) ((4 + (b) * 2 + (h)) * HTB)
#define PG8_STAGE(bufoff, goff, voff) do { _Pragma("unroll") for (int _i = 0; _i < 2; ++_i) \
        __builtin_amdgcn_raw_ptr_buffer_load_lds(rs, (LAS unsigned*)(lds + (bufoff) + ldsw + _i * 8192), 16, (voff)[_i], (int)(goff), 0, 0); } while (0)
#define PG8_LD16(off) (*(const LAS bf16x8*)(lds + (off)))
#define PG8_CAT(x, y) __builtin_shufflevector(__builtin_bit_cast(i32x4_, (x)), __builtin_bit_cast(i32x4_, (y)), 0, 1, 2, 3, 4, 5, 6, 7)
#define PG8_LDA(dst, b, h) do { _Pragma("unroll") for (int m = 0; m < 4; ++m) { if constexpr (F8) dst##8[m] = PG8_CAT(PG8_LD16(PG8_SA(b, h) + aoff + m * 2048), PG8_LD16(PG8_SA(b, h) + aoff + m * 2048 + 1024)); \
        else { _Pragma("unroll") for (int k = 0; k < 2; ++k) dst[m][k] = PG8_LD16(PG8_SA(b, h) + aoff + m * 2048 + k * 1024); } } } while (0)
#define PG8_LDB(dst, b, h) do { _Pragma("unroll") for (int n = 0; n < 2; ++n) { if constexpr (F8) dst##8[n] = PG8_CAT(PG8_LD16(PG8_SB(b, h) + boff + n * 2048), PG8_LD16(PG8_SB(b, h) + boff + n * 2048 + 1024)); \
        else { _Pragma("unroll") for (int k = 0; k < 2; ++k) dst[n][k] = PG8_LD16(PG8_SB(b, h) + boff + n * 2048 + k * 1024); } } } while (0)
#define PG8_MMA_ASM8(C0, C1, C2, C3, C4, C5, C6, C7, OUTC) \
            asm volatile("s_nop 1\n\t" \
                "v_mfma_f32_16x16x128_f8f6f4 %0, %8, %10, " C0 "\n\tv_mfma_f32_16x16x128_f8f6f4 %1, %9, %10, " C1 "\n\t" \
                "v_mfma_f32_16x16x128_f8f6f4 %2, %8, %11, " C2 "\n\tv_mfma_f32_16x16x128_f8f6f4 %3, %9, %11, " C3 "\n\t" \
                "v_mfma_f32_16x16x128_f8f6f4 %4, %8, %12, " C4 "\n\tv_mfma_f32_16x16x128_f8f6f4 %5, %9, %12, " C5 "\n\t" \
                "v_mfma_f32_16x16x128_f8f6f4 %6, %8, %13, " C6 "\n\tv_mfma_f32_16x16x128_f8f6f4 %7, %9, %13, " C7
#define PG8_MMA(ai, bj, Af, Bf, Z) do { __builtin_amdgcn_s_setprio(1); \
        if constexpr (F8) {   \
            if (Z) { PG8_MMA_ASM8("0", "0", "0", "0", "0", "0", "0", "0", 0) \
                : "=&v"(acc[ai][bj][0][0]), "=&v"(acc[ai][bj][0][1]), "=&v"(acc[ai][bj][1][0]), "=&v"(acc[ai][bj][1][1]), "=&v"(acc[ai][bj][2][0]), "=&v"(acc[ai][bj][2][1]), "=&v"(acc[ai][bj][3][0]), "=&v"(acc[ai][bj][3][1]) \
                : "v"(Bf##8[0]), "v"(Bf##8[1]), "v"(Af##8[0]), "v"(Af##8[1]), "v"(Af##8[2]), "v"(Af##8[3])); } \
            else { PG8_MMA_ASM8("%0", "%1", "%2", "%3", "%4", "%5", "%6", "%7", 1) \
                : "+v"(acc[ai][bj][0][0]), "+v"(acc[ai][bj][0][1]), "+v"(acc[ai][bj][1][0]), "+v"(acc[ai][bj][1][1]), "+v"(acc[ai][bj][2][0]), "+v"(acc[ai][bj][2][1]), "+v"(acc[ai][bj][3][0]), "+v"(acc[ai][bj][3][1]) \
                : "v"(Bf##8[0]), "v"(Bf##8[1]), "v"(Af##8[0]), "v"(Af##8[1]), "v"(Af##8[2]), "v"(Af##8[3])); } } \
        else {   \
            if (Z) { asm volatile("s_nop 1\n\t" \
                "v_mfma_f32_16x16x32_bf16 %0, %8, %12, 0\n\t" \
                "v_mfma_f32_16x16x32_bf16 %1, %9, %12, 0\n\t" \
                "v_mfma_f32_16x16x32_bf16 %2, %8, %13, 0\n\t" \
                "v_mfma_f32_16x16x32_bf16 %3, %9, %13, 0\n\t" \
                "v_mfma_f32_16x16x32_bf16 %4, %8, %14, 0\n\t" \
                "v_mfma_f32_16x16x32_bf16 %5, %9, %14, 0\n\t" \
                "v_mfma_f32_16x16x32_bf16 %6, %8, %15, 0\n\t" \
                "v_mfma_f32_16x16x32_bf16 %7, %9, %15, 0\n\t" \
                "v_mfma_f32_16x16x32_bf16 %0, %10, %16, %0\n\t" \
                "v_mfma_f32_16x16x32_bf16 %1, %11, %16, %1\n\t" \
                "v_mfma_f32_16x16x32_bf16 %2, %10, %17, %2\n\t" \
                "v_mfma_f32_16x16x32_bf16 %3, %11, %17, %3\n\t" \
                "v_mfma_f32_16x16x32_bf16 %4, %10, %18, %4\n\t" \
                "v_mfma_f32_16x16x32_bf16 %5, %11, %18, %5\n\t" \
                "v_mfma_f32_16x16x32_bf16 %6, %10, %19, %6\n\t" \
                "v_mfma_f32_16x16x32_bf16 %7, %11, %19, %7" \
                : "=&v"(acc[ai][bj][0][0]), "=&v"(acc[ai][bj][0][1]), "=&v"(acc[ai][bj][1][0]), "=&v"(acc[ai][bj][1][1]), "=&v"(acc[ai][bj][2][0]), "=&v"(acc[ai][bj][2][1]), "=&v"(acc[ai][bj][3][0]), "=&v"(acc[ai][bj][3][1]) \
                : "v"(Bf[0][0]), "v"(Bf[1][0]), "v"(Bf[0][1]), "v"(Bf[1][1]), "v"(Af[0][0]), "v"(Af[1][0]), "v"(Af[2][0]), "v"(Af[3][0]), "v"(Af[0][1]), "v"(Af[1][1]), "v"(Af[2][1]), "v"(Af[3][1])); } \
            else { asm volatile("s_nop 1\n\t" \
                "v_mfma_f32_16x16x32_bf16 %0, %8, %12, %0\n\t" \
                "v_mfma_f32_16x16x32_bf16 %1, %9, %12, %1\n\t" \
                "v_mfma_f32_16x16x32_bf16 %2, %8, %13, %2\n\t" \
                "v_mfma_f32_16x16x32_bf16 %3, %9, %13, %3\n\t" \
                "v_mfma_f32_16x16x32_bf16 %4, %8, %14, %4\n\t" \
                "v_mfma_f32_16x16x32_bf16 %5, %9, %14, %5\n\t" \
                "v_mfma_f32_16x16x32_bf16 %6, %8, %15, %6\n\t" \
                "v_mfma_f32_16x16x32_bf16 %7, %9, %15, %7\n\t" \
                "v_mfma_f32_16x16x32_bf16 %0, %10, %16, %0\n\t" \
                "v_mfma_f32_16x16x32_bf16 %1, %11, %16, %1\n\t" \
                "v_mfma_f32_16x16x32_bf16 %2, %10, %17, %2\n\t" \
                "v_mfma_f32_16x16x32_bf16 %3, %11, %17, %3\n\t" \
                "v_mfma_f32_16x16x32_bf16 %4, %10, %18, %4\n\t" \
                "v_mfma_f32_16x16x32_bf16 %5, %11, %18, %5\n\t" \
                "v_mfma_f32_16x16x32_bf16 %6, %10, %19, %6\n\t" \
                "v_mfma_f32_16x16x32_bf16 %7, %11, %19, %7" \
                : "+v"(acc[ai][bj][0][0]), "+v"(acc[ai][bj][0][1]), "+v"(acc[ai][bj][1][0]), "+v"(acc[ai][bj][1][1]), "+v"(acc[ai][bj][2][0]), "+v"(acc[ai][bj][2][1]), "+v"(acc[ai][bj][3][0]), "+v"(acc[ai][bj][3][1]) \
                : "v"(Bf[0][0]), "v"(Bf[1][0]), "v"(Bf[0][1]), "v"(Bf[1][1]), "v"(Af[0][0]), "v"(Af[1][0]), "v"(Af[2][0]), "v"(Af[3][0]), "v"(Af[0][1]), "v"(Af[1][1]), "v"(Af[2][1]), "v"(Af[3][1])); } } \
        __builtin_amdgcn_s_setprio(0); } while (0)
#define PG8_WAIT_V(n) asm volatile("s_waitcnt vmcnt(" #n ")" ::: "memory")
#define PG8_WAIT_L(n) asm volatile("s_waitcnt lgkmcnt(" #n ")" ::: "memory")
#define PG8_BAR __builtin_amdgcn_s_barrier()
#define PG8_SCHED __builtin_amdgcn_sched_barrier(0)
    Unit cur, nxt; int ui = 0;
    if (!S.next(0, cur)) return;
    f32x4 acc[2][2][4][2];
    typedef int i32x4_ __attribute__((ext_vector_type(4))); typedef int i32x8_ __attribute__((ext_vector_type(8)));
    bf16x8 At[4][2], B0[2][2], B1[2][2]; i32x8_ At8[4], B08[2], B18[2];
    unsigned cA = (unsigned)(cur.A - wsb), cB = (unsigned)(cur.B - wsb);
    int ntc = nt; if constexpr (SchedVarK<Sched>::v) ntc = S.nt_of(cur, nt);
    S.a_ready(cur);
    if constexpr (SP2) {
        PG8_STAGE(PG8_SB(0, 0), cB, voffB); PG8_STAGE(PG8_SB(0, 1), cB + hstepB, voffB); PG8_STAGE(PG8_SA(0, 0), cA, voffA); PG8_STAGE(PG8_SA(0, 1), cA + hstepA, voffA);
        if (wr == 1) PG8_BAR;
        PG8_WAIT_V(2); PG8_BAR;
        PG8_STAGE(PG8_SB(1, 0), cB + kstep, voffB); PG8_STAGE(PG8_SA(1, 0), cA + kstep, voffA); PG8_STAGE(PG8_SB(1, 1), cB + hstepB + kstep, voffB);
        PG8_WAIT_V(6); PG8_BAR;
    } else {
        PG8_STAGE(PG8_SB(0, 0), cB, voffB); PG8_STAGE(PG8_SA(0, 0), cA, voffA); PG8_STAGE(PG8_SB(0, 1), cB + hstepB, voffB); PG8_STAGE(PG8_SA(0, 1), cA + hstepA, voffA);
        if (wr == 1) PG8_BAR;
        PG8_WAIT_V(4); PG8_BAR;
        PG8_STAGE(PG8_SB(1, 0), cB + kstep, voffB); PG8_STAGE(PG8_SA(1, 0), cA + kstep, voffA); PG8_STAGE(PG8_SB(1, 1), cB + hstepB + kstep, voffB);
        PG8_WAIT_V(6); PG8_BAR;
    }
    for (;;) {
        const bool has_next = S.next(ui + 1, nxt);
        const unsigned nA = has_next ? (unsigned)(nxt.A - wsb) : cA, nB = has_next ? (unsigned)(nxt.B - wsb) : cB;
        for (int t = 0; t < ntc; t += 2) {
            const bool last = (t == ntc - 2), z0 = (t == 0);
            const unsigned a1 = cA + (unsigned)(t + 1) * kstep;
            const unsigned a2 = last ? nA : cA + (unsigned)(t + 2) * kstep, b2 = last ? nB : cB + (unsigned)(t + 2) * kstep;
            const unsigned a3 = a2 + kstep, b3 = b2 + kstep;
            if (last && has_next) S.a_ready(nxt);
            if constexpr (SP2) {
            PG8_LDB(B0, 0, 0); PG8_LDB(B1, 0, 1); PG8_SCHED; PG8_LDA(At, 0, 0); PG8_STAGE(PG8_SA(1, 1), a1 + hstepA, voffA);
            PG8_WAIT_V(8); PG8_WAIT_L(0); PG8_BAR; PG8_MMA(0, 0, At, B0, z0); PG8_MMA(0, 1, At, B1, z0); PG8_BAR; PG8_SCHED;
            PG8_LDA(At, 0, 1); PG8_STAGE(PG8_SB(0, 0), b2, voffB); PG8_STAGE(PG8_SB(0, 1), b2 + hstepB, voffB); PG8_STAGE(PG8_SA(0, 0), a2, voffA);
            PG8_WAIT_V(8); PG8_WAIT_L(0); PG8_BAR; PG8_MMA(1, 0, At, B0, z0); PG8_MMA(1, 1, At, B1, z0); PG8_BAR; PG8_SCHED;
            PG8_LDB(B0, 1, 0); PG8_LDB(B1, 1, 1); PG8_SCHED; PG8_LDA(At, 1, 0); PG8_STAGE(PG8_SA(0, 1), a2 + hstepA, voffA);
            PG8_WAIT_V(8); PG8_WAIT_L(0); PG8_BAR; PG8_MMA(0, 0, At, B0, false); PG8_MMA(0, 1, At, B1, false); PG8_BAR; PG8_SCHED;
            PG8_LDA(At, 1, 1); PG8_STAGE(PG8_SB(1, 0), b3, voffB); PG8_STAGE(PG8_SB(1, 1), b3 + hstepB, voffB); PG8_STAGE(PG8_SA(1, 0), a3, voffA);
            PG8_WAIT_V(8); PG8_WAIT_L(0); PG8_BAR; PG8_MMA(1, 0, At, B0, false); PG8_MMA(1, 1, At, B1, false); PG8_BAR; PG8_SCHED;
            } else {
            PG8_LDB(B0, 0, 0); PG8_SCHED; PG8_LDA(At, 0, 0); PG8_STAGE(PG8_SA(1, 1), a1 + hstepA, voffA);
            PG8_WAIT_L(8); PG8_BAR; PG8_WAIT_L(0); PG8_MMA(0, 0, At, B0, z0); PG8_BAR; PG8_SCHED;
            PG8_LDB(B1, 0, 1); PG8_STAGE(PG8_SB(0, 0), b2, voffB);
            PG8_BAR; PG8_WAIT_L(0); PG8_MMA(0, 1, At, B1, z0); PG8_BAR;
            PG8_LDA(At, 0, 1); PG8_STAGE(PG8_SA(0, 0), a2, voffA);
            PG8_BAR; PG8_WAIT_L(0); PG8_MMA(1, 0, At, B0, z0); PG8_BAR; PG8_SCHED;
            PG8_STAGE(PG8_SB(0, 1), b2 + hstepB, voffB);
            PG8_WAIT_V(6); PG8_BAR; PG8_MMA(1, 1, At, B1, z0); PG8_BAR;
            PG8_LDB(B0, 1, 0); PG8_SCHED; PG8_LDA(At, 1, 0); PG8_STAGE(PG8_SA(0, 1), a2 + hstepA, voffA);
            PG8_WAIT_L(8); PG8_BAR; PG8_WAIT_L(0); PG8_MMA(0, 0, At, B0, false); PG8_BAR; PG8_SCHED;
            PG8_LDB(B1, 1, 1); PG8_STAGE(PG8_SB(1, 0), b3, voffB);
            PG8_BAR; PG8_WAIT_L(0); PG8_MMA(0, 1, At, B1, false); PG8_BAR;
            PG8_LDA(At, 1, 1); PG8_STAGE(PG8_SA(1, 0), a3, voffA);
            PG8_BAR; PG8_WAIT_L(0); PG8_MMA(1, 0, At, B0, false); PG8_BAR; PG8_SCHED;
            PG8_STAGE(PG8_SB(1, 1), b3 + hstepB, voffB);
            PG8_WAIT_V(6); PG8_BAR; PG8_MMA(1, 1, At, B1, false); PG8_BAR;
            }
        }
        asm volatile("s_nop 15\n\ts_nop 7" ::: "memory");
        if constexpr (ALIGN_EPI) { if (wr == 0) PG8_BAR; }
        if constexpr (!Epi::AFTER_DRAIN) { int fr2 = fr, fq2 = fq; asm volatile("" : "+v"(fr2), "+v"(fq2));
            E(acc, cur, wr, wc, fr2, fq2); S.done(cur); }
        if (!has_next) break;
        cur = nxt; cA = nA; cB = nB; ++ui;
        if constexpr (SchedVarK<Sched>::v) ntc = S.nt_of(cur, nt);
        if constexpr (ALIGN_EPI) { if (wr == 1) PG8_BAR; }
    }
    PG8_WAIT_V(0);
    if constexpr (!ALIGN_EPI) { if (wr == 0) PG8_BAR; }
    PG8_BAR;
    if constexpr (Epi::AFTER_DRAIN) { int fr2 = fr, fq2 = fq, lane2 = lane; asm volatile("" : "+v"(fr2), "+v"(fq2), "+v"(lane2)); E.fused(acc, cur, wr, wc, fr2, fq2, lds, wid, lane2); S.done(cur); }
#undef PG8_SA
#undef PG8_SB
#undef PG8_STAGE
#undef PG8_LDA
#undef PG8_LD16
#undef PG8_CAT
#undef PG8_LDB
#undef PG8_MMA
#undef PG8_MMA_ASM8
#undef PG8_WAIT_V
#undef PG8_WAIT_L
#undef PG8_BAR
#undef PG8_SCHED
}
}
using pg8::Unit;
typedef const f32x4 (&AccRef)[2][2][4][2];

__device__ __forceinline__ u32x4 pack8(const f32x4 a, const f32x4 b) { u32x4 w; w.x = pk2(a[0], a[1]); w.y = pk2(a[2], a[3]); w.z = pk2(b[0], b[1]); w.w = pk2(b[2], b[3]); return w; }
__device__ __forceinline__ void unpack8(const u32x4 w, f32x4& a, f32x4& b) { a = (f32x4){bflo(w.x), bfhi(w.x), bflo(w.y), bfhi(w.y)}; b = (f32x4){bflo(w.z), bfhi(w.z), bflo(w.w), bfhi(w.w)}; }

struct EpiInproj {
    static constexpr bool PERM = true, AFTER_DRAIN = false;
    const float* stats; bf16_t* uconv; bf16_t* xu; bf16_t* gates;
    __device__ __forceinline__ void operator()(AccRef acc, const Unit& u, int wr, int wc, int fr, int fq) const {
        float rr[2][4];
#pragma unroll
        for (int ai = 0; ai < 2; ++ai)
#pragma unroll
            for (int m = 0; m < 4; ++m) rr[ai][m] = row_rstd(stats, u.pm * 256 + ai * 128 + wr * 64 + m * 16 + fr);
#pragma unroll
        for (int ai = 0; ai < 2; ++ai)
#pragma unroll
            for (int m = 0; m < 4; ++m) {
                const int row = u.pm * 256 + ai * 128 + wr * 64 + m * 16 + fr;
                const float r = rr[ai][m];
                if (u.pn < 4) {
                    f32x4 v[2];
#pragma unroll
                    for (int n = 0; n < 2; ++n)
#pragma unroll
                        for (int i = 0; i < 4; ++i) v[n][i] = (acc[ai][0][m][n][i] * r) * sigmoidf_(acc[ai][1][m][n][i] * r);
                    *(u32x4*)(uconv + (size_t)row * CW + u.pn * 128 + wc * 32 + fq * 8) = pack8(v[0], v[1]);
                } else if (u.pn < 6) {
                    const int b = row >> 12, t = row & 4095;
#pragma unroll
                    for (int bj = 0; bj < 2; ++bj) {
                        const int ch = (u.pn - 4) * 256 + bj * 128 + wc * 32 + fq * 8, g = ch >> 4, h0 = ch & 15;
                        const size_t off = ((size_t)((b * NG + g) * 256 + (t >> 4))) * 384 + (t & 15) * 16 + h0;
                        *(u32x4*)(xu + off) = pack8(acc[ai][bj][m][0] * r, acc[ai][bj][m][1] * r);
                    }
                } else {
#pragma unroll
                    for (int bj = 0; bj < 2; ++bj) {
                        f32x4 v[2];
#pragma unroll
                        for (int n = 0; n < 2; ++n)
#pragma unroll
                            for (int i = 0; i < 4; ++i) v[n][i] = sigmoidf_(acc[ai][bj][m][n][i] * r);
                        *(u32x4*)(gates + (size_t)row * 2048 + (u.pn - 6) * 256 + bj * 128 + wc * 32 + fq * 8) = pack8(v[0], v[1]);
                    }
                }
            }
    }
};
struct EpiGates {
    static constexpr bool PERM = true, AFTER_DRAIN = false;
    const float* stats; bf16_t* gates; float sc; bf16_t* xu;
    __device__ __forceinline__ void operator()(AccRef acc, const Unit& u, int wr, int wc, int fr, int fq) const {
        float rr[2][4];
#pragma unroll
        for (int ai = 0; ai < 2; ++ai)
#pragma unroll
            for (int m = 0; m < 4; ++m) rr[ai][m] = row_rstd(stats, u.pm * 256 + ai * 128 + wr * 64 + m * 16 + fr) * sc;
#pragma unroll
        for (int ai = 0; ai < 2; ++ai)
#pragma unroll
            for (int m = 0; m < 4; ++m) {
                const int row = u.pm * 256 + ai * 128 + wr * 64 + m * 16 + fr; const float r = rr[ai][m];
                if (F8_IN_S && u.pn >= 8) {
                    const int b = row >> 12, t = row & 4095;
#pragma unroll
                    for (int bj = 0; bj < 2; ++bj) {
                        const int ch = (u.pn - 8) * 256 + bj * 128 + wc * 32 + fq * 8, g = ch >> 4, h0 = ch & 15;
                        const size_t off = ((size_t)((b * NG + g) * 256 + (t >> 4))) * 384 + (t & 15) * 16 + h0;
                        *(u32x4*)(xu + off) = pack8(acc[ai][bj][m][0] * r, acc[ai][bj][m][1] * r);
                    }
                    continue;
                }
#pragma unroll
                for (int bj = 0; bj < 2; ++bj) {
                    f32x4 v[2];
#pragma unroll
                    for (int n = 0; n < 2; ++n)
#pragma unroll
                        for (int i = 0; i < 4; ++i) v[n][i] = sigmoidf_(acc[ai][bj][m][n][i] * r);
                    *(u32x4*)(gates + (size_t)row * 2048 + u.pn * 256 + bj * 128 + wc * 32 + fq * 8) = pack8(v[0], v[1]);
                }
            }
    }
};
struct EpiZ {
    static constexpr bool PERM = true, AFTER_DRAIN = false;
    const bf16_t* gates; bf16_t* mb;
    __device__ __forceinline__ void operator()(AccRef acc, const Unit& u, int wr, int wc, int fr, int fq) const {
        const int oc = u.pn * 128 + wc * 32 + fq * 8;
        u32x4 gv[2][4];
#pragma unroll
        for (int ai = 0; ai < 2; ++ai)
#pragma unroll
            for (int m = 0; m < 4; ++m) gv[ai][m] = *(const u32x4*)(gates + (size_t)(u.pm * 256 + ai * 128 + wr * 64 + m * 16 + fr) * 2048 + 1024 + oc);
#pragma unroll
        for (int ai = 0; ai < 2; ++ai)
#pragma unroll
            for (int m = 0; m < 4; ++m) {
                const int row = u.pm * 256 + ai * 128 + wr * 64 + m * 16 + fr;
                f32x4 g0, g1; unpack8(gv[ai][m], g0, g1);
                f32x4 v[2];
#pragma unroll
                for (int i = 0; i < 4; ++i) { v[0][i] = g0[i] * acc[ai][0][m][0][i] * sigmoidf_(acc[ai][1][m][0][i]); v[1][i] = g1[i] * acc[ai][0][m][1][i] * sigmoidf_(acc[ai][1][m][1][i]); }
                *(u32x4*)(mb + (size_t)row * D + oc) = pack8(v[0], v[1]);
            }
    }
};
struct EpiPw {
    static constexpr bool PERM = true, AFTER_DRAIN = false;
    const bf16_t* gates; const bf16_t* mb; bf16_t* merged;
    __device__ __forceinline__ void operator()(AccRef acc, const Unit& u, int wr, int wc, int fr, int fq) const {
#pragma unroll
        for (int ai = 0; ai < 2; ++ai) {
            u32x4 gv[4][2], mv[4][2];
#pragma unroll
            for (int m = 0; m < 4; ++m)
#pragma unroll
                for (int bj = 0; bj < 2; ++bj) { const int row = u.pm * 256 + ai * 128 + wr * 64 + m * 16 + fr, c = u.pn * 256 + bj * 128 + wc * 32 + fq * 8;
                    gv[m][bj] = *(const u32x4*)(gates + (size_t)row * 2048 + c); mv[m][bj] = *(const u32x4*)(mb + (size_t)row * D + c); }
#pragma unroll
            for (int m = 0; m < 4; ++m)
#pragma unroll
                for (int bj = 0; bj < 2; ++bj) { const int row = u.pm * 256 + ai * 128 + wr * 64 + m * 16 + fr, c = u.pn * 256 + bj * 128 + wc * 32 + fq * 8;
                    f32x4 g0, g1, m0, m1; unpack8(gv[m][bj], g0, g1); unpack8(mv[m][bj], m0, m1);
                    *(u32x4*)(merged + (size_t)row * D + c) = pack8(g0 * acc[ai][bj][m][0] + m0, g1 * acc[ai][bj][m][1] + m1); }
        }
    }
};
struct EpiZPW {
    static constexpr bool PERM = true, AFTER_DRAIN = false;
    EpiZ ez; EpiPw ep;
    __device__ __forceinline__ void operator()(AccRef acc, const Unit& u, int wr, int wc, int fr, int fq) const {
        if (u.tag == 0) ez(acc, u, wr, wc, fr, fq);
        else { asm volatile("s_waitcnt vmcnt(0)" ::: "memory"); ep(acc, u, wr, wc, fr, fq); }
    }
};
struct SchedZPW {
    pg8::StaticOrder o; const char* ys; const char* uc; const char* wglu; const char* wpw;
    __device__ __forceinline__ bool next(int i, Unit& u) const { const int gi = i / 3, sub = i - gi * 3; int pm, pn; if (!o.next(gi, pm, pn)) return false;
        u.pm = pm;
        if (sub < 2) { u.pn = 2 * pn + sub; u.tag = 0; u.A = ys + (size_t)pm * 256 * SW * 2; u.B = wglu + (size_t)u.pn * 256 * SW * 2; }
        else { u.pn = pn; u.tag = 1; u.A = uc + (size_t)pm * 256 * CW * 2; u.B = wpw + (size_t)pn * 256 * CW * 2; }
        return true; }
    __device__ __forceinline__ void a_ready(const Unit&) const {}
    __device__ __forceinline__ void done(const Unit&) const {}
};
template <bool H8OUT = false, bool SCALED = false> struct EpiRes {
    static constexpr bool PERM = true, AFTER_DRAIN = false;
    bf16_t* h; float* stats; bf16_t* hdst; unsigned char* h8; LAS unsigned char* lds;
    __device__ __forceinline__ void operator()(AccRef acc, const Unit& u, int wr, int wc, int fr, int fq) const {
        LAS float* X = (LAS float*)(lds + LDS_AUX);
#pragma unroll
        for (int ai = 0; ai < 2; ++ai) {
            u32x4 hv[4][2];
#pragma unroll
            for (int m = 0; m < 4; ++m)
#pragma unroll
                for (int bj = 0; bj < 2; ++bj) hv[m][bj] = *(const u32x4*)(h + (size_t)(u.pm * 256 + ai * 128 + wr * 64 + m * 16 + fr) * D + u.pn * 256 + bj * 128 + wc * 32 + fq * 8);
#pragma unroll
            for (int m = 0; m < 4; ++m) {
                const int row = u.pm * 256 + ai * 128 + wr * 64 + m * 16 + fr; float ss = 0.f;
#pragma unroll
                for (int bj = 0; bj < 2; ++bj) {
                    const size_t eo = (size_t)row * D + u.pn * 256 + bj * 128 + wc * 32 + fq * 8;
                    f32x4 h0, h1; unpack8(hv[m][bj], h0, h1);
                    constexpr float asc = SCALED ? 1.0f / (F8_WD_SCALE * F8_ACT_SCALE) : 1.0f;
                    h0 = h0 + acc[ai][bj][m][0] * asc; h1 = h1 + acc[ai][bj][m][1] * asc;
                    ss += (h0[0] * h0[0] + h0[1] * h0[1]) + (h0[2] * h0[2] + h0[3] * h0[3]) + (h1[0] * h1[0] + h1[1] * h1[1]) + (h1[2] * h1[2] + h1[3] * h1[3]);
                    *(u32x4*)(hdst + eo) = pack8(h0, h1);
                    if (H8OUT) { u32x2 w8; w8.x = pk4_fp8(h0[0], h0[1], h0[2], h0[3]); w8.y = pk4_fp8(h1[0], h1[1], h1[2], h1[3]); *(u32x2*)(h8 + eo) = w8; }
                }
                ss += __shfl_xor(ss, 16); ss += __shfl_xor(ss, 32);
                if (fq == 0) X[(ai * 128 + wr * 64 + m * 16 + fr) * 4 + wc] = ss;
            }
        }
        LDS_WAIT(); __builtin_amdgcn_s_barrier(); asm volatile("" ::: "memory");
        const int lane = fq * 16 + fr, wid = wr * 4 + wc;
        if (lane < 32) { const int rl = wid * 32 + lane; const f32x4 v = *(const LAS f32x4*)(X + rl * 4); stats[(size_t)(u.pm * 256 + rl) * 4 + u.pn] = (v[0] + v[1]) + (v[2] + v[3]); }
    }
};
struct EpiQ {
    static constexpr bool PERM = true, AFTER_DRAIN = false;
    const float* stats; bf16_t* q; float sc;
    __device__ __forceinline__ void operator()(AccRef acc, const Unit& u, int wr, int wc, int fr, int fq) const {
        float rr[2][4];
#pragma unroll
        for (int ai = 0; ai < 2; ++ai)
#pragma unroll
            for (int m = 0; m < 4; ++m) rr[ai][m] = row_rstd(stats, u.pm * 256 + ai * 128 + wr * 64 + m * 16 + fr) * sc;
#pragma unroll
        for (int ai = 0; ai < 2; ++ai)
#pragma unroll
            for (int m = 0; m < 4; ++m) {
                const int row = u.pm * 256 + ai * 128 + wr * 64 + m * 16 + fr; const float r = rr[ai][m];
#pragma unroll
                for (int bj = 0; bj < 2; ++bj)
                    *(u32x4*)(q + (size_t)row * D + u.pn * 256 + bj * 128 + wc * 32 + fq * 8) = pack8(acc[ai][bj][m][0] * r, acc[ai][bj][m][1] * r);
            }
    }
};
template <bool MOE, bool F8 = false> struct EpiGU {
    static constexpr bool PERM = true, AFTER_DRAIN = false;
    const float* stats;
    const float* gwt;
    bf16_t* act; int ldc;
    __device__ __forceinline__ void operator()(AccRef acc, const Unit& u, int wr, int wc, int fr, int fq) const {
        float rr[2][4], gg[2][4];
#pragma unroll
        for (int ai = 0; ai < 2; ++ai)
#pragma unroll
            for (int m = 0; m < 4; ++m) { const int row = u.pm * 256 + ai * 128 + wr * 64 + m * 16 + fr; gg[ai][m] = 1.f; if (MOE) { rr[ai][m] = stats[row]; gg[ai][m] = gwt[row]; } else rr[ai][m] = row_rstd(stats, row); }
#pragma unroll
        for (int ai = 0; ai < 2; ++ai)
#pragma unroll
            for (int m = 0; m < 4; ++m) {
                const int row = u.pm * 256 + ai * 128 + wr * 64 + m * 16 + fr;
                float r = rr[ai][m], gw = gg[ai][m];
                if (F8) { r *= 1.0f / F8_WGU_SCALE; gw *= F8_ACT_SCALE; }
                f32x4 v[2];
#pragma unroll
                for (int n = 0; n < 2; ++n)
#pragma unroll
                    for (int i = 0; i < 4; ++i) v[n][i] = siluf_(acc[ai][0][m][n][i] * r) * (acc[ai][1][m][n][i] * r) * gw;
                if (F8) { u32x2 w8; w8.x = pk4_fp8(v[0][0], v[0][1], v[0][2], v[0][3]); w8.y = pk4_fp8(v[1][0], v[1][1], v[1][2], v[1][3]); *(u32x2*)((unsigned char*)act + (size_t)row * ldc + u.pn * 128 + wc * 32 + fq * 8) = w8; }
                else *(u32x4*)(act + (size_t)row * ldc + u.pn * 128 + wc * 32 + fq * 8) = pack8(v[0], v[1]);
            }
    }
};
struct EpiPlain {
    static constexpr bool PERM = true, AFTER_DRAIN = false;
    bf16_t* o0; bf16_t* o1; int ld0, ld1; size_t ls0, ls1; float osc = 1.f;
    __device__ __forceinline__ void operator()(AccRef acc, const Unit& u, int wr, int wc, int fr, int fq) const {
        const int which = u.tag & 1, layer = u.tag >> 1; bf16_t* o = which ? o1 + (size_t)layer * ls1 : o0 + (size_t)layer * ls0; const int ld = which ? ld1 : ld0;
#pragma unroll
        for (int ai = 0; ai < 2; ++ai)
#pragma unroll
            for (int m = 0; m < 4; ++m) {
                const int row = u.pm * 256 + ai * 128 + wr * 64 + m * 16 + fr;
#pragma unroll
                for (int bj = 0; bj < 2; ++bj)
                    *(u32x4*)(o + (size_t)row * ld + u.pn * 256 + bj * 128 + wc * 32 + fq * 8) = pack8(acc[ai][bj][m][0] * osc, acc[ai][bj][m][1] * osc);
            }
    }
};
constexpr int MOE_FULL_PANELS = (2 * T) / 256, MOE_TAIL_ROWS = 2048;
struct EpiDown {
    static constexpr bool PERM = true, AFTER_DRAIN = false;
    bf16_t* ye; float* part; float osc;
    __device__ __forceinline__ void operator()(AccRef acc, const Unit& u, int wr, int wc, int fr, int fq) const {
        if (u.tag == 0) {
#pragma unroll
            for (int ai = 0; ai < 2; ++ai)
#pragma unroll
                for (int m = 0; m < 4; ++m) {
                    const int row = u.pm * 256 + ai * 128 + wr * 64 + m * 16 + fr;
#pragma unroll
                    for (int bj = 0; bj < 2; ++bj)
                        *(u32x4*)(ye + (size_t)row * D + u.pn * 256 + bj * 128 + wc * 32 + fq * 8) = pack8(acc[ai][bj][m][0] * osc, acc[ai][bj][m][1] * osc);
                }
        } else {
            float* o = part + (size_t)(u.tag - 1) * MOE_TAIL_ROWS * D;
#pragma unroll
            for (int ai = 0; ai < 2; ++ai)
#pragma unroll
                for (int m = 0; m < 4; ++m) {
                    const int row = (u.pm - MOE_FULL_PANELS) * 256 + ai * 128 + wr * 64 + m * 16 + fr;
#pragma unroll
                    for (int bj = 0; bj < 2; ++bj)
#pragma unroll
                        for (int n = 0; n < 2; ++n)
                            *(f32x4*)(o + (size_t)row * D + u.pn * 256 + bj * 128 + wc * 32 + fq * 8 + n * 4) = acc[ai][bj][m][n] * osc;
                }
        }
    }
};
struct EpiSsm1 {
    static constexpr bool PERM = true, AFTER_DRAIN = true;
    const float* a16;
    bf16_t* xu;
    __device__ __forceinline__ void fused(AccRef acc, const Unit& u, int wr, int wc, int fr, int fq, LAS unsigned char* lds, int wid, int lane) const {
        LAS float* S = (LAS float*)lds;
#pragma unroll
        for (int ai = 0; ai < 2; ++ai)
#pragma unroll
            for (int m = 0; m < 4; ++m) {
                const int row = ai * 128 + wr * 64 + m * 16 + fr;
#pragma unroll
                for (int n = 0; n < 2; ++n) *(LAS f32x4*)(S + row * 128 + wc * 32 + fq * 8 + n * 4) = acc[ai][0][m][n];
            }
        LDS_WAIT(); __builtin_amdgcn_s_barrier(); asm volatile("" ::: "memory");
        LAS f32x2* Sp = (LAS f32x2*)lds; LAS f32x2* E = (LAS f32x2*)(lds + LDS_AUX);
        const int p = lane, seg = wid;
        const f32x2 a = *(const f32x2*)(a16 + 2 * p);
        f32x2 x = {0.f, 0.f};
        for (int c = seg * 32; c < seg * 32 + 32; ++c) { const f32x2 s = Sp[c * 64 + p]; Sp[c * 64 + p] = x; x = (f32x2){a.x * x.x - a.y * x.y + s.x, a.x * x.y + a.y * x.x + s.y}; }
        E[seg * 64 + p] = x;
        LDS_WAIT(); __builtin_amdgcn_s_barrier(); asm volatile("" ::: "memory");
        f32x2 a512 = a;
#pragma unroll
        for (int i = 0; i < 5; ++i) a512 = (f32x2){a512.x * a512.x - a512.y * a512.y, 2.f * a512.x * a512.y};
        f32x2 z = {0.f, 0.f};
        for (int j = 0; j < seg; ++j) { const f32x2 e = E[j * 64 + p]; z = (f32x2){a512.x * z.x - a512.y * z.y + e.x, a512.x * z.y + a512.y * z.x + e.y}; }
        for (int c = seg * 32; c < seg * 32 + 32; ++c) { const f32x2 hl = Sp[c * 64 + p];
            *(unsigned*)(xu + (size_t)c * 384 + 256 + 2 * p) = pk2(hl.x + z.x, hl.y + z.y);
            z = (f32x2){a.x * z.x - a.y * z.y, a.x * z.y + a.y * z.x}; }
    }
};
struct EpiSsm2 {
    static constexpr bool PERM = true, AFTER_DRAIN = false;
    bf16_t* ys; int b, g;
    __device__ __forceinline__ void operator()(AccRef acc, const Unit& u, int wr, int wc, int fr, int fq) const {
#pragma unroll
        for (int ai = 0; ai < 2; ++ai)
#pragma unroll
            for (int m = 0; m < 4; ++m) {
                const int c = ai * 128 + wr * 64 + m * 16 + fr;
#pragma unroll
                for (int bj = 0; bj < 2; ++bj) {
                    const int j = bj * 8 + wc * 2 + (fq >> 1), h0 = (fq & 1) * 8;
                    f32x4 v[2];
#pragma unroll
                    for (int n = 0; n < 2; ++n)
#pragma unroll
                        for (int i = 0; i < 4; ++i) v[n][i] = gelu_tanh_(acc[ai][bj][m][n][i]);
                    *(u32x4*)(ys + ((size_t)b * SEQ + c * 16 + j) * SW + g * 16 + h0) = pack8(v[0], v[1]);
                }
            }
    }
};

#define XB_TMO      128
#define XB_XCNT(j)  (256  + 64 * (j))
#define XB_XSUB(j)  (1280 + 64 * (j))
#define XB_XGEN(j)  (2304 + 64 * (j))
#define XB_TOP      3328
#define XB_TOPGEN   3392
#define XCD_BAR_WORDS 3456
#define XB_SPIN_CAP (1u << 18)
__device__ __forceinline__ unsigned xb_ld(unsigned* p)              { return __hip_atomic_load(p, __ATOMIC_RELAXED, __HIP_MEMORY_SCOPE_AGENT); }
__device__ __forceinline__ unsigned xb_add(unsigned* p, unsigned v) { return __hip_atomic_fetch_add(p, v, __ATOMIC_RELAXED, __HIP_MEMORY_SCOPE_AGENT); }
__device__ __forceinline__ unsigned xb_xcc_id() { return (unsigned)__builtin_amdgcn_s_getreg((3 << 11) | 20) & 0xFu; }
#define XB_SPIN(cond, bar) do { unsigned _sp = 0; while (cond) { __builtin_amdgcn_s_sleep(1); \
    if ((++_sp & 255u) == 0u) { if (xb_ld(&(bar)[XB_TMO])) break; if (_sp > XB_SPIN_CAP) { atomicAdd(&(bar)[XB_TMO], 1u); break; } } } } while (0)
struct XcdBarrier { unsigned* bar; unsigned x; volatile LAS unsigned* st; };
__device__ __forceinline__ XcdBarrier xcd_barrier_post(unsigned* bar, volatile LAS unsigned* st) {
    XcdBarrier b; b.bar = bar; b.x = xb_xcc_id(); b.st = st;
    if (threadIdx.x == 0) (void)xb_add(&bar[XB_XCNT(b.x)], 1u);
    return b;
}
__device__ __forceinline__ void xcd_barrier_complete(unsigned* bar, unsigned x, unsigned& nloc, unsigned& nx) {
    const unsigned G = gridDim.x * gridDim.y * gridDim.z;
    unsigned sum, cnt, mine, sp = 0u;
    for (;;) {
        sum = 0u; cnt = 0u; mine = 0u;
#pragma unroll
        for (unsigned j = 0; j < 16; ++j) { const unsigned c = xb_ld(&bar[XB_XCNT(j)]); sum += c; cnt += (c > 0u) ? 1u : 0u; mine = (j == x) ? c : mine; }
        if (sum == G) break;
        __builtin_amdgcn_s_sleep(1);
        if ((++sp & 255u) == 0u) { if (xb_ld(&bar[XB_TMO])) break; if (sp > XB_SPIN_CAP) { atomicAdd(&bar[XB_TMO], 1u); break; } }
    }
    nloc = mine > 0u ? mine : 1u; nx = cnt > 0u ? cnt : 1u;
}
__device__ __forceinline__ void xcd_barrier(const XcdBarrier& b, const int tid) {
    asm volatile("s_waitcnt vmcnt(0)" ::: "memory");
    __syncthreads();
    if (tid == 0) {
        unsigned* bar = b.bar;
        __builtin_amdgcn_s_waitcnt(0);
        unsigned nloc = b.st[0], nx = b.st[1];
        if (nloc == 0u) { xcd_barrier_complete(bar, b.x, nloc, nx); b.st[0] = nloc; b.st[1] = nx; }
        const unsigned old = xb_add(&bar[XB_XSUB(b.x)], 1u);
        const unsigned gen = old / nloc;
        if (old + 1u == (gen + 1u) * nloc) {
            __builtin_amdgcn_fence(__ATOMIC_RELEASE, "agent");
            asm volatile("s_waitcnt vmcnt(0)" ::: "memory");
            const unsigned og = xb_add(&bar[XB_TOP], 1u);
            const unsigned tg = og / nx;
            if (og + 1u == (tg + 1u) * nx) xb_add(&bar[XB_TOPGEN], 1u);
            else XB_SPIN(xb_ld(&bar[XB_TOPGEN]) == tg, bar);
            __builtin_amdgcn_fence(__ATOMIC_ACQUIRE, "agent");
            xb_add(&bar[XB_XGEN(b.x)], 1u);
            asm volatile("s_waitcnt vmcnt(0)" ::: "memory");
        } else {
            XB_SPIN(xb_ld(&bar[XB_XGEN(b.x)]) == gen, bar);
            __builtin_amdgcn_fence(__ATOMIC_ACQUIRE, "agent");
            asm volatile("s_waitcnt vmcnt(0)" ::: "memory");
        }
    }
    __syncthreads();
}

struct Args {
    const float* in[32];
    float* out; unsigned char* ws;
    int ph_lo, ph_hi;
};
enum { I_X = 0, I_MEM, I_MEMG, I_NMIXG, I_WIN, I_CONVW, I_CONVB, I_LNG, I_LNB, I_WPW, I_LRE, I_LIM, I_LOGDT, I_BRE, I_BIM, I_CRE, I_CIM, I_DSKIP, I_WGLU, I_WOUT,
       I_NXG, I_WQ, I_WKV, I_WO, I_NFG, I_FGU, I_FD, I_RW, I_RB, I_MGU, I_MD, I_FINALG };

struct Frame {
    LAS unsigned char* lds; int tid, lane, wave, c, G;
    unsigned char* ws; const float* const* in; float* out;
};
template <class Tp> __device__ __forceinline__ Tp* wsp(const Frame& F, size_t off) { return (Tp*)(F.ws + off); }

template <bool F8 = false>
__device__ __forceinline__ void xpose_matrix(const Frame& F, const float* W, int K, int Nsrc, int N, bf16_t* WT, int permlimit, int halfN, const float* gk, float sc, unsigned& item_base) {
    LAS float* scr = (LAS float*)(F.lds + F.wave * 16640);
    const int lane = F.lane, NGW = F.G * 8, gw = F.c * 8 + F.wave;
    const int nblk = N / 64, items = (K / 64) * nblk;
    int first = (int)(((unsigned)gw + (unsigned)NGW - (item_base % (unsigned)NGW)) % (unsigned)NGW);
    item_base = (item_base + (unsigned)items) % (unsigned)NGW;
    const int kr = lane >> 4, nc = (lane & 15) * 4;
    for (int it = first; it < items; it += NGW) {
        const int kb = it / nblk, nb = it % nblk, k0 = 64 * kb, n0 = 64 * nb;
        const int c0 = (n0 < permlimit) ? (((n0 >> 7) & 1) * halfN + (n0 >> 8) * 128 + (n0 & 127)) : n0;
        f32x4 v[16];
#pragma unroll
        for (int i = 0; i < 16; ++i) v[i] = *(const f32x4*)(W + (size_t)(k0 + 4 * i + kr) * Nsrc + c0 + nc);
#pragma unroll
        for (int i = 0; i < 16; ++i) { const float g = gk ? gk[k0 + 4 * i + kr] * sc : sc; LAS float* d = scr + (4 * i + kr) * 65 + nc;
            d[0] = v[i][0] * g; d[1] = v[i][1] * g; d[2] = v[i][2] * g; d[3] = v[i][3] * g; }
        LDS_WAIT(); asm volatile("" ::: "memory");
        const int c = lane & 7;
#pragma unroll
        for (int j = 0; j < 8; ++j) { const int n = (lane >> 3) + 8 * j; const LAS float* s = scr + (8 * c) * 65 + n;
            u32x4 o; o.x = pk2(s[0 * 65], s[1 * 65]); o.y = pk2(s[2 * 65], s[3 * 65]); o.z = pk2(s[4 * 65], s[5 * 65]); o.w = pk2(s[6 * 65], s[7 * 65]);
            if (F8) { u32x2 o8; o8.x = pk4_fp8(s[0 * 65], s[1 * 65], s[2 * 65], s[3 * 65]); o8.y = pk4_fp8(s[4 * 65], s[5 * 65], s[6 * 65], s[7 * 65]); *(u32x2*)((unsigned char*)WT + (size_t)(n0 + n) * K + k0 + 8 * c) = o8; }
            else *(u32x4*)(WT + (size_t)(n0 + n) * K + k0 + 8 * c) = o; }
        LDS_WAIT(); asm volatile("" ::: "memory");
    }
}
struct XDesc { unsigned long long src, dst, gk; int K, Nsrc, nblk, permlimit, halfN, f8; float sc; unsigned base; unsigned pad[2]; };
static_assert(sizeof(XDesc) == 64, "XDesc is four 16-byte words");
static_assert(MK_ONE_LAUNCH == 1, "deferred weights are converted inside the grid barriers of the one-launch kernel");
static_assert(F8_GATES && F8_QO && F8_MOE_MASK == 0xA && F8_DENSE_MASK == 0x4, "the deferred-conversion table below is written for this precision configuration");
constexpr int LDS_BGTAB = LDS_MISC + 256, BG_NMAT = 55 + (F8_IN_S ? 3 : 0);
static_assert(LDS_BGTAB + (BG_NMAT + 1) * 64 <= LDS_BYTES, "descriptor table inside the LDS allocation");
constexpr int MI_LCUR = 16, MI_SEQ = 17, MI_THR = 18  , MI_MCUR = 24  ;
__device__ __forceinline__ void xd_store(LAS XDesc* p, const XDesc& v) { const u32x4* q = (const u32x4*)&v; LAS u32x4* d = (LAS u32x4*)p; d[0] = q[0]; d[1] = q[1]; d[2] = q[2]; d[3] = q[3]; }
__device__ __forceinline__ XDesc xd_load(const LAS XDesc* p) { const LAS u32x4* d = (const LAS u32x4*)p; u32x4 q[4] = {d[0], d[1], d[2], d[3]}; return __builtin_bit_cast(XDesc, q); }
__device__ __forceinline__ unsigned xd_base(const LAS XDesc* p) { return ((const volatile LAS unsigned*)p)[13]; }
__device__ __forceinline__ void xpose_item(const Frame& F, const XDesc& d, int it) {
    LAS float* scr = (LAS float*)(F.lds + F.wave * 16640);
    const int lane = F.lane, kr = lane >> 4, nc = (lane & 15) * 4;
    const GAS float* W = (const GAS float*)d.src; const GAS float* gk = (const GAS float*)d.gk;     const int K = d.K, Nsrc = d.Nsrc;
    const int kb = it / d.nblk, nb = it - kb * d.nblk, k0 = 64 * kb, n0 = 64 * nb;
    const int c0 = (n0 < d.permlimit) ? (((n0 >> 7) & 1) * d.halfN + (n0 >> 8) * 128 + (n0 & 127)) : n0;
#pragma unroll
    for (int hh = 0; hh < 2; ++hh) {
        f32x4 v[8];
#pragma unroll
        for (int i = 0; i < 8; ++i) v[i] = *(const GAS f32x4*)(W + (size_t)(k0 + 4 * (8 * hh + i) + kr) * Nsrc + c0 + nc);
#pragma unroll
        for (int i = 0; i < 8; ++i) { const float g = gk ? gk[k0 + 4 * (8 * hh + i) + kr] * d.sc : d.sc; LAS float* q = scr + (4 * (8 * hh + i) + kr) * 65 + nc;
            q[0] = v[i][0] * g; q[1] = v[i][1] * g; q[2] = v[i][2] * g; q[3] = v[i][3] * g; }
    }
    LDS_WAIT(); asm volatile("" ::: "memory");
    const int c = lane & 7;
#pragma unroll
    for (int j = 0; j < 8; ++j) { const int n = (lane >> 3) + 8 * j; const LAS float* s = scr + (8 * c) * 65 + n;
        if (d.f8) { u32x2 o8; o8.x = pk4_fp8(s[0 * 65], s[1 * 65], s[2 * 65], s[3 * 65]); o8.y = pk4_fp8(s[4 * 65], s[5 * 65], s[6 * 65], s[7 * 65]); *(GAS u32x2*)((GAS unsigned char*)d.dst + (size_t)(n0 + n) * K + k0 + 8 * c) = o8; }
        else { u32x4 o; o.x = pk2(s[0 * 65], s[1 * 65]); o.y = pk2(s[2 * 65], s[3 * 65]); o.z = pk2(s[4 * 65], s[5 * 65]); o.w = pk2(s[6 * 65], s[7 * 65]); *(GAS u32x4*)((GAS bf16_t*)d.dst + (size_t)(n0 + n) * K + k0 + 8 * c) = o; } }
    LDS_WAIT(); asm volatile("" ::: "memory");
}
__device__ __forceinline__ bool bg_try(const Frame& F, unsigned limit) {
    volatile LAS unsigned* MISC = (volatile LAS unsigned*)(F.lds + LDS_MISC);
    LAS unsigned* lcur = (LAS unsigned*)(F.lds + LDS_MISC) + MI_LCUR;
    unsigned k = 0u; if (F.lane == 0) k = __hip_atomic_fetch_add(lcur, 1u, __ATOMIC_RELAXED, __HIP_MEMORY_SCOPE_WORKGROUP);
    k = (unsigned)__builtin_amdgcn_readfirstlane((int)k);
    const unsigned g = k * (unsigned)F.G + (unsigned)F.c;
    if (g >= limit) { if (F.lane == 0) __hip_atomic_fetch_sub(lcur, 1u, __ATOMIC_RELAXED, __HIP_MEMORY_SCOPE_WORKGROUP); return false; }
    const LAS XDesc* tab = (const LAS XDesc*)(F.lds + LDS_BGTAB);
    int m = (int)MISC[MI_MCUR + F.wave];
    while (g >= xd_base(tab + m + 1)) ++m;
    if (F.lane == 0) MISC[MI_MCUR + F.wave] = (unsigned)m;
    const XDesc d = xd_load(tab + m);
    xpose_item(F, d, (int)(g - d.base));
    return true;
}
__device__ __forceinline__ void bg_drain(const Frame& F, int which) {
    const unsigned limit = ((volatile LAS unsigned*)(F.lds + LDS_MISC))[MI_THR + which];
    while (bg_try(F, limit)) {}
}
__device__ __forceinline__ void ssm_tables(const Frame& F, int layer, int g) {
    LAS float* L = (LAS float*)F.lds;
    LAS float* AP = L;
    LAS float* BB = L + 17 * 128;
    LAS float* CC = BB + 2048;
    LAS float* KI = CC + 2048;
    const int tid = F.tid;
    const float* lre = F.in[I_LRE] + (size_t)(layer * NG + g) * SP; const float* lim = F.in[I_LIM] + (size_t)(layer * NG + g) * SP;
    const float dt = expf(F.in[I_LOGDT][layer * NG + g]);
    __syncthreads();
    for (int i = tid; i < 17 * 64; i += 512) { const int n = i >> 6, p = i & 63; const float mag = expf((float)n * lre[p] * dt), th = (float)n * (lim[p] * dt); AP[i * 2] = mag * cosf(th); AP[i * 2 + 1] = mag * sinf(th); }
    {
        const float* bre = F.in[I_BRE] + (size_t)(layer * NG + g) * SP * SG; const float* bim = F.in[I_BIM] + (size_t)(layer * NG + g) * SP * SG;
        for (int i = tid; i < 1024; i += 512) { const int p = i >> 4; const float lr = lre[p], li = lim[p];
            const float mag = expf(lr * dt), ar = mag * cosf(li * dt), aim = mag * sinf(li * dt), den = lr * lr + li * li, xr = ar - 1.0f;
            const float kr = (xr * lr + aim * li) / den, ki = (aim * lr - xr * li) / den, br = bre[i], bi = bim[i];
            BB[i * 2] = kr * br - ki * bi; BB[i * 2 + 1] = kr * bi + ki * br; }
        const float* cre = F.in[I_CRE] + (size_t)(layer * NG + g) * SG * SP; const float* cim = F.in[I_CIM] + (size_t)(layer * NG + g) * SG * SP;
        for (int i = tid; i < 1024; i += 512) { CC[i * 2] = cre[i]; CC[i * 2 + 1] = cim[i]; }
    }
    __syncthreads();
    for (int i = tid; i < 4096; i += 512) { const int tau = i >> 8, hp = (i >> 4) & 15, h = i & 15; float s = 0.f;
        for (int p = 0; p < 64; ++p) { const float ar = AP[(tau * 64 + p) * 2], ai = AP[(tau * 64 + p) * 2 + 1], br = BB[(p * 16 + h) * 2], bi = BB[(p * 16 + h) * 2 + 1];
            const float tr = ar * br - ai * bi, ti = ar * bi + ai * br; s += CC[(hp * 64 + p) * 2] * tr - CC[(hp * 64 + p) * 2 + 1] * ti; }
        if (tau == 0 && hp == h) s += F.in[I_DSKIP][(layer * NG + g) * SG + h];
        KI[i] = s; }
    __syncthreads();
    bf16_t* wst = wsp<bf16_t>(F, WS_WST) + (size_t)(layer * NG + g) * 256 * 256;
    bf16_t* tw = wsp<bf16_t>(F, WS_TW) + (size_t)(layer * NG + g) * 256 * 384;
    for (int i = tid; i < 256 * 128; i += 512) { const int row = i >> 7, cp = (i & 127) * 2; unsigned o = 0u;
        if (row < 128) { const int p = row >> 1, ri = row & 1; float v[2];
#pragma unroll
            for (int e = 0; e < 2; ++e) { const int col = cp + e, s = col >> 4, h = col & 15; const float ar = AP[((15 - s) * 64 + p) * 2], ai = AP[((15 - s) * 64 + p) * 2 + 1], br = BB[(p * 16 + h) * 2], bi = BB[(p * 16 + h) * 2 + 1];
                v[e] = ri ? (ar * bi + ai * br) : (ar * br - ai * bi); }
            o = pk2(v[0], v[1]); }
        *(unsigned*)(wst + (size_t)row * 256 + cp) = o; }
    for (int i = tid; i < 256 * 192; i += 512) { const int row = i / 192, cp = (i % 192) * 2, j = row >> 4, hp = row & 15; float v[2];
#pragma unroll
        for (int e = 0; e < 2; ++e) { const int col = cp + e;
            if (col < 256) { const int s = col >> 4, h = col & 15; v[e] = (j >= s) ? KI[((j - s) * 16 + hp) * 16 + h] : 0.f; }
            else { const int q = col - 256, p = q >> 1, ri = q & 1; const float ar = AP[((j + 1) * 64 + p) * 2], ai = AP[((j + 1) * 64 + p) * 2 + 1], cr = CC[(hp * 64 + p) * 2], ci = CC[(hp * 64 + p) * 2 + 1];
                v[e] = ri ? -(cr * ai + ci * ar) : (cr * ar - ci * ai); } }
        *(unsigned*)(tw + (size_t)row * 384 + cp) = pk2(v[0], v[1]); }
    float* a16 = wsp<float>(F, WS_A16) + (size_t)(layer * NG + g) * 128;
    for (int i = tid; i < 128; i += 512) a16[i] = AP[16 * 128 + i];
    __syncthreads();
}

__device__ __forceinline__ void prologue(const Frame& F) {
    if (F.tid == 0) {
        LAS XDesc* tab = (LAS XDesc*)(F.lds + LDS_BGTAB); volatile LAS unsigned* MISC = (volatile LAS unsigned*)(F.lds + LDS_MISC);
        int n = 0; unsigned base = 0u;
#define XQ_ADD(SRC, K_, NSRC_, N_, DST, PERML, HALFN, GK, SC, F8_) do { XDesc xd_; xd_.src = (unsigned long long)(SRC); xd_.dst = (unsigned long long)(DST); xd_.gk = (unsigned long long)(GK); xd_.K = (K_); xd_.Nsrc = (NSRC_); xd_.nblk = (N_) / 64; \
        xd_.permlimit = (PERML); xd_.halfN = (HALFN); xd_.f8 = (F8_) ? 1 : 0; xd_.sc = (SC); xd_.base = base; xd_.pad[0] = 0u; xd_.pad[1] = 0u; xd_store(tab + n, xd_); base += (unsigned)(((K_) / 64) * ((N_) / 64)); ++n; } while (0)
#define XQ_MIXER(l) do { \
        XQ_ADD(F.in[I_WIN] + (size_t)(l) * D * INC, D, INC, (F8_IN_S ? 1024 : 1536), wsp<bf16_t>(F, WS_WIN) + (size_t)(l) * INC * D, 1024, 512, F.in[I_NMIXG] + (l) * D, 1.f, false); \
        if (F8_IN_S) XQ_ADD(F.in[I_WIN] + (size_t)(l) * D * INC + 1024, D, INC, 512, wsp<bf16_t>(F, WS_WIN) + (size_t)(l) * INC * D + (size_t)2560 * D, 0, 0, F.in[I_NMIXG] + (l) * D, F8_WGU_SCALE, true);     \
        XQ_ADD(F.in[I_WIN] + (size_t)(l) * D * INC + 1536, D, INC, 2048, wsp<bf16_t>(F, WS_WIN) + (size_t)(l) * INC * D + (size_t)1536 * D, 0, 0, F.in[I_NMIXG] + (l) * D, F8_WGU_SCALE, true); \
        XQ_ADD(F.in[I_WPW] + (size_t)(l) * CW * D, CW, D, D, wsp<bf16_t>(F, WS_WPW) + (size_t)(l) * D * CW, 0, 0, (const float*)nullptr, 1.f, false); \
        XQ_ADD(F.in[I_WGLU] + (size_t)(l) * SW * 2 * D, SW, 2 * D, 2 * D, wsp<bf16_t>(F, WS_WGLU) + (size_t)(l) * 2 * D * SW, 2 * D, D, (const float*)nullptr, 1.f, false); \
        XQ_ADD(F.in[I_WOUT] + (size_t)(l) * D * D, D, D, D, wsp<bf16_t>(F, WS_WOUT) + (size_t)(l) * D * D, 0, 0, (const float*)nullptr, 1.f, false); \
        XQ_ADD(F.in[I_WQ] + (size_t)(l) * D * D, D, D, D, wsp<bf16_t>(F, WS_WQ) + (size_t)(l) * D * D, 0, 0, F.in[I_NXG] + (l) * D, 0.0625f * F8_WQ_SCALE, true); \
        XQ_ADD(F.in[I_WO] + (size_t)(l) * D * D, D, D, D, wsp<bf16_t>(F, WS_WO) + (size_t)(l) * D * D, 0, 0, (const float*)nullptr, F8_WO_SCALE, true); } while (0)
#define XQ_MOE(j) do { for (int e = 0; e < NE; ++e) { \
        XQ_ADD(F.in[I_MGU] + (size_t)((j) * NE + e) * D * 2 * DFE, D, 2 * DFE, 2 * DFE, (unsigned char*)wsp<bf16_t>(F, WS_WMGU) + (size_t)(j) * NE * 2 * DFE * D * 2 + (size_t)e * 2 * DFE * D, 2 * DFE, DFE, F.in[I_NFG] + (2 * (j) + 1) * D, F8_WGU_SCALE, true); \
        XQ_ADD(F.in[I_MD] + (size_t)((j) * NE + e) * DFE * D, DFE, D, D, (unsigned char*)wsp<bf16_t>(F, WS_WMD) + (size_t)(j) * NE * D * DFE * 2 + (size_t)e * D * DFE, 0, 0, (const float*)nullptr, F8_WD_SCALE, true); } } while (0)
        XQ_MIXER(1); XQ_MOE(0); MISC[MI_THR + 0] = base;
        XQ_MIXER(2);
        XQ_ADD(F.in[I_FGU] + (size_t)1 * D * 2 * DFF, D, 2 * DFF, 2 * DFF, wsp<bf16_t>(F, WS_WFGU) + (size_t)1 * 2 * DFF * D, 2 * DFF, DFF, F.in[I_NFG] + 2 * D, F8_WGU_SCALE, true);
        XQ_ADD(F.in[I_FD] + (size_t)1 * DFF * D, DFF, D, D, wsp<bf16_t>(F, WS_WFD) + (size_t)1 * D * DFF, 0, 0, (const float*)nullptr, F8_WD_SCALE, true);
        MISC[MI_THR + 1] = base;
        XQ_MIXER(3); XQ_MOE(1); MISC[MI_THR + 2] = base;
        XDesc sent{}; sent.base = base; xd_store(tab + n, sent);
#undef XQ_MOE
#undef XQ_MIXER
#undef XQ_ADD
    }
    unsigned ib = 0u;
    {
        const int l = 0;
        xpose_matrix(F, F.in[I_WIN] + (size_t)l * D * INC, D, INC, (F8_IN_S ? 1024 : 1536), wsp<bf16_t>(F, WS_WIN) + (size_t)l * INC * D, 1024, 512, F.in[I_NMIXG] + l * D, 1.f, ib);
        if (F8_IN_S) xpose_matrix<true>(F, F.in[I_WIN] + (size_t)l * D * INC + 1024, D, INC, 512, wsp<bf16_t>(F, WS_WIN) + (size_t)l * INC * D + (size_t)2560 * D, 0, 0, F.in[I_NMIXG] + l * D, F8_WGU_SCALE, ib);
        xpose_matrix<true>(F, F.in[I_WIN] + (size_t)l * D * INC + 1536, D, INC, 2048, wsp<bf16_t>(F, WS_WIN) + (size_t)l * INC * D + (size_t)1536 * D, 0, 0, F.in[I_NMIXG] + l * D, F8_WGU_SCALE, ib);
        xpose_matrix(F, F.in[I_WPW] + (size_t)l * CW * D, CW, D, D, wsp<bf16_t>(F, WS_WPW) + (size_t)l * D * CW, 0, 0, nullptr, 1.f, ib);
        xpose_matrix(F, F.in[I_WGLU] + (size_t)l * SW * 2 * D, SW, 2 * D, 2 * D, wsp<bf16_t>(F, WS_WGLU) + (size_t)l * 2 * D * SW, 2 * D, D, nullptr, 1.f, ib);
        xpose_matrix(F, F.in[I_WOUT] + (size_t)l * D * D, D, D, D, wsp<bf16_t>(F, WS_WOUT) + (size_t)l * D * D, 0, 0, nullptr, 1.f, ib);
        xpose_matrix<true>(F, F.in[I_WQ] + (size_t)l * D * D, D, D, D, wsp<bf16_t>(F, WS_WQ) + (size_t)l * D * D, 0, 0, F.in[I_NXG] + l * D, 0.0625f * F8_WQ_SCALE, ib);
        xpose_matrix<true>(F, F.in[I_WO] + (size_t)l * D * D, D, D, D, wsp<bf16_t>(F, WS_WO) + (size_t)l * D * D, 0, 0, nullptr, F8_WO_SCALE, ib);
    }
    for (int l = 0; l < DEPTH; ++l) xpose_matrix(F, F.in[I_WKV] + (size_t)l * D * 2 * D, D, 2 * D, 2 * D, wsp<bf16_t>(F, WS_WKV) + (size_t)l * 2 * D * D, 0, 0, nullptr, 1.f, ib);
    xpose_matrix(F, F.in[I_FGU], D, 2 * DFF, 2 * DFF, wsp<bf16_t>(F, WS_WFGU), 2 * DFF, DFF, F.in[I_NFG], 1.f, ib);
    xpose_matrix(F, F.in[I_FD], DFF, D, D, wsp<bf16_t>(F, WS_WFD), 0, 0, nullptr, 1.f, ib);
    const int gw = F.c * 8 + F.wave, NGW = F.G * 8, lane = F.lane;
    { const float* gm = F.in[I_MEMG]; bf16_t* mn = wsp<bf16_t>(F, WS_MEMN);
      for (int r = gw; r < NMEM; r += NGW) { const f32x4* xr = (const f32x4*)(F.in[I_MEM] + (size_t)r * D) + lane; f32x4 v[4]; float s = 0.f;
#pragma unroll
          for (int j = 0; j < 4; ++j) { v[j] = xr[64 * j]; s += (v[j][0] * v[j][0] + v[j][1] * v[j][1]) + (v[j][2] * v[j][2] + v[j][3] * v[j][3]); }
          const float rs = __builtin_amdgcn_rsqf(wave_sum(s) * (1.f / D) + RMS_EPS);
#pragma unroll
          for (int j = 0; j < 4; ++j) { const f32x4 gg = ((const f32x4*)gm)[64 * j + lane]; u32x2 o; o.x = pk2(v[j][0] * rs * gg[0], v[j][1] * rs * gg[1]); o.y = pk2(v[j][2] * rs * gg[2], v[j][3] * rs * gg[3]);
              *((u32x2*)(mn + (size_t)r * D) + 64 * j + lane) = o; } } }
    { bf16_t* h = wsp<bf16_t>(F, WS_H); float* st = wsp<float>(F, WS_STATS); unsigned* h8 = wsp<unsigned>(F, WS_H8);
      for (int r = gw; r < T; r += NGW) { const f32x4* xr = (const f32x4*)(F.in[I_X] + (size_t)r * D) + lane; float s = 0.f;
#pragma unroll
          for (int j = 0; j < 4; ++j) { const f32x4 v = xr[64 * j]; s += (v[0] * v[0] + v[1] * v[1]) + (v[2] * v[2] + v[3] * v[3]); u32x2 o; o.x = pk2(v[0], v[1]); o.y = pk2(v[2], v[3]);
              *((u32x2*)(h + (size_t)r * D) + 64 * j + lane) = o; if (F8_GATES) h8[(size_t)r * (D / 4) + 64 * j + lane] = pk4_fp8(v[0], v[1], v[2], v[3]); }
          s = wave_sum(s);
          if (lane < 4) st[(size_t)r * 4 + lane] = (lane == 0) ? s : 0.f; } }
    for (int it = F.c; it < DEPTH * NG; it += F.G) ssm_tables(F, it / NG, it % NG);
}

__device__ __forceinline__ void conv_phase(const Frame& F, int layer) {
    const bf16_t* uin_g = wsp<bf16_t>(F, WS_UCONV); bf16_t* uc = wsp<bf16_t>(F, WS_UC);
    LAS bf16_t* uin = (LAS bf16_t*)F.lds;
    LAS float* yb = (LAS float*)(F.lds + 65536);
    const int tid = F.tid, lane = F.lane, wave = F.wave;
    float w[CK];
#pragma unroll
    for (int k = 0; k < CK; ++k) w[k] = F.in[I_CONVW][(size_t)(layer * CK + k) * CW + tid];
    const float bias = F.in[I_CONVB][layer * CW + tid];
    f32x4 lg0, lg1, lb0, lb1;
    { const f32x4* gp = (const f32x4*)(F.in[I_LNG] + layer * CW + lane * 8); lg0 = gp[0]; lg1 = gp[1]; const f32x4* bp = (const f32x4*)(F.in[I_LNB] + layer * CW + lane * 8); lb0 = bp[0]; lb1 = bp[1]; }
    for (int tile = F.c; tile < T / 32; tile += F.G) {
        const int t0 = tile * 32, p0 = t0 & (SEQ - 1);
        __syncthreads();
#pragma unroll
        for (int it = 0; it < 8; ++it) { const int id = it * 512 + tid;
            if (id < 62 * 64) { const int row = id >> 6, ch = id & 63; u32x4 v = {0u, 0u, 0u, 0u};
                if (p0 - 30 + row >= 0) v = *(const u32x4*)(uin_g + (size_t)(t0 - 30 + row) * CW + ch * 8);
                *(LAS u32x4*)(uin + row * 512 + ch * 8) = v; } }
        __syncthreads();
        float y[32], uu[62];
#pragma unroll
        for (int o = 0; o < 32; ++o) y[o] = bias;
#pragma unroll
        for (int j = 0; j < 62; ++j) uu[j] = __uint_as_float(((unsigned)uin[j * 512 + tid]) << 16);
#pragma unroll
        for (int k = 0; k < CK; ++k)
#pragma unroll
            for (int o = 0; o < 32; ++o) y[o] += w[k] * uu[o + k];
#pragma unroll
        for (int o = 0; o < 32; ++o) yb[o * 512 + tid] = y[o];
        __syncthreads();
#pragma unroll
        for (int q = 0; q < 4; ++q) { const int o = wave + 8 * q; const LAS f32x4* rp = (const LAS f32x4*)(yb + o * 512 + lane * 8); f32x4 a = rp[0], b = rp[1];
            const float mean = wave_sum((a[0] + a[1]) + (a[2] + a[3]) + (b[0] + b[1]) + (b[2] + b[3])) * (1.f / CW);
            a = a - mean; b = b - mean;
            const float var = wave_sum((a[0] * a[0] + a[1] * a[1]) + (a[2] * a[2] + a[3] * a[3]) + (b[0] * b[0] + b[1] * b[1]) + (b[2] * b[2] + b[3] * b[3])) * (1.f / CW);
            const float rs = __builtin_amdgcn_rsqf(var + LN_EPS);
            a = a * rs * lg0 + lb0; b = b * rs * lg1 + lb1;
#pragma unroll
            for (int i = 0; i < 4; ++i) { a[i] = siluf_(a[i]); b[i] = siluf_(b[i]); }
            *(u32x4*)(uc + (size_t)(t0 + o) * CW + lane * 8) = pack8(a, b); }
    }
    __syncthreads();
}

#define MFMA32(a, b, c) __builtin_amdgcn_mfma_f32_32x32x16_bf16((a), (b), (c), 0, 0, 0)
#define ATT_LOAD16(dst, ptr0, stride_bytes) do { unsigned long long _p = (unsigned long long)(ptr0); _Pragma("unroll") for (int it = 0; it < 16; ++it) { dst[it] = *(const GAS u32x4*)_p; _p += (stride_bytes); asm volatile("" : "+v"(_p)); } } while (0)
#define ATT_STORE16(src) do { LAS char* _w0 = (LAS char*)Ks + (tid >> 5) * 528 + (tid & 31) * 16; asm volatile("" : "+v"(_w0)); LAS char* _w1 = _w0 + 8 * 8448; _Pragma("unroll") for (int it = 0; it < 8; ++it) { *(LAS u32x4*)(_w0 + it * 8448) = src[it]; *(LAS u32x4*)(_w1 + it * 8448) = src[it + 8]; } } while (0)
__device__ __forceinline__ void attn_phase(const Frame& F, int layer) {
    const bf16_t* Q = wsp<bf16_t>(F, WS_Q); const bf16_t* Km = wsp<bf16_t>(F, WS_KMAT) + (size_t)layer * NMEM * D; const bf16_t* Vt = wsp<bf16_t>(F, WS_VT) + (size_t)layer * D * NMEM;
    bf16_t* AO = wsp<bf16_t>(F, WS_AO);
    LAS bf16_t* Ks = (LAS bf16_t*)F.lds;
    const int tid = F.tid, lane = F.lane, wave = F.wave, l31 = lane & 31, lh = lane >> 5;
    constexpr int NU = BATCH * HEADS * (SEQ / 256);
    u32x4 Kr[16];
    if (F.c < NU) { const int bh = F.c & 31, b = bh >> 2, hd = bh & 3;
        ATT_LOAD16(Kr, Km + (size_t)(b * MEM + (tid >> 5)) * D + hd * HD + (tid & 31) * 8, 16 * D * 2); }
    for (int unit = F.c; unit < NU; unit += F.G) {
        const int bh = unit & 31, qt = unit >> 5, b = bh >> 2, hd = bh & 3;
        const size_t qrow = (size_t)b * SEQ + qt * 256 + wave * 32 + l31;
        bf16x8 Qf[16];
#pragma unroll
        for (int db = 0; db < 16; ++db) Qf[db] = *(const bf16x8*)(Q + qrow * D + hd * HD + db * 16 + lh * 8);
        __syncthreads();
        ATT_STORE16(Kr);
        ATT_LOAD16(Kr, Vt + (size_t)(hd * HD + (tid >> 5)) * NMEM + b * MEM + (tid & 31) * 8, 16 * NMEM * 2);
        __syncthreads();
        u32x4 sp[8][2];
        float mx = -3.0e38f;
#pragma unroll
        for (int kb = 0; kb < 8; ++kb) {
            f32x16 sc;
#pragma unroll
            for (int i = 0; i < 16; ++i) sc[i] = 0.f;
#pragma unroll
            for (int db = 0; db < 16; ++db) { const bf16x8 a = *(const LAS bf16x8*)(Ks + (kb * 32 + l31) * 264 + db * 16 + lh * 8); sc = MFMA32(a, Qf[db], sc); }
#pragma unroll
            for (int i = 0; i < 16; ++i) mx = fmaxf(mx, sc[i]);
#pragma unroll
            for (int hh = 0; hh < 2; ++hh) { sp[kb][hh].x = pk2(sc[8 * hh + 0], sc[8 * hh + 1]); sp[kb][hh].y = pk2(sc[8 * hh + 2], sc[8 * hh + 3]); sp[kb][hh].z = pk2(sc[8 * hh + 4], sc[8 * hh + 5]); sp[kb][hh].w = pk2(sc[8 * hh + 6], sc[8 * hh + 7]); }
        }
        mx = fmaxf(mx, __shfl_xor(mx, 32));
        float sum = 0.f;
        bf16x8 Pf[16];
#pragma unroll
        for (int kb = 0; kb < 8; ++kb)
#pragma unroll
            for (int hh = 0; hh < 2; ++hh) { f32x4 a, bq; unpack8(sp[kb][hh], a, bq);
#pragma unroll
                for (int i = 0; i < 4; ++i) { a[i] = fast_exp2((a[i] - mx) * 1.44269504f); bq[i] = fast_exp2((bq[i] - mx) * 1.44269504f); sum += a[i] + bq[i]; }
                Pf[kb * 2 + hh] = __builtin_bit_cast(bf16x8, pack8(a, bq)); }
        sum += __shfl_xor(sum, 32);
        const float inv = 1.0f / sum;
        __syncthreads();
        ATT_STORE16(Kr);
        if (unit + F.G < NU) { const int nbh = (unit + F.G) & 31, nb = nbh >> 2, nhd = nbh & 3;
            ATT_LOAD16(Kr, Km + (size_t)(nb * MEM + (tid >> 5)) * D + nhd * HD + (tid & 31) * 8, 16 * D * 2); }
        __syncthreads();
#pragma unroll
        for (int db = 0; db < 8; ++db) {
            f32x16 o;
#pragma unroll
            for (int i = 0; i < 16; ++i) o[i] = 0.f;
#pragma unroll
            for (int kk = 0; kk < 16; ++kk) { const LAS bf16_t* base = Ks + (db * 32 + l31) * 264 + kk * 16 + 4 * lh;
                const u32x2 lo = *(const LAS u32x2*)base, hi = *(const LAS u32x2*)(base + 8);
                u32x4 w; w.x = lo.x; w.y = lo.y; w.z = hi.x; w.w = hi.y;
                o = MFMA32(__builtin_bit_cast(bf16x8, w), Pf[kk], o); }
#pragma unroll
            for (int g4 = 0; g4 < 4; ++g4) {
                if (F8_QO) *(unsigned*)((unsigned char*)AO + qrow * D + hd * HD + db * 32 + 8 * g4 + 4 * lh) = pk4_fp8(o[4 * g4 + 0] * (inv * F8_AO_SCALE), o[4 * g4 + 1] * (inv * F8_AO_SCALE), o[4 * g4 + 2] * (inv * F8_AO_SCALE), o[4 * g4 + 3] * (inv * F8_AO_SCALE));
                else { u32x2 w; w.x = pk2(o[4 * g4 + 0] * inv, o[4 * g4 + 1] * inv); w.y = pk2(o[4 * g4 + 2] * inv, o[4 * g4 + 3] * inv); *(u32x2*)(AO + qrow * D + hd * HD + db * 32 + 8 * g4 + 4 * lh) = w; } }
        }
    }
    __syncthreads();
}

__device__ __forceinline__ void router_phase(const Frame& F, int layer, int j) {
    const bf16_t* h = wsp<bf16_t>(F, WS_H);
    unsigned* toke = (unsigned*)(F.ws + WS_META + MT_TOKE); float* tokw = (float*)(F.ws + WS_META + MT_TOKW); float* tokr = (float*)(F.ws + WS_META + MT_TOKR); int* wgcnt = (int*)(F.ws + WS_META + MT_WGCNT);
    LAS int* cnt = (LAS int*)(F.lds + LDS_AUX);
    const int lane = F.lane, wave = F.wave, tid = F.tid;
    float wr_[16][8];
    { const float* rw = F.in[I_RW] + (size_t)j * D * NE; const float* gg = F.in[I_NFG] + (size_t)layer * D;
#pragma unroll
      for (int kk = 0; kk < 16; ++kk) { const int k = lane * 16 + kk; const f32x4 a = *(const f32x4*)(rw + (size_t)k * NE), b = *(const f32x4*)(rw + (size_t)k * NE + 4); const float g = gg[k];
#pragma unroll
          for (int e = 0; e < 4; ++e) { wr_[kk][e] = a[e] * g; wr_[kk][4 + e] = b[e] * g; } } }
    float rb[8];
#pragma unroll
    for (int e = 0; e < 8; ++e) rb[e] = F.in[I_RB][j * NE + e];
    for (int chunk = F.c; chunk < T / 128; chunk += F.G) {
        __syncthreads();
        if (tid < 8) cnt[tid] = 0;
        __syncthreads();
        for (int ib = 0; ib < 16; ib += 4) {
          u32x4 qa[4], qb[4];
#pragma unroll
          for (int ii = 0; ii < 4; ++ii) { const int tk = chunk * 128 + wave * 16 + ib + ii; qa[ii] = *(const u32x4*)(h + (size_t)tk * D + lane * 16); qb[ii] = *(const u32x4*)(h + (size_t)tk * D + lane * 16 + 8); }
#pragma unroll
          for (int ii = 0; ii < 4; ++ii) {
            const int tok = chunk * 128 + wave * 16 + ib + ii;
            const u32x4 q0 = qa[ii], q1 = qb[ii];
            float x[16]; { f32x4 a, b, c, d; unpack8(q0, a, b); unpack8(q1, c, d);
#pragma unroll
                for (int e = 0; e < 4; ++e) { x[e] = a[e]; x[4 + e] = b[e]; x[8 + e] = c[e]; x[12 + e] = d[e]; } }
            float ss = 0.f, dt[8];
#pragma unroll
            for (int e = 0; e < 8; ++e) dt[e] = 0.f;
#pragma unroll
            for (int kk = 0; kk < 16; ++kk) { ss += x[kk] * x[kk];
#pragma unroll
                for (int e = 0; e < 8; ++e) dt[e] += x[kk] * wr_[kk][e]; }
            ss = wave_sum(ss);
#pragma unroll
            for (int e = 0; e < 8; ++e) dt[e] = wave_sum(dt[e]);
            const float r = __builtin_amdgcn_rsqf(ss * (1.f / D) + RMS_EPS);
            float v1 = -3.0e38f, v2 = -3.0e38f; int e1 = 0, e2 = 0;
#pragma unroll
            for (int e = 0; e < 8; ++e) { const float lg = dt[e] * r + rb[e]; if (lg > v1) { v2 = v1; e2 = e1; v1 = lg; e1 = e; } else if (lg > v2) { v2 = lg; e2 = e; } }
            const float w1 = 1.0f / (1.0f + __expf(v2 - v1)), w2 = 1.0f - w1;
            if (lane == 0) { toke[tok] = (unsigned)e1 | ((unsigned)e2 << 8); tokw[2 * tok] = w1; tokw[2 * tok + 1] = w2; tokr[tok] = r;
                atomicAdd((int*)&cnt[e1], 1); atomicAdd((int*)&cnt[e2], 1); }
          }
        }
        __syncthreads();
        if (tid < 8) wgcnt[chunk * 8 + tid] = cnt[tid];
    }
    __syncthreads();
}
template <bool F8>
__device__ __forceinline__ void assign_phase(const Frame& F) {
    const bf16_t* h = wsp<bf16_t>(F, WS_H); bf16_t* hs = wsp<bf16_t>(F, WS_HS);
    const unsigned* toke = (const unsigned*)(F.ws + WS_META + MT_TOKE); const float* tokw = (const float*)(F.ws + WS_META + MT_TOKW); const float* tokr = (const float*)(F.ws + WS_META + MT_TOKR);
    int* tokslot = (int*)(F.ws + WS_META + MT_TOKSLOT); float* rscale = (float*)(F.ws + WS_META + MT_RSCALE); float* gwt = (float*)(F.ws + WS_META + MT_GWT);
    const int* wgcnt = (const int*)(F.ws + WS_META + MT_WGCNT); int* pexp = (int*)(F.ws + WS_META + MT_PEXP); unsigned* ctl = (unsigned*)(F.ws + WS_CTL);
    LAS int* cl = (LAS int*)(F.lds);
    LAS int* tot = (LAS int*)(F.lds + 8192);
    LAS int* sl = (LAS int*)(F.lds + 8192 + 256);
    const int tid = F.tid, lane = F.lane, wave = F.wave;
    for (int chunk = F.c; chunk < T / 128; chunk += F.G) {
        __syncthreads();
        if (tid < 16) tot[tid] = 0;
        __syncthreads();
        if (tid < 256) {
            const u32x4 c0 = *(const u32x4*)(wgcnt + tid * 8), c1 = *(const u32x4*)(wgcnt + tid * 8 + 4);
            const int my[8] = {(int)c0.x, (int)c0.y, (int)c0.z, (int)c0.w, (int)c1.x, (int)c1.y, (int)c1.z, (int)c1.w};
#pragma unroll
            for (int e = 0; e < 8; ++e) { int a = my[e], p = (tid < chunk) ? my[e] : 0;
#pragma unroll
                for (int o = 1; o < 64; o <<= 1) { a += __shfl_xor(a, o); p += __shfl_xor(p, o); }
                if (lane == 0) { atomicAdd((int*)&tot[e], a); atomicAdd((int*)&tot[8 + e], p); } }
        }
        __syncthreads();
        if (tid == 0) { int base = 0; for (int e = 0; e < 8; ++e) { tot[16 + e] = base; tot[24 + e] = base + tot[8 + e]; base += (tot[e] + 255) & ~255; }
            if (chunk == 0) { ctl[CW_PTOTAL] = (unsigned)(base >> 8); int pp = 0; for (int e = 0; e < 8; ++e) { ctl[CW_PBASE + e] = (unsigned)(tot[16 + e] >> 8); const int np = (tot[e] + 255) >> 8; for (int q = 0; q < np; ++q) pexp[pp++] = e; } } }
        __syncthreads();
        if (chunk == 0) {
            for (int e = 0; e < 8; ++e) { const int lo = tot[16 + e] + tot[e], hi = tot[16 + e] + ((tot[e] + 255) & ~255);
                for (int s = lo + tid; s < hi; s += 512) { rscale[s] = 0.f; gwt[s] = 0.f; } } }
        if (wave == 0) {
            for (int it = 0; it < 2; ++it) { const int li = it * 64 + lane, tok = chunk * 128 + li; const unsigned ee = toke[tok]; const int e1 = ee & 255, e2 = (ee >> 8) & 255; int s1 = 0, s2 = 0;
                const unsigned long long ltmask = (1ull << lane) - 1ull;
#pragma unroll
                for (int e = 0; e < 8; ++e) { const unsigned long long m1 = __ballot(e1 == e), m2 = __ballot(e2 == e); const int off = tot[24 + e];
                    if (e1 == e) s1 = off + __popcll(m1 & ltmask);
                    if (e2 == e) s2 = off + __popcll(m1) + __popcll(m2 & ltmask);
                    __builtin_amdgcn_s_waitcnt(0);
                    if (lane == 0) tot[24 + e] = off + __popcll(m1) + __popcll(m2);
                    __builtin_amdgcn_s_waitcnt(0); }
                sl[li * 2] = s1; sl[li * 2 + 1] = s2; tokslot[2 * tok] = s1; tokslot[2 * tok + 1] = s2;
                const float r = tokr[tok]; rscale[s1] = r; rscale[s2] = r; gwt[s1] = tokw[2 * tok]; gwt[s2] = tokw[2 * tok + 1]; }
        }
        __syncthreads();
        for (int q = wave; q < 256; q += 8) { const int li = q >> 1, tok = chunk * 128 + li, s = sl[q];
            const u32x4 a = *(const u32x4*)(h + (size_t)tok * D + lane * 16), b = *(const u32x4*)(h + (size_t)tok * D + lane * 16 + 8);
            if (F8) { f32x4 x0, x1, x2, x3; unpack8(a, x0, x1); unpack8(b, x2, x3); u32x4 o8; o8.x = pk4_fp8(x0[0], x0[1], x0[2], x0[3]); o8.y = pk4_fp8(x1[0], x1[1], x1[2], x1[3]); o8.z = pk4_fp8(x2[0], x2[1], x2[2], x2[3]); o8.w = pk4_fp8(x3[0], x3[1], x3[2], x3[3]);
                *(u32x4*)((unsigned char*)hs + (size_t)s * D + lane * 16) = o8; }
            else { *(u32x4*)(hs + (size_t)s * D + lane * 16) = a; *(u32x4*)(hs + (size_t)s * D + lane * 16 + 8) = b; } }
    }
    __syncthreads();
}
__device__ __forceinline__ void combine_phase(const Frame& F, bool final_) {
    bf16_t* h = wsp<bf16_t>(F, WS_H); const bf16_t* ye = wsp<bf16_t>(F, WS_YE); const float* part = wsp<float>(F, WS_MPART); const int* tokslot = (const int*)(F.ws + WS_META + MT_TOKSLOT); float* st = wsp<float>(F, WS_STATS);
    const int gw = F.c * 8 + F.wave, NGW = F.G * 8, lane = F.lane;
    for (int tok = gw; tok < T; tok += NGW) {
        const int s1 = __builtin_amdgcn_readfirstlane(tokslot[2 * tok]), s2 = __builtin_amdgcn_readfirstlane(tokslot[2 * tok + 1]);
        f32x4 x[4], y[4], z[4];
        unpack8(*(const u32x4*)(h + (size_t)tok * D + lane * 16), x[0], x[1]); unpack8(*(const u32x4*)(h + (size_t)tok * D + lane * 16 + 8), x[2], x[3]);
        if (s1 < 2 * T) { unpack8(*(const u32x4*)(ye + (size_t)s1 * D + lane * 16), y[0], y[1]); unpack8(*(const u32x4*)(ye + (size_t)s1 * D + lane * 16 + 8), y[2], y[3]); }
        else { const f32x4* p = (const f32x4*)(part + (size_t)(s1 - 2 * T) * D + lane * 16);
#pragma unroll
            for (int q = 0; q < 4; ++q) y[q] = (p[q] + p[q + (size_t)MOE_TAIL_ROWS * D / 4]) + (p[q + (size_t)2 * MOE_TAIL_ROWS * D / 4] + p[q + (size_t)3 * MOE_TAIL_ROWS * D / 4]); }
        if (s2 < 2 * T) { unpack8(*(const u32x4*)(ye + (size_t)s2 * D + lane * 16), z[0], z[1]); unpack8(*(const u32x4*)(ye + (size_t)s2 * D + lane * 16 + 8), z[2], z[3]); }
        else { const f32x4* p = (const f32x4*)(part + (size_t)(s2 - 2 * T) * D + lane * 16);
#pragma unroll
            for (int q = 0; q < 4; ++q) z[q] = (p[q] + p[q + (size_t)MOE_TAIL_ROWS * D / 4]) + (p[q + (size_t)2 * MOE_TAIL_ROWS * D / 4] + p[q + (size_t)3 * MOE_TAIL_ROWS * D / 4]); }
        float ss = 0.f;
#pragma unroll
        for (int q = 0; q < 4; ++q) { x[q] = x[q] + y[q] + z[q]; ss += (x[q][0] * x[q][0] + x[q][1] * x[q][1]) + (x[q][2] * x[q][2] + x[q][3] * x[q][3]); }
        ss = wave_sum(ss);
        if (final_) { const float r = __builtin_amdgcn_rsqf(ss * (1.f / D) + RMS_EPS); const f32x4* gp = (const f32x4*)(F.in[I_FINALG] + lane * 16); f32x4* op = (f32x4*)(F.out + (size_t)tok * D + lane * 16);
#pragma unroll
            for (int q = 0; q < 4; ++q) op[q] = x[q] * r * gp[q]; }
        else { *(u32x4*)(h + (size_t)tok * D + lane * 16) = pack8(x[0], x[1]); *(u32x4*)(h + (size_t)tok * D + lane * 16 + 8) = pack8(x[2], x[3]);
            if (F8_GATES) { u32x4 o8; o8.x = pk4_fp8(x[0][0], x[0][1], x[0][2], x[0][3]); o8.y = pk4_fp8(x[1][0], x[1][1], x[1][2], x[1][3]); o8.z = pk4_fp8(x[2][0], x[2][1], x[2][2], x[2][3]); o8.w = pk4_fp8(x[3][0], x[3][1], x[3][2], x[3][3]); *(u32x4*)(F.ws + WS_H8 + (size_t)tok * D + lane * 16) = o8; }
            if (lane < 4) st[(size_t)tok * 4 + lane] = (lane == 0) ? ss : 0.f; }
    }
}

struct SchedKV {
    int G, c; const char* memn; const char* wkv;
    __device__ __forceinline__ bool next(int i, Unit& u) const { const int L = i * G + c; if (L >= 256) return false; const int layer = L >> 6, r = L & 63; const char* w = wkv + (size_t)layer * 2 * D * D * 2;
        if (r < 32) { u.pm = r >> 2; u.pn = r & 3; u.tag = layer * 2; u.A = memn + (size_t)u.pm * 256 * D * 2; u.B = w + (size_t)u.pn * 256 * D * 2; }
        else { const int q = r - 32; u.pm = q >> 3; u.pn = q & 7; u.tag = layer * 2 + 1; u.A = w + (size_t)(D + u.pm * 256) * D * 2; u.B = memn + (size_t)u.pn * 256 * D * 2; }
        return true; }
    __device__ __forceinline__ void a_ready(const Unit&) const {}
    __device__ __forceinline__ void done(const Unit&) const {}
};
struct SchedMoe {
    pg8::StaticOrder o; const char* A; const char* B; size_t sA, sB, sE; int pb1, pb2, pb3, pb4, pb5, pb6, pb7;
    __device__ __forceinline__ void load_bases(const unsigned* ctl) {
        pb1 = __builtin_amdgcn_readfirstlane((int)ctl[CW_PBASE + 1]); pb2 = __builtin_amdgcn_readfirstlane((int)ctl[CW_PBASE + 2]); pb3 = __builtin_amdgcn_readfirstlane((int)ctl[CW_PBASE + 3]); pb4 = __builtin_amdgcn_readfirstlane((int)ctl[CW_PBASE + 4]);
        pb5 = __builtin_amdgcn_readfirstlane((int)ctl[CW_PBASE + 5]); pb6 = __builtin_amdgcn_readfirstlane((int)ctl[CW_PBASE + 6]); pb7 = __builtin_amdgcn_readfirstlane((int)ctl[CW_PBASE + 7]); }
    __device__ __forceinline__ bool next(int i, Unit& u) const { int pm, pn; if (!o.next(i, pm, pn)) return false;
        const int e = (pm >= pb1) + (pm >= pb2) + (pm >= pb3) + (pm >= pb4) + (pm >= pb5) + (pm >= pb6) + (pm >= pb7);
        u.pm = pm; u.pn = pn; u.tag = 0; u.A = A + (size_t)pm * sA; u.B = B + (size_t)e * sE + (size_t)pn * sB; return true; }
    __device__ __forceinline__ void a_ready(const Unit&) const {}
    __device__ __forceinline__ void done(const Unit&) const {}
};

struct SchedMoeD {
    pg8::StaticOrder o; const char* A; const char* B; size_t sA, sB, sE; int pb1, pb2, pb3, pb4, pb5, pb6, pb7, ptot;
    __device__ __forceinline__ void load_bases(const unsigned* ctl) {
        pb1 = __builtin_amdgcn_readfirstlane((int)ctl[CW_PBASE + 1]); pb2 = __builtin_amdgcn_readfirstlane((int)ctl[CW_PBASE + 2]); pb3 = __builtin_amdgcn_readfirstlane((int)ctl[CW_PBASE + 3]); pb4 = __builtin_amdgcn_readfirstlane((int)ctl[CW_PBASE + 4]);
        pb5 = __builtin_amdgcn_readfirstlane((int)ctl[CW_PBASE + 5]); pb6 = __builtin_amdgcn_readfirstlane((int)ctl[CW_PBASE + 6]); pb7 = __builtin_amdgcn_readfirstlane((int)ctl[CW_PBASE + 7]); }
    __device__ __forceinline__ bool next(int i, Unit& u) const { int pm, pn, kq = -1;
        if (!o.next(i, pm, pn)) { const long q = (long)i * o.G + o.c - o.nwg; if (q >= (long)(ptot - MOE_FULL_PANELS) * 16) return false; pm = MOE_FULL_PANELS + (int)(q >> 4); pn = ((int)q >> 2) & 3; kq = (int)q & 3; }
        const int e = (pm >= pb1) + (pm >= pb2) + (pm >= pb3) + (pm >= pb4) + (pm >= pb5) + (pm >= pb6) + (pm >= pb7);
        const int koff = kq <= 0 ? 0 : (kq == 1 ? 8 : (kq == 2 ? 16 : 22));
        u.pm = pm; u.pn = pn; u.tag = kq + 1; u.A = A + (size_t)pm * sA + koff * 128; u.B = B + (size_t)e * sE + (size_t)pn * sB + koff * 128; return true; }
    __device__ __forceinline__ int nt_of(const Unit& u, int nt) const { return u.tag == 0 ? nt : (u.tag <= 2 ? 8 : 6); }
    __device__ __forceinline__ void a_ready(const Unit&) const {}
    __device__ __forceinline__ void done(const Unit&) const {}
};
template <> struct pg8::SchedVarK<SchedMoeD> { static constexpr bool v = true; };

__device__ __forceinline__ void xcd_barrier_bg(const XcdBarrier& b, const Frame& F) {
    volatile LAS unsigned* MISC = (volatile LAS unsigned*)(F.lds + LDS_MISC);
    const unsigned want = MISC[MI_SEQ] + 1u;
    asm volatile("s_waitcnt vmcnt(0)" ::: "memory");
    __syncthreads();
    const unsigned limit = MISC[MI_THR + 2];
    if (F.wave == 0) {
        if (F.tid == 0) {
            unsigned* bar = b.bar;
            __builtin_amdgcn_s_waitcnt(0);
            unsigned nloc = b.st[0], nx = b.st[1];
            if (nloc == 0u) { xcd_barrier_complete(bar, b.x, nloc, nx); b.st[0] = nloc; b.st[1] = nx; }
            const unsigned old = xb_add(&bar[XB_XSUB(b.x)], 1u);
            const unsigned gen = old / nloc;
            if (old + 1u == (gen + 1u) * nloc) {
                __builtin_amdgcn_fence(__ATOMIC_RELEASE, "agent");
                asm volatile("s_waitcnt vmcnt(0)" ::: "memory");
                const unsigned og = xb_add(&bar[XB_TOP], 1u);
                const unsigned tg = og / nx;
                if (og + 1u == (tg + 1u) * nx) xb_add(&bar[XB_TOPGEN], 1u);
                else XB_SPIN(xb_ld(&bar[XB_TOPGEN]) == tg, bar);
                __builtin_amdgcn_fence(__ATOMIC_ACQUIRE, "agent");
                xb_add(&bar[XB_XGEN(b.x)], 1u);
                asm volatile("s_waitcnt vmcnt(0)" ::: "memory");
            } else {
                XB_SPIN(xb_ld(&bar[XB_XGEN(b.x)]) == gen, bar);
                __builtin_amdgcn_fence(__ATOMIC_ACQUIRE, "agent");
                asm volatile("s_waitcnt vmcnt(0)" ::: "memory");
            }
            MISC[MI_SEQ] = want;
        }
    } else {
        while (MISC[MI_SEQ] != want) { if (!bg_try(F, limit)) break; }
    }
    __syncthreads();
}

constexpr int NPH_LAYER = 13, PH_LAYER0 = 2, NPHASES = PH_LAYER0 + DEPTH * NPH_LAYER;
extern __shared__ __attribute__((aligned(16))) unsigned char lds_raw[];
struct PA { unsigned char* ws; const float* const* in; float* out; int layer; int wave; };
__device__ __forceinline__ unsigned long long uni64(unsigned long long v) { const unsigned lo = __builtin_amdgcn_readfirstlane((unsigned)v), hi = __builtin_amdgcn_readfirstlane((unsigned)(v >> 32)); return ((unsigned long long)hi << 32) | lo; }
__device__ __forceinline__ Frame mkframe(const PA a) {
    Frame P; P.lds = (LAS unsigned char*)lds_raw; P.tid = a.wave * 64 + (int)__builtin_amdgcn_mbcnt_hi(~0u, __builtin_amdgcn_mbcnt_lo(~0u, 0u)); asm volatile("" : "+v"(P.tid));     P.lane = P.tid & 63; P.wave = __builtin_amdgcn_readfirstlane(P.tid >> 6); P.c = blockIdx.x; P.G = gridDim.x;
    { typedef __attribute__((address_space(4))) const char* kptr_t; kptr_t kp = (kptr_t)__builtin_amdgcn_kernarg_segment_ptr(); asm volatile("" : "+s"(kp));
      P.ws = *(unsigned char* const __attribute__((address_space(4)))*)(kp + __builtin_offsetof(Args, ws)); (void)a.ws; }
    P.in = a.in; P.out = a.out; return P;
}
#define ST_A (wsp<float>(P, WS_STATS))
#define ST_B (wsp<float>(P, WS_STATS) + (size_t)T * 16)
#define ST_C (wsp<float>(P, WS_STATS) + (size_t)T * 32)
#define H_ (wsp<bf16_t>(P, WS_H))
#define PH_HEAD const Frame P = mkframe(a); const int layer = a.layer, c = P.c, G = P.G, jj = layer >> 1; LAS unsigned char* lds = P.lds; (void)layer; (void)c; (void)G; (void)jj; (void)lds;

__device__ __forceinline__ void ph_prologue(const PA a) { PH_HEAD prologue(P); }
__device__ __forceinline__ void ph_kv(const PA a) { PH_HEAD
    SchedKV S{G, c, (const char*)wsp<bf16_t>(P, WS_MEMN), (const char*)wsp<bf16_t>(P, WS_WKV)};
    EpiPlain E{wsp<bf16_t>(P, WS_KMAT), wsp<bf16_t>(P, WS_VT), D, NMEM, (size_t)NMEM * D, (size_t)D * NMEM};
    pg8::gemm_phase<EpiPlain, SchedKV, false, true>(lds, D, D, D, S, E, (const char*)P.ws, P.tid);
}
__device__ __forceinline__ void ph_inproj(const PA a) { PH_HEAD
    pg8::SchedStd S; S.o.init(T / 256, (F8_GATES ? (F8_IN_S ? 1024 : 1536) : INC) / 256, G, c); S.A = (const char*)H_; S.B = (const char*)(wsp<bf16_t>(P, WS_WIN) + (size_t)layer * INC * D); S.sA = (size_t)256 * D * 2; S.sB = (size_t)256 * D * 2;
    EpiInproj E{ST_A, wsp<bf16_t>(P, WS_UCONV), wsp<bf16_t>(P, WS_XU), wsp<bf16_t>(P, WS_GATES)};
    pg8::gemm_phase<EpiInproj, pg8::SchedStd, true, true>(lds, D, D, D, S, E, (const char*)P.ws, P.tid);
}
__device__ __forceinline__ void ph_inproj_gates(const PA a) { PH_HEAD
    pg8::SchedStd S; S.o.init(T / 256, (F8_IN_S ? 2560 : 2048) / 256, G, c); S.A = (const char*)wsp<unsigned char>(P, WS_H8); S.B = (const char*)(wsp<bf16_t>(P, WS_WIN) + (size_t)layer * INC * D + (size_t)1536 * D); S.sA = (size_t)256 * D; S.sB = (size_t)256 * D;
    EpiGates E{ST_A, wsp<bf16_t>(P, WS_GATES), 1.0f / F8_WGU_SCALE, wsp<bf16_t>(P, WS_XU)};
    pg8::gemm_phase<EpiGates, pg8::SchedStd, true, true, true>(lds, D, D, D, S, E, (const char*)P.ws, P.tid);
}
__device__ __forceinline__ void ph_conv(const PA a) { PH_HEAD conv_phase(P, layer); }
__device__ __forceinline__ void ph_ssm1(const PA a) { PH_HEAD
    if (c < BATCH * NG) {
        const int unit = c, g = (unit & 7) * 4 + ((unit >> 3) & 3), b = unit >> 5, ug = b * NG + g;
        bf16_t* xu = wsp<bf16_t>(P, WS_XU) + (size_t)ug * 256 * 384;
        pg8::SchedOne S; S.u0.pm = 0; S.u0.pn = 0; S.u0.tag = 0; S.u0.A = (const char*)xu; S.u0.B = (const char*)(wsp<bf16_t>(P, WS_WST) + (size_t)(layer * NG + g) * 256 * 256);
        EpiSsm1 E{wsp<float>(P, WS_A16) + (size_t)(layer * NG + g) * 128, xu};
        pg8::gemm_phase<EpiSsm1, pg8::SchedOne, false, true>(lds, 256, 384, 256, S, E, (const char*)P.ws, P.tid);
        VM_WAIT(); __syncthreads(); __builtin_amdgcn_fence(__ATOMIC_ACQUIRE, "agent"); VM_WAIT(); __syncthreads();
    }
}
__device__ __forceinline__ void ph_ssm2(const PA a) { PH_HEAD
    if (c < BATCH * NG) {
        const int unit = c, g = (unit & 7) * 4 + ((unit >> 3) & 3), b = unit >> 5, ug = b * NG + g;
        bf16_t* xu = wsp<bf16_t>(P, WS_XU) + (size_t)ug * 256 * 384;
        pg8::SchedOne S; S.u0.pm = 0; S.u0.pn = 0; S.u0.tag = 0; S.u0.A = (const char*)xu; S.u0.B = (const char*)(wsp<bf16_t>(P, WS_TW) + (size_t)(layer * NG + g) * 256 * 384);
        EpiSsm2 E{wsp<bf16_t>(P, WS_YS), b, g};
        pg8::gemm_phase<EpiSsm2, pg8::SchedOne, false, true>(lds, 384, 384, 384, S, E, (const char*)P.ws, P.tid);
        __syncthreads();
    }
}
__device__ __forceinline__ void ph_zpw(const PA a) { PH_HEAD
    SchedZPW S; S.o.init(T / 256, D / 256, G, c); S.ys = (const char*)wsp<bf16_t>(P, WS_YS); S.uc = (const char*)wsp<bf16_t>(P, WS_UC);
    S.wglu = (const char*)(wsp<bf16_t>(P, WS_WGLU) + (size_t)layer * 2 * D * SW); S.wpw = (const char*)(wsp<bf16_t>(P, WS_WPW) + (size_t)layer * D * CW);
    EpiZPW E{EpiZ{wsp<bf16_t>(P, WS_GATES), wsp<bf16_t>(P, WS_MB)}, EpiPw{wsp<bf16_t>(P, WS_GATES), wsp<bf16_t>(P, WS_MB), wsp<bf16_t>(P, WS_MERGED)}};
    pg8::gemm_phase<EpiZPW, SchedZPW, true, true>(lds, SW, SW, SW, S, E, (const char*)P.ws, P.tid);
}
template <bool H8OUT> __device__ __forceinline__ void ph_res_out(const PA a) { PH_HEAD
    pg8::SchedStd S; S.o.init(T / 256, D / 256, G, c); S.A = (const char*)wsp<bf16_t>(P, WS_MERGED); S.B = (const char*)(wsp<bf16_t>(P, WS_WOUT) + (size_t)layer * D * D); S.sA = (size_t)256 * D * 2; S.sB = (size_t)256 * D * 2;
    EpiRes<H8OUT, false> E{H_, ST_B, H_, wsp<unsigned char>(P, WS_H8), lds};
    pg8::gemm_phase<EpiRes<H8OUT, false>, pg8::SchedStd, true, true>(lds, D, D, D, S, E, (const char*)P.ws, P.tid);
}
template <bool H8OUT> __device__ __forceinline__ void ph_res_o(const PA a) { PH_HEAD
    constexpr bool F8 = F8_QO != 0; constexpr int ES = F8 ? 1 : 2;
    pg8::SchedStd S; S.o.init(T / 256, D / 256, G, c); S.A = (const char*)wsp<bf16_t>(P, WS_AO); S.B = (const char*)(wsp<bf16_t>(P, WS_WO) + (size_t)layer * D * D); S.sA = (size_t)256 * D * ES; S.sB = (size_t)256 * D * ES;
    EpiRes<H8OUT, F8> E{H_, ST_C, H_, wsp<unsigned char>(P, WS_H8), lds};
    pg8::gemm_phase<EpiRes<H8OUT, F8>, pg8::SchedStd, true, true, F8>(lds, D, D, D, S, E, (const char*)P.ws, P.tid);
}
struct SchedQ {
    int G, c; const char* h; const char* wq; int es;
    __device__ __forceinline__ bool next(int i, Unit& u) const { const int L = i * G + c; if (L >= BATCH * HEADS * (SEQ / 256)) return false; const int bh = L & 31, qt = L >> 5, b = bh >> 2, hd = bh & 3;
        u.pm = b * 16 + qt; u.pn = hd; u.tag = 0; u.A = h + (size_t)u.pm * 256 * D * es; u.B = wq + (size_t)hd * 256 * D * es; return true; }
    __device__ __forceinline__ void a_ready(const Unit&) const {}
    __device__ __forceinline__ void done(const Unit&) const {}
};
__device__ __forceinline__ void ph_q(const PA a) { PH_HEAD
    constexpr bool F8 = F8_QO != 0;
    SchedQ S{G, c, F8 ? (const char*)wsp<unsigned char>(P, WS_H8) : (const char*)H_, (const char*)(wsp<bf16_t>(P, WS_WQ) + (size_t)layer * D * D), F8 ? 1 : 2};
    EpiQ E{ST_B, wsp<bf16_t>(P, WS_Q), F8 ? 1.0f / F8_WQ_SCALE : 1.0f};
    pg8::gemm_phase<EpiQ, SchedQ, true, true, F8>(lds, D, D, D, S, E, (const char*)P.ws, P.tid);
    VM_WAIT(); __syncthreads();
}
__device__ __forceinline__ void ph_attn(const PA a) { PH_HEAD attn_phase(P, layer); }
template <bool F8> __device__ __forceinline__ void ph_fgu(const PA a) { PH_HEAD
    constexpr int ES = F8 ? 1 : 2;
    pg8::SchedStd S; S.o.init(T / 256, 2 * DFF / 256, G, c); S.A = F8 ? (const char*)wsp<unsigned char>(P, WS_H8) : (const char*)H_; S.B = (const char*)(wsp<bf16_t>(P, WS_WFGU) + (size_t)jj * 2 * DFF * D); S.sA = (size_t)256 * D * ES; S.sB = (size_t)256 * D * ES;
    EpiGU<false, F8> E{ST_C, nullptr, wsp<bf16_t>(P, WS_ACT), DFF};
    pg8::gemm_phase<EpiGU<false, F8>, pg8::SchedStd, true, true, F8>(lds, D, D, D, S, E, (const char*)P.ws, P.tid);
}
template <bool F8> __device__ __forceinline__ void ph_fdown(const PA a, const bool dry = false) { PH_HEAD
    constexpr int ES = F8 ? 1 : 2;
    pg8::SchedStd S; S.o.init(T / 256, D / 256, G, c); S.A = (const char*)wsp<bf16_t>(P, WS_ACT); S.B = (const char*)(wsp<bf16_t>(P, WS_WFD) + (size_t)jj * D * DFF); S.sA = (size_t)256 * DFF * ES; S.sB = (size_t)256 * DFF * ES;
    EpiRes<(F8_GATES != 0), F8> E{H_, dry ? wsp<float>(P, WS_UCONV) : ST_A, dry ? wsp<bf16_t>(P, WS_Q) : H_, wsp<unsigned char>(P, WS_H8), lds};
    pg8::gemm_phase<EpiRes<(F8_GATES != 0), F8>, pg8::SchedStd, true, true, F8>(lds, DFF, DFF, DFF, S, E, (const char*)P.ws, P.tid);
}
__device__ __forceinline__ void ph_router(const PA a) { PH_HEAD router_phase(P, layer, jj); }
template <bool F8> __device__ __forceinline__ void ph_assign(const PA a) { PH_HEAD assign_phase<F8>(P); }
template <bool F8> __device__ __forceinline__ void ph_mgu(const PA a) { PH_HEAD
    constexpr int ES = F8 ? 1 : 2;
    const int ptot = (int)__hip_atomic_load((unsigned*)(P.ws + WS_CTL) + CW_PTOTAL, __ATOMIC_RELAXED, __HIP_MEMORY_SCOPE_AGENT);
    SchedMoe S; S.o.init(__builtin_amdgcn_readfirstlane(ptot), 2 * DFE / 256, G, c); S.A = (const char*)wsp<bf16_t>(P, WS_HS); S.B = (const char*)(wsp<bf16_t>(P, WS_WMGU) + (size_t)jj * NE * 2 * DFE * D);
    S.sA = (size_t)256 * D * ES; S.sB = (size_t)256 * D * ES; S.sE = (size_t)2 * DFE * D * ES; S.load_bases((const unsigned*)(P.ws + WS_CTL));
    EpiGU<true, F8> E{(const float*)(P.ws + WS_META + MT_RSCALE), (const float*)(P.ws + WS_META + MT_GWT), wsp<bf16_t>(P, WS_ACT), DFE};
    pg8::gemm_phase<EpiGU<true, F8>, SchedMoe, true, true, F8>(lds, D, D, D, S, E, (const char*)P.ws, P.tid);
}
template <bool F8> __device__ __forceinline__ void ph_mdown(const PA a) { PH_HEAD
    constexpr int ES = F8 ? 1 : 2;
    const int ptot = (int)__hip_atomic_load((unsigned*)(P.ws + WS_CTL) + CW_PTOTAL, __ATOMIC_RELAXED, __HIP_MEMORY_SCOPE_AGENT);
    static_assert(!F8 || DFE * ES / 128 == 28, "the K-split of the tail panels is laid out for 28 K-tiles (the bf16 instantiation is never run: F8_MOE_MASK covers both MoE layers)");
    SchedMoeD S; S.o.init(MOE_FULL_PANELS, D / 256, G, c); S.ptot = __builtin_amdgcn_readfirstlane(ptot); S.A = (const char*)wsp<bf16_t>(P, WS_ACT); S.B = (const char*)(wsp<bf16_t>(P, WS_WMD) + (size_t)jj * NE * D * DFE);
    S.sA = (size_t)256 * DFE * ES; S.sB = (size_t)256 * DFE * ES; S.sE = (size_t)D * DFE * ES; S.load_bases((const unsigned*)(P.ws + WS_CTL));
    EpiDown E{wsp<bf16_t>(P, WS_YE), wsp<float>(P, WS_MPART), F8 ? 1.0f / (F8_WD_SCALE * F8_ACT_SCALE) : 1.0f};
    pg8::gemm_phase<EpiDown, SchedMoeD, true, true, F8>(lds, DFE, DFE, DFE, S, E, (const char*)P.ws, P.tid);
}
__device__ __forceinline__ void ph_combine(const PA a) { PH_HEAD combine_phase(P, layer == DEPTH - 1); }

__global__ void __launch_bounds__(512, 2) fwd(Args args) {
    LAS unsigned char* lds = (LAS unsigned char*)lds_raw;
    volatile LAS unsigned* MISC = (volatile LAS unsigned*)(lds + LDS_MISC);
    if (threadIdx.x < 64) MISC[threadIdx.x] = 0u;
    __syncthreads();
    const int lo = args.ph_lo, hi = args.ph_hi;
    unsigned* barw = (unsigned*)(args.ws + WS_CTL) + CW_BAR;
    XcdBarrier bar; bar.bar = barw; bar.x = 0; bar.st = MISC + 8;
    if (hi - lo > 1) bar = xcd_barrier_post(barw, MISC + 8);
#ifndef PROBE_DUP
#define PROBE_DUP 0
#endif
#define DUPB(b) ((PROBE_DUP >> (b)) & 1)
#define IN(k) (lo <= (k) && (k) < hi)
#define SEAM(k) do { if (IN(k) && IN((k) + 1)) { if ((k) < PH_LAYER0 + 3 * NPH_LAYER - 1) { const Frame BF_ = mkframe(a); xcd_barrier_bg(bar, BF_); } else { const Frame BF_ = mkframe(a); xcd_barrier(bar, BF_.tid); } } } while (0)
#define SEAMX(k, kn) do { if (IN(k) && IN(kn)) { if ((k) < PH_LAYER0 + 3 * NPH_LAYER - 1) { const Frame BF_ = mkframe(a); xcd_barrier_bg(bar, BF_); } else { const Frame BF_ = mkframe(a); xcd_barrier(bar, BF_.tid); } } } while (0)
    PA a; a.ws = args.ws; a.in = args.in; a.out = args.out; a.layer = 0; a.wave = __builtin_amdgcn_readfirstlane((int)(threadIdx.x >> 6));
    if (IN(0)) { ph_prologue(a); if (DUPB(0)) ph_prologue(a); } SEAMX(0, 2);
#define LAYER_BODY(LYR) { \
        constexpr int layer = (LYR), pb = PH_LAYER0 + layer * NPH_LAYER; a.layer = layer; \
        if (IN(pb + 0)) { if (layer == 0) ph_kv(a); ph_inproj(a); if (F8_GATES) ph_inproj_gates(a); } SEAM(pb + 0); \
        if (IN(pb + 1)) { ph_conv(a); ph_ssm1(a); ph_ssm2(a); if (DUPB(3)) { ph_conv(a); ph_ssm1(a); ph_ssm2(a); } if (DUPB(11)) ph_conv(a); if (DUPB(12)) { ph_ssm1(a); ph_ssm2(a); } if (DUPB(13)) ph_ssm1(a); } SEAM(pb + 1); \
        if (IN(pb + 2)) { ph_zpw(a); if (DUPB(4)) ph_zpw(a); } SEAMX(pb + 2, pb + 4); \
        if (IN(pb + 4)) { ph_res_out<(F8_QO != 0)>(a); } SEAM(pb + 4); \
        if (IN(pb + 5)) { ph_q(a); ph_attn(a); if (DUPB(5)) { ph_q(a); ph_attn(a); } } SEAMX(pb + 5, pb + 7); \
        if (IN(pb + 7)) { ph_res_o<F8_DENSE(layer)>(a); } SEAM(pb + 7); \
        if ((layer & 1) == 0) { \
            if (IN(pb + 8)) { ph_fgu<F8_DENSE(layer)>(a); } SEAM(pb + 8); \
            if (IN(pb + 9)) { ph_fdown<F8_DENSE(layer)>(a); if (layer < DEPTH - 1) { const Frame DF_ = mkframe(a); bg_drain(DF_, layer); } } do { if (IN(pb + 9) && IN(pb + 13)) { if ((pb + 12) < PH_LAYER0 + 3 * NPH_LAYER - 1) { const Frame BF_ = mkframe(a); xcd_barrier_bg(bar, BF_); } else { const Frame BF_ = mkframe(a); xcd_barrier(bar, BF_.tid); } } } while (0); \
        } else { \
            if (IN(pb + 8)) { ph_router(a); if (DUPB(8)) ph_router(a); } SEAM(pb + 8); \
            if (IN(pb + 9)) { ph_assign<F8_MOE(layer)>(a); } SEAM(pb + 9); \
            if (IN(pb + 10)) { ph_mgu<F8_MOE(layer)>(a); } SEAM(pb + 10); \
            if (IN(pb + 11)) { ph_mdown<F8_MOE(layer)>(a); } SEAM(pb + 11); \
            if (IN(pb + 12)) { ph_combine(a); if (layer < DEPTH - 1) { const Frame DF_ = mkframe(a); bg_drain(DF_, layer); } } SEAM(pb + 12); \
        } }
    LAYER_BODY(0) LAYER_BODY(1) LAYER_BODY(2) LAYER_BODY(3)
#undef LAYER_BODY
#undef IN
#undef SEAM
#undef SEAMX
}

extern "C" void kernel_launch(void* const* d_in, const int* in_sizes, int n_in, void* d_out, int out_size, void* d_ws, size_t ws_size, hipStream_t stream) {
    static int grid = 0;
    if (grid == 0) {
        if (n_in != 32 || out_size != T * D || ws_size < WS_END) { fprintf(stderr, "kernel_launch: unexpected problem (n_in %d out %d ws %zu need %zu)\n", n_in, out_size, ws_size, (size_t)WS_END); grid = -1; return; }
        int dev = 0, cus = 0, per_cu = 0;
        if (hipGetDevice(&dev) != hipSuccess || hipDeviceGetAttribute(&cus, hipDeviceAttributeMultiprocessorCount, dev) != hipSuccess) { grid = -1; return; }
        if (hipFuncSetAttribute((const void*)fwd, hipFuncAttributeMaxDynamicSharedMemorySize, LDS_BYTES) != hipSuccess) { fprintf(stderr, "kernel_launch: hipFuncSetAttribute failed\n"); grid = -1; return; }
        if (hipOccupancyMaxActiveBlocksPerMultiprocessor(&per_cu, (const void*)fwd, 512, LDS_BYTES) != hipSuccess || per_cu < 1) { fprintf(stderr, "kernel_launch: occupancy query says %d\n", per_cu); }
        (void)hipGetLastError();
        grid = cus < 256 ? cus : 256;
    }
    if (grid < 0) return;
    if (hipMemsetAsync((char*)d_ws + WS_CTL, 0, CTL_BYTES, stream) != hipSuccess) return;
    Args a{};
    for (int i = 0; i < 32; ++i) a.in[i] = (const float*)d_in[i];
    a.out = (float*)d_out; a.ws = (unsigned char*)d_ws;
#if MK_ONE_LAUNCH
    a.ph_lo = 0; a.ph_hi = NPHASES;
    hipLaunchKernelGGL(fwd, dim3(grid), dim3(512), LDS_BYTES, stream, a);
#else
    for (int p = 0; p < NPHASES; ++p) {
        if (p >= PH_LAYER0) { const int layer = (p - PH_LAYER0) / NPH_LAYER, k = (p - PH_LAYER0) % NPH_LAYER; if ((layer & 1) == 0 && k >= 10) continue; }
        a.ph_lo = p; a.ph_hi = p + 1;
        hipLaunchKernelGGL(fwd, dim3(grid), dim3(512), LDS_BYTES, stream, a);
    }
#endif
}
```

```cpp
#include <hip/hip_runtime.h>
#include <cstdio>
#include <cstdint>

#ifndef MK_ONE_LAUNCH
#define MK_ONE_LAUNCH 1
#endif

#define GAS __attribute__((address_space(1)))
#define LAS __attribute__((address_space(3)))
typedef unsigned short bf16_t;
typedef short bf16x8 __attribute__((ext_vector_type(8)));
typedef float f32x4 __attribute__((ext_vector_type(4)));
typedef float f32x2 __attribute__((ext_vector_type(2)));
typedef float f32x16 __attribute__((ext_vector_type(16)));
typedef unsigned u32x4 __attribute__((ext_vector_type(4)));
typedef unsigned u32x2 __attribute__((ext_vector_type(2)));
typedef __bf16 bf2_t __attribute__((ext_vector_type(2)));

constexpr int D = 1024, BATCH = 8, SEQ = 4096, T = BATCH * SEQ, DEPTH = 4, MEM = 256, NMEM = BATCH * MEM;
constexpr int CW = 512, CK = 31, SW = 512, SG = 16, NG = 32, SP = 64, HEADS = 4, HD = 256;
constexpr int DFF = 2816, NE = 8, DFE = 3584, INC = 3584;
constexpr int NSLOT = 2 * T + NE * 256;
constexpr float RMS_EPS = 1e-6f, LN_EPS = 1e-5f;

constexpr size_t MiB = 1u << 20;
constexpr size_t WS_CTL = 0, CTL_BYTES = 1 * MiB;
constexpr size_t WS_A16 = 1 * MiB;
constexpr size_t WS_META = 2 * MiB;
constexpr size_t WS_STATS = 4 * MiB;
constexpr size_t WS_MEMN = 10 * MiB, WS_KMAT = 14 * MiB, WS_VT = 30 * MiB, WS_H = 46 * MiB;
constexpr size_t WS_WIN = 110 * MiB, WS_WPW = 138 * MiB, WS_WGLU = 142 * MiB, WS_WOUT = 150 * MiB, WS_WQ = 158 * MiB, WS_WKV = 166 * MiB, WS_WO = 182 * MiB;
constexpr size_t WS_WFGU = 190 * MiB, WS_WFD = 212 * MiB, WS_WMGU = 224 * MiB, WS_WMD = 448 * MiB, WS_WST = 560 * MiB, WS_TW = 576 * MiB;
constexpr size_t WS_R = 600 * MiB;
constexpr size_t WS_UCONV = WS_R, WS_XU = WS_R + 32 * MiB, WS_GATES = WS_R + 80 * MiB, WS_UC = WS_R + 208 * MiB, WS_YS = WS_R + 240 * MiB;
constexpr size_t WS_MB = WS_R + 272 * MiB, WS_MERGED = WS_R + 336 * MiB, WS_Q = WS_R + 400 * MiB, WS_AO = WS_R + 464 * MiB;
constexpr size_t WS_H8 = WS_R + 300 * MiB;
constexpr size_t WS_ACT = WS_R, WS_HS = WS_R + 462 * MiB, WS_YE = WS_R + 594 * MiB, WS_END = WS_R + 726 * MiB;
constexpr size_t WS_MPART = WS_R + 530 * MiB;
static_assert((size_t)NSLOT * DFE * 2 <= 462 * MiB && (size_t)NSLOT * D * 2 <= 132 * MiB, "moe buffers");
constexpr size_t MT_TOKE = 0, MT_TOKW = 128 * 1024, MT_TOKR = 384 * 1024, MT_TOKSLOT = 512 * 1024, MT_RSCALE = 768 * 1024, MT_GWT = 1088 * 1024, MT_WGCNT = 1408 * 1024, MT_PEXP = 1424 * 1024;
constexpr int CW_PTOTAL = 16, CW_PBASE = 32;
constexpr int CW_BAR = 4096;

constexpr int LDS_AUX = 131072;
constexpr int LDS_MISC = 131072 + 8192;
constexpr int LDS_BYTES = 147456;

#ifndef F8_MOE_MASK
#define F8_MOE_MASK 0xA
#endif
#define F8_MOE(l) (((F8_MOE_MASK >> (l)) & 1) != 0)
#ifndef F8_QO
#define F8_QO 1
#endif
#ifndef F8_OUT
#define F8_OUT 1
#endif
#ifndef F8_IN_S
#define F8_IN_S 1
#endif
#ifndef F8_GATES
#define F8_GATES 1
#endif
#ifndef F8_DENSE_MASK
#define F8_DENSE_MASK 0x4
#endif
#define F8_DENSE(l) (((F8_DENSE_MASK >> (l)) & 1) != 0)
__device__ __forceinline__ unsigned pk2(float lo, float hi) { f32x2 v = {lo, hi}; bf2_t r = __builtin_convertvector(v, bf2_t); return __builtin_bit_cast(unsigned, r); }
__device__ __forceinline__ float bflo(unsigned u) { return __uint_as_float(u << 16); }
__device__ __forceinline__ float bfhi(unsigned u) { return __uint_as_float(u & 0xffff0000u); }
__device__ __forceinline__ float fast_rcp(float x) { return __builtin_amdgcn_rcpf(x); }
__device__ __forceinline__ float fast_exp2(float x) { return __builtin_amdgcn_exp2f(x); }
__device__ __forceinline__ float sigmoidf_(float x) { return fast_rcp(1.0f + fast_exp2(-1.44269504f * x)); }
__device__ __forceinline__ float siluf_(float x) { return x * sigmoidf_(x); }
__device__ __forceinline__ float gelu_tanh_(float x) { const float z = 0.7978845608f * (x + 0.044715f * x * x * x); return x * fast_rcp(1.0f + fast_exp2(-2.88539008f * z)); }
__device__ __forceinline__ float wave_sum(float v) {
#pragma unroll
    for (int o = 1; o < 64; o <<= 1) v += __shfl_xor(v, o);
    return v;
}
__device__ __forceinline__ float row_rstd(const float* stats, int row) {
    const f32x4 a = *(const f32x4*)(stats + (size_t)row * 4);
    return __builtin_amdgcn_rsqf(((a[0] + a[1]) + (a[2] + a[3])) * (1.0f / D) + RMS_EPS);
}
__device__ __forceinline__ unsigned pk4_fp8(float a, float b, float c, float d) { int w = 0; w = __builtin_amdgcn_cvt_pk_fp8_f32(a, b, w, false); w = __builtin_amdgcn_cvt_pk_fp8_f32(c, d, w, true); return (unsigned)w; }
constexpr float F8_WGU_SCALE = 32.f, F8_WD_SCALE = 64.f, F8_ACT_SCALE = 4.f, F8_WQ_SCALE = 512.f, F8_WO_SCALE = 32.f, F8_AO_SCALE = 8.f;
#define LDS_WAIT() asm volatile("s_waitcnt lgkmcnt(0)" ::: "memory")
#define VM_WAIT() asm volatile("s_waitcnt vmcnt(0)" ::: "memory")

namespace pg8 {
constexpr int BM = 256, BK = 64, HALF = 128, HTB = HALF * BK * 2, STAGE_BYTES = 8 * HTB, NXCD = 8, WGM = 4;
__host__ __device__ __forceinline__ int lds_byte(int r, int c) { const int st = (r >> 4) * 2 + (c >> 5), rr = r & 15, cc = c & 31, ob = rr * 64 + cc * 2; return st * 1024 + (ob ^ (((ob >> 9) & 1) << 5)); }
__host__ __device__ __forceinline__ void stage_rc(int b, int& R, int& C) { const int st = b / 1024, sb = b % 1024, swz = sb ^ (((sb >> 9) & 1) << 5); R = (st >> 1) * 16 + swz / 64; C = (st & 1) * 32 + (swz % 64) / 2; }
__host__ __device__ __forceinline__ int perm32(int rho) { const int n = rho >> 4, i = rho & 15; return 8 * (i >> 2) + 4 * n + (i & 3); }

struct Unit { int pm, pn, tag; const char* A; const char* B; };

struct StaticOrder {
    int nM, nN, nwg, G, c;
    __device__ __forceinline__ void init(int nM_, int nN_, int G_, int c_) { nM = nM_; nN = nN_; nwg = nM * nN; G = G_; c = c_; }
    __device__ __forceinline__ bool next(int i, int& pm, int& pn) const {
        const long L = (long)i * G + c; if (L >= nwg) return false;
        int wgid = (int)L; { const int q = nwg / NXCD, r = nwg % NXCD, xcd = wgid % NXCD, off = wgid / NXCD; wgid = (xcd < r ? xcd * (q + 1) : r * (q + 1) + (xcd - r) * q) + off; }
        const int nig = WGM * nN, gid = wgid / nig, fm = gid * WGM, gsz = (nM - fm) < WGM ? (nM - fm) : WGM;
        pm = fm + ((wgid % nig) % gsz); pn = (wgid % nig) / gsz; return true;
    }
};
struct SchedStd {
    StaticOrder o; const char* A; const char* B; size_t sA, sB;
    __device__ __forceinline__ bool next(int i, Unit& u) const { int pm, pn; if (!o.next(i, pm, pn)) return false; u.pm = pm; u.pn = pn; u.tag = 0; u.A = A + (size_t)pm * sA; u.B = B + (size_t)pn * sB; return true; }
    __device__ __forceinline__ void a_ready(const Unit&) const {}
    __device__ __forceinline__ void done(const Unit&) const {}
};
struct SchedOne {
    Unit u0;
    __device__ __forceinline__ bool next(int i, Unit& u) const { if (i) return false; u = u0; return true; }
    __device__ __forceinline__ void a_ready(const Unit&) const {}
    __device__ __forceinline__ void done(const Unit&) const {}
};

template <class S_> struct SchedVarK { static constexpr bool v = false; };
template <class Epi, class Sched, bool ALIGN_EPI, bool SP2, bool F8 = false>
__device__ __forceinline__ void gemm_phase(LAS unsigned char* lds, const int K, const int lda, const int ldb, const Sched& S, const Epi& E, const char* wsb, const int tid_in) {
    int tid_ = tid_in; asm volatile("" : "+v"(tid_));
    const int tid = tid_, wid = __builtin_amdgcn_readfirstlane(tid >> 6), lane = tid & 63, wr = wid >> 2, wc = wid & 3, fr = lane & 15, fq = lane >> 4;
    constexpr int ES = F8 ? 1 : 2;
    const int nt = K * ES / (BK * 2);
    unsigned voffA[2], voffB[2];
#pragma unroll
    for (int i = 0; i < 2; ++i) { int R, C; stage_rc(tid * 16 + i * 8192, R, C); const int Rb = Epi::PERM ? ((R & ~31) + perm32(R & 31)) : R;
        voffA[i] = (unsigned)(R * lda * ES + C * 2); voffB[i] = (unsigned)(Rb * ldb * ES + C * 2); }
    const unsigned kstep = (unsigned)(BK * 2);
    const unsigned hstepA = (unsigned)(HALF * lda * ES), hstepB = (unsigned)(HALF * ldb * ES);
    const __amdgpu_buffer_rsrc_t rs = __builtin_amdgcn_make_buffer_rsrc((void*)wsb, (short)0, 0x7fffffff, 0x00020000);
    const unsigned ldsw = (unsigned)wid * 1024u;
    const int aoff = lds_byte(wr * 64 + fr, fq * 8), boff = lds_byte(wc * 32 + fr, fq * 8);
#define PG8_SA(b, h) (((b) * 2 + (h)) * HTB)
#define PG8_SB(b, h) ((4 + (b) * 2 + (h)) * HTB)
#define PG8_STAGE(bufoff, goff, voff) do { _Pragma("unroll") for (int _i = 0; _i < 2; ++_i) \
        __builtin_amdgcn_raw_ptr_buffer_load_lds(rs, (LAS unsigned*)(lds + (bufoff) + ldsw + _i * 8192), 16, (voff)[_i], (int)(goff), 0, 0); } while (0)
#define PG8_LD16(off) (*(const LAS bf16x8*)(lds + (off)))
#define PG8_CAT(x, y) __builtin_shufflevector(__builtin_bit_cast(i32x4_, (x)), __builtin_bit_cast(i32x4_, (y)), 0, 1, 2, 3, 4, 5, 6, 7)
#define PG8_LDA(dst, b, h) do { _Pragma("unroll") for (int m = 0; m < 4; ++m) { if constexpr (F8) dst##8[m] = PG8_CAT(PG8_LD16(PG8_SA(b, h) + aoff + m * 2048), PG8_LD16(PG8_SA(b, h) + aoff + m * 2048 + 1024)); \
        else { _Pragma("unroll") for (int k = 0; k < 2; ++k) dst[m][k] = PG8_LD16(PG8_SA(b, h) + aoff + m * 2048 + k * 1024); } } } while (0)
#define PG8_LDB(dst, b, h) do { _Pragma("unroll") for (int n = 0; n < 2; ++n) { if constexpr (F8) dst##8[n] = PG8_CAT(PG8_LD16(PG8_SB(b, h) + boff + n * 2048), PG8_LD16(PG8_SB(b, h) + boff + n * 2048 + 1024)); \
        else { _Pragma("unroll") for (int k = 0; k < 2; ++k) dst[n][k] = PG8_LD16(PG8_SB(b, h) + boff + n * 2048 + k * 1024); } } } while (0)
#define PG8_MMA_ASM8(C0, C1, C2, C3, C4, C5, C6, C7, OUTC) \
            asm volatile("s_nop 1\n\t" \
                "v_mfma_f32_16x16x128_f8f6f4 %0, %8, %10, " C0 "\n\tv_mfma_f32_16x16x128_f8f6f4 %1, %9, %10, " C1 "\n\t" \
                "v_mfma_f32_16x16x128_f8f6f4 %2, %8, %11, " C2 "\n\tv_mfma_f32_16x16x128_f8f6f4 %3, %9, %11, " C3 "\n\t" \
                "v_mfma_f32_16x16x128_f8f6f4 %4, %8, %12, " C4 "\n\tv_mfma_f32_16x16x128_f8f6f4 %5, %9, %12, " C5 "\n\t" \
                "v_mfma_f32_16x16x128_f8f6f4 %6, %8, %13, " C6 "\n\tv_mfma_f32_16x16x128_f8f6f4 %7, %9, %13, " C7
#define PG8_MMA(ai, bj, Af, Bf, Z) do { __builtin_amdgcn_s_setprio(1); \
        if constexpr (F8) {   \
            if (Z) { PG8_MMA_ASM8("0", "0", "0", "0", "0", "0", "0", "0", 0) \
                : "=&v"(acc[ai][bj][0][0]), "=&v"(acc[ai][bj][0][1]), "=&v"(acc[ai][bj][1][0]), "=&v"(acc[ai][bj][1][1]), "=&v"(acc[ai][bj][2][0]), "=&v"(acc[ai][bj][2][1]), "=&v"(acc[ai][bj][3][0]), "=&v"(acc[ai][bj][3][1]) \
                : "v"(Bf##8[0]), "v"(Bf##8[1]), "v"(Af##8[0]), "v"(Af##8[1]), "v"(Af##8[2]), "v"(Af##8[3])); } \
            else { PG8_MMA_ASM8("%0", "%1", "%2", "%3", "%4", "%5", "%6", "%7", 1) \
                : "+v"(acc[ai][bj][0][0]), "+v"(acc[ai][bj][0][1]), "+v"(acc[ai][bj][1][0]), "+v"(acc[ai][bj][1][1]), "+v"(acc[ai][bj][2][0]), "+v"(acc[ai][bj][2][1]), "+v"(acc[ai][bj][3][0]), "+v"(acc[ai][bj][3][1]) \
                : "v"(Bf##8[0]), "v"(Bf##8[1]), "v"(Af##8[0]), "v"(Af##8[1]), "v"(Af##8[2]), "v"(Af##8[3])); } } \
        else {   \
            if (Z) { asm volatile("s_nop 1\n\t" \
                "v_mfma_f32_16x16x32_bf16 %0, %8, %12, 0\n\t" \
                "v_mfma_f32_16x16x32_bf16 %1, %9, %12, 0\n\t" \
                "v_mfma_f32_16x16x32_bf16 %2, %8, %13, 0\n\t" \
                "v_mfma_f32_16x16x32_bf16 %3, %9, %13, 0\n\t" \
                "v_mfma_f32_16x16x32_bf16 %4, %8, %14, 0\n\t" \
                "v_mfma_f32_16x16x32_bf16 %5, %9, %14, 0\n\t" \
                "v_mfma_f32_16x16x32_bf16 %6, %8, %15, 0\n\t" \
                "v_mfma_f32_16x16x32_bf16 %7, %9, %15, 0\n\t" \
                "v_mfma_f32_16x16x32_bf16 %0, %10, %16, %0\n\t" \
                "v_mfma_f32_16x16x32_bf16 %1, %11, %16, %1\n\t" \
                "v_mfma_f32_16x16x32_bf16 %2, %10, %17, %2\n\t" \
                "v_mfma_f32_16x16x32_bf16 %3, %11, %17, %3\n\t" \
                "v_mfma_f32_16x16x32_bf16 %4, %10, %18, %4\n\t" \
                "v_mfma_f32_16x16x32_bf16 %5, %11, %18, %5\n\t" \
                "v_mfma_f32_16x16x32_bf16 %6, %10, %19, %6\n\t" \
                "v_mfma_f32_16x16x32_bf16 %7, %11, %19, %7" \
                : "=&v"(acc[ai][bj][0][0]), "=&v"(acc[ai][bj][0][1]), "=&v"(acc[ai][bj][1][0]), "=&v"(acc[ai][bj][1][1]), "=&v"(acc[ai][bj][2][0]), "=&v"(acc[ai][bj][2][1]), "=&v"(acc[ai][bj][3][0]), "=&v"(acc[ai][bj][3][1]) \
                : "v"(Bf[0][0]), "v"(Bf[1][0]), "v"(Bf[0][1]), "v"(Bf[1][1]), "v"(Af[0][0]), "v"(Af[1][0]), "v"(Af[2][0]), "v"(Af[3][0]), "v"(Af[0][1]), "v"(Af[1][1]), "v"(Af[2][1]), "v"(Af[3][1])); } \
            else { asm volatile("s_nop 1\n\t" \
                "v_mfma_f32_16x16x32_bf16 %0, %8, %12, %0\n\t" \
                "v_mfma_f32_16x16x32_bf16 %1, %9, %12, %1\n\t" \
                "v_mfma_f32_16x16x32_bf16 %2, %8, %13, %2\n\t" \
                "v_mfma_f32_16x16x32_bf16 %3, %9, %13, %3\n\t" \
                "v_mfma_f32_16x16x32_bf16 %4, %8, %14, %4\n\t" \
                "v_mfma_f32_16x16x32_bf16 %5, %9, %14, %5\n\t" \
                "v_mfma_f32_16x16x32_bf16 %6, %8, %15, %6\n\t" \
                "v_mfma_f32_16x16x32_bf16 %7, %9, %15, %7\n\t" \
                "v_mfma_f32_16x16x32_bf16 %0, %10, %16, %0\n\t" \
                "v_mfma_f32_16x16x32_bf16 %1, %11, %16, %1\n\t" \
                "v_mfma_f32_16x16x32_bf16 %2, %10, %17, %2\n\t" \
                "v_mfma_f32_16x16x32_bf16 %3, %11, %17, %3\n\t" \
                "v_mfma_f32_16x16x32_bf16 %4, %10, %18, %4\n\t" \
                "v_mfma_f32_16x16x32_bf16 %5, %11, %18, %5\n\t" \
                "v_mfma_f32_16x16x32_bf16 %6, %10, %19, %6\n\t" \
                "v_mfma_f32_16x16x32_bf16 %7, %11, %19, %7" \
                : "+v"(acc[ai][bj][0][0]), "+v"(acc[ai][bj][0][1]), "+v"(acc[ai][bj][1][0]), "+v"(acc[ai][bj][1][1]), "+v"(acc[ai][bj][2][0]), "+v"(acc[ai][bj][2][1]), "+v"(acc[ai][bj][3][0]), "+v"(acc[ai][bj][3][1]) \
                : "v"(Bf[0][0]), "v"(Bf[1][0]), "v"(Bf[0][1]), "v"(Bf[1][1]), "v"(Af[0][0]), "v"(Af[1][0]), "v"(Af[2][0]), "v"(Af[3][0]), "v"(Af[0][1]), "v"(Af[1][1]), "v"(Af[2][1]), "v"(Af[3][1])); } } \
        __builtin_amdgcn_s_setprio(0); } while (0)
#define PG8_WAIT_V(n) asm volatile("s_waitcnt vmcnt(" #n ")" ::: "memory")
#define PG8_WAIT_L(n) asm volatile("s_waitcnt lgkmcnt(" #n ")" ::: "memory")
#define PG8_BAR __builtin_amdgcn_s_barrier()
#define PG8_SCHED __builtin_amdgcn_sched_barrier(0)
    Unit cur, nxt; int ui = 0;
    if (!S.next(0, cur)) return;
    f32x4 acc[2][2][4][2];
    typedef int i32x4_ __attribute__((ext_vector_type(4))); typedef int i32x8_ __attribute__((ext_vector_type(8)));
    bf16x8 At[4][2], B0[2][2], B1[2][2]; i32x8_ At8[4], B08[2], B18[2];
    unsigned cA = (unsigned)(cur.A - wsb), cB = (unsigned)(cur.B - wsb);
    int ntc = nt; if constexpr (SchedVarK<Sched>::v) ntc = S.nt_of(cur, nt);
    S.a_ready(cur);
    if constexpr (SP2) {
        PG8_STAGE(PG8_SB(0, 0), cB, voffB); PG8_STAGE(PG8_SB(0, 1), cB + hstepB, voffB); PG8_STAGE(PG8_SA(0, 0), cA, voffA); PG8_STAGE(PG8_SA(0, 1), cA + hstepA, voffA);
        if (wr == 1) PG8_BAR;
        PG8_WAIT_V(2); PG8_BAR;
        PG8_STAGE(PG8_SB(1, 0), cB + kstep, voffB); PG8_STAGE(PG8_SA(1, 0), cA + kstep, voffA); PG8_STAGE(PG8_SB(1, 1), cB + hstepB + kstep, voffB);
        PG8_WAIT_V(6); PG8_BAR;
    } else {
        PG8_STAGE(PG8_SB(0, 0), cB, voffB); PG8_STAGE(PG8_SA(0, 0), cA, voffA); PG8_STAGE(PG8_SB(0, 1), cB + hstepB, voffB); PG8_STAGE(PG8_SA(0, 1), cA + hstepA, voffA);
        if (wr == 1) PG8_BAR;
        PG8_WAIT_V(4); PG8_BAR;
        PG8_STAGE(PG8_SB(1, 0), cB + kstep, voffB); PG8_STAGE(PG8_SA(1, 0), cA + kstep, voffA); PG8_STAGE(PG8_SB(1, 1), cB + hstepB + kstep, voffB);
        PG8_WAIT_V(6); PG8_BAR;
    }
    for (;;) {
        const bool has_next = S.next(ui + 1, nxt);
        const unsigned nA = has_next ? (unsigned)(nxt.A - wsb) : cA, nB = has_next ? (unsigned)(nxt.B - wsb) : cB;
        for (int t = 0; t < ntc; t += 2) {
            const bool last = (t == ntc - 2), z0 = (t == 0);
            const unsigned a1 = cA + (unsigned)(t + 1) * kstep;
            const unsigned a2 = last ? nA : cA + (unsigned)(t + 2) * kstep, b2 = last ? nB : cB + (unsigned)(t + 2) * kstep;
            const unsigned a3 = a2 + kstep, b3 = b2 + kstep;
            if (last && has_next) S.a_ready(nxt);
            if constexpr (SP2) {
            PG8_LDB(B0, 0, 0); PG8_LDB(B1, 0, 1); PG8_SCHED; PG8_LDA(At, 0, 0); PG8_STAGE(PG8_SA(1, 1), a1 + hstepA, voffA);
            PG8_WAIT_V(8); PG8_WAIT_L(0); PG8_BAR; PG8_MMA(0, 0, At, B0, z0); PG8_MMA(0, 1, At, B1, z0); PG8_BAR; PG8_SCHED;
            PG8_LDA(At, 0, 1); PG8_STAGE(PG8_SB(0, 0), b2, voffB); PG8_STAGE(PG8_SB(0, 1), b2 + hstepB, voffB); PG8_STAGE(PG8_SA(0, 0), a2, voffA);
            PG8_WAIT_V(8); PG8_WAIT_L(0); PG8_BAR; PG8_MMA(1, 0, At, B0, z0); PG8_MMA(1, 1, At, B1, z0); PG8_BAR; PG8_SCHED;
            PG8_LDB(B0, 1, 0); PG8_LDB(B1, 1, 1); PG8_SCHED; PG8_LDA(At, 1, 0); PG8_STAGE(PG8_SA(0, 1), a2 + hstepA, voffA);
            PG8_WAIT_V(8); PG8_WAIT_L(0); PG8_BAR; PG8_MMA(0, 0, At, B0, false); PG8_MMA(0, 1, At, B1, false); PG8_BAR; PG8_SCHED;
            PG8_LDA(At, 1, 1); PG8_STAGE(PG8_SB(1, 0), b3, voffB); PG8_STAGE(PG8_SB(1, 1), b3 + hstepB, voffB); PG8_STAGE(PG8_SA(1, 0), a3, voffA);
            PG8_WAIT_V(8); PG8_WAIT_L(0); PG8_BAR; PG8_MMA(1, 0, At, B0, false); PG8_MMA(1, 1, At, B1, false); PG8_BAR; PG8_SCHED;
            } else {
            PG8_LDB(B0, 0, 0); PG8_SCHED; PG8_LDA(At, 0, 0); PG8_STAGE(PG8_SA(1, 1), a1 + hstepA, voffA);
            PG8_WAIT_L(8); PG8_BAR; PG8_WAIT_L(0); PG8_MMA(0, 0, At, B0, z0); PG8_BAR; PG8_SCHED;
            PG8_LDB(B1, 0, 1); PG8_STAGE(PG8_SB(0, 0), b2, voffB);
            PG8_BAR; PG8_WAIT_L(0); PG8_MMA(0, 1, At, B1, z0); PG8_BAR;
            PG8_LDA(At, 0, 1); PG8_STAGE(PG8_SA(0, 0), a2, voffA);
            PG8_BAR; PG8_WAIT_L(0); PG8_MMA(1, 0, At, B0, z0); PG8_BAR; PG8_SCHED;
            PG8_STAGE(PG8_SB(0, 1), b2 + hstepB, voffB);
            PG8_WAIT_V(6); PG8_BAR; PG8_MMA(1, 1, At, B1, z0); PG8_BAR;
            PG8_LDB(B0, 1, 0); PG8_SCHED; PG8_LDA(At, 1, 0); PG8_STAGE(PG8_SA(0, 1), a2 + hstepA, voffA);
            PG8_WAIT_L(8); PG8_BAR; PG8_WAIT_L(0); PG8_MMA(0, 0, At, B0, false); PG8_BAR; PG8_SCHED;
            PG8_LDB(B1, 1, 1); PG8_STAGE(PG8_SB(1, 0), b3, voffB);
            PG8_BAR; PG8_WAIT_L(0); PG8_MMA(0, 1, At, B1, false); PG8_BAR;
            PG8_LDA(At, 1, 1); PG8_STAGE(PG8_SA(1, 0), a3, voffA);
            PG8_BAR; PG8_WAIT_L(0); PG8_MMA(1, 0, At, B0, false); PG8_BAR; PG8_SCHED;
            PG8_STAGE(PG8_SB(1, 1), b3 + hstepB, voffB);
            PG8_WAIT_V(6); PG8_BAR; PG8_MMA(1, 1, At, B1, false); PG8_BAR;
            }
        }
        asm volatile("s_nop 15\n\ts_nop 7" ::: "memory");
        if constexpr (ALIGN_EPI) { if (wr == 0) PG8_BAR; }
        if constexpr (!Epi::AFTER_DRAIN) { int fr2 = fr, fq2 = fq; asm volatile("" : "+v"(fr2), "+v"(fq2));
            E(acc, cur, wr, wc, fr2, fq2); S.done(cur); }
        if (!has_next) break;
        cur = nxt; cA = nA; cB = nB; ++ui;
        if constexpr (SchedVarK<Sched>::v) ntc = S.nt_of(cur, nt);
        if constexpr (ALIGN_EPI) { if (wr == 1) PG8_BAR; }
    }
    PG8_WAIT_V(0);
    if constexpr (!ALIGN_EPI) { if (wr == 0) PG8_BAR; }
    PG8_BAR;
    if constexpr (Epi::AFTER_DRAIN) { int fr2 = fr, fq2 = fq, lane2 = lane; asm volatile("" : "+v"(fr2), "+v"(fq2), "+v"(lane2)); E.fused(acc, cur, wr, wc, fr2, fq2, lds, wid, lane2); S.done(cur); }
#undef PG8_SA
#undef PG8_SB
#undef PG8_STAGE
#undef PG8_LDA
#undef PG8_LD16
#undef PG8_CAT
#undef PG8_LDB
#undef PG8_MMA
#undef PG8_MMA_ASM8
#undef PG8_WAIT_V
#undef PG8_WAIT_L
#undef PG8_BAR
#undef PG8_SCHED
}
}
using pg8::Unit;
typedef const f32x4 (&AccRef)[2][2][4][2];

__device__ __forceinline__ u32x4 pack8(const f32x4 a, const f32x4 b) { u32x4 w; w.x = pk2(a[0], a[1]); w.y = pk2(a[2], a[3]); w.z = pk2(b[0], b[1]); w.w = pk2(b[2], b[3]); return w; }
__device__ __forceinline__ void unpack8(const u32x4 w, f32x4& a, f32x4& b) { a = (f32x4){bflo(w.x), bfhi(w.x), bflo(w.y), bfhi(w.y)}; b = (f32x4){bflo(w.z), bfhi(w.z), bflo(w.w), bfhi(w.w)}; }

struct EpiInproj {
    static constexpr bool PERM = true, AFTER_DRAIN = false;
    const float* stats; bf16_t* uconv; bf16_t* xu; bf16_t* gates;
    __device__ __forceinline__ void operator()(AccRef acc, const Unit& u, int wr, int wc, int fr, int fq) const {
        float rr[2][4];
#pragma unroll
        for (int ai = 0; ai < 2; ++ai)
#pragma unroll
            for (int m = 0; m < 4; ++m) rr[ai][m] = row_rstd(stats, u.pm * 256 + ai * 128 + wr * 64 + m * 16 + fr);
#pragma unroll
        for (int ai = 0; ai < 2; ++ai)
#pragma unroll
            for (int m = 0; m < 4; ++m) {
                const int row = u.pm * 256 + ai * 128 + wr * 64 + m * 16 + fr;
                const float r = rr[ai][m];
                if (u.pn < 4) {
                    f32x4 v[2];
#pragma unroll
                    for (int n = 0; n < 2; ++n)
#pragma unroll
                        for (int i = 0; i < 4; ++i) v[n][i] = (acc[ai][0][m][n][i] * r) * sigmoidf_(acc[ai][1][m][n][i] * r);
                    *(u32x4*)(uconv + (size_t)row * CW + u.pn * 128 + wc * 32 + fq * 8) = pack8(v[0], v[1]);
                } else if (u.pn < 6) {
                    const int b = row >> 12, t = row & 4095;
#pragma unroll
                    for (int bj = 0; bj < 2; ++bj) {
                        const int ch = (u.pn - 4) * 256 + bj * 128 + wc * 32 + fq * 8, g = ch >> 4, h0 = ch & 15;
                        const size_t off = ((size_t)((b * NG + g) * 256 + (t >> 4))) * 384 + (t & 15) * 16 + h0;
                        *(u32x4*)(xu + off) = pack8(acc[ai][bj][m][0] * r, acc[ai][bj][m][1] * r);
                    }
                } else {
#pragma unroll
                    for (int bj = 0; bj < 2; ++bj) {
                        f32x4 v[2];
#pragma unroll
                        for (int n = 0; n < 2; ++n)
#pragma unroll
                            for (int i = 0; i < 4; ++i) v[n][i] = sigmoidf_(acc[ai][bj][m][n][i] * r);
                        *(u32x4*)(gates + (size_t)row * 2048 + (u.pn - 6) * 256 + bj * 128 + wc * 32 + fq * 8) = pack8(v[0], v[1]);
                    }
                }
            }
    }
};
struct EpiGates {
    static constexpr bool PERM = true, AFTER_DRAIN = false;
    const float* stats; bf16_t* gates; float sc; bf16_t* xu;
    __device__ __forceinline__ void operator()(AccRef acc, const Unit& u, int wr, int wc, int fr, int fq) const {
        float rr[2][4];
#pragma unroll
        for (int ai = 0; ai < 2; ++ai)
#pragma unroll
            for (int m = 0; m < 4; ++m) rr[ai][m] = row_rstd(stats, u.pm * 256 + ai * 128 + wr * 64 + m * 16 + fr) * sc;
#pragma unroll
        for (int ai = 0; ai < 2; ++ai)
#pragma unroll
            for (int m = 0; m < 4; ++m) {
                const int row = u.pm * 256 + ai * 128 + wr * 64 + m * 16 + fr; const float r = rr[ai][m];
                if (F8_IN_S && u.pn >= 8) {
                    const int b = row >> 12, t = row & 4095;
#pragma unroll
                    for (int bj = 0; bj < 2; ++bj) {
                        const int ch = (u.pn - 8) * 256 + bj * 128 + wc * 32 + fq * 8, g = ch >> 4, h0 = ch & 15;
                        const size_t off = ((size_t)((b * NG + g) * 256 + (t >> 4))) * 384 + (t & 15) * 16 + h0;
                        *(u32x4*)(xu + off) = pack8(acc[ai][bj][m][0] * r, acc[ai][bj][m][1] * r);
                    }
                    continue;
                }
#pragma unroll
                for (int bj = 0; bj < 2; ++bj) {
                    f32x4 v[2];
#pragma unroll
                    for (int n = 0; n < 2; ++n)
#pragma unroll
                        for (int i = 0; i < 4; ++i) v[n][i] = sigmoidf_(acc[ai][bj][m][n][i] * r);
                    *(u32x4*)(gates + (size_t)row * 2048 + u.pn * 256 + bj * 128 + wc * 32 + fq * 8) = pack8(v[0], v[1]);
                }
            }
    }
};
struct EpiZ {
    static constexpr bool PERM = true, AFTER_DRAIN = false;
    const bf16_t* gates; bf16_t* mb;
    __device__ __forceinline__ void operator()(AccRef acc, const Unit& u, int wr, int wc, int fr, int fq) const {
        const int oc = u.pn * 128 + wc * 32 + fq * 8;
        u32x4 gv[2][4];
#pragma unroll
        for (int ai = 0; ai < 2; ++ai)
#pragma unroll
            for (int m = 0; m < 4; ++m) gv[ai][m] = *(const u32x4*)(gates + (size_t)(u.pm * 256 + ai * 128 + wr * 64 + m * 16 + fr) * 2048 + 1024 + oc);
#pragma unroll
        for (int ai = 0; ai < 2; ++ai)
#pragma unroll
            for (int m = 0; m < 4; ++m) {
                const int row = u.pm * 256 + ai * 128 + wr * 64 + m * 16 + fr;
                f32x4 g0, g1; unpack8(gv[ai][m], g0, g1);
                f32x4 v[2];
#pragma unroll
                for (int i = 0; i < 4; ++i) { v[0][i] = g0[i] * acc[ai][0][m][0][i] * sigmoidf_(acc[ai][1][m][0][i]); v[1][i] = g1[i] * acc[ai][0][m][1][i] * sigmoidf_(acc[ai][1][m][1][i]); }
                *(u32x4*)(mb + (size_t)row * D + oc) = pack8(v[0], v[1]);
            }
    }
};
struct EpiPw {
    static constexpr bool PERM = true, AFTER_DRAIN = false;
    const bf16_t* gates; const bf16_t* mb; bf16_t* merged;
    __device__ __forceinline__ void operator()(AccRef acc, const Unit& u, int wr, int wc, int fr, int fq) const {
#pragma unroll
        for (int ai = 0; ai < 2; ++ai) {
            u32x4 gv[4][2], mv[4][2];
#pragma unroll
            for (int m = 0; m < 4; ++m)
#pragma unroll
                for (int bj = 0; bj < 2; ++bj) { const int row = u.pm * 256 + ai * 128 + wr * 64 + m * 16 + fr, c = u.pn * 256 + bj * 128 + wc * 32 + fq * 8;
                    gv[m][bj] = *(const u32x4*)(gates + (size_t)row * 2048 + c); mv[m][bj] = *(const u32x4*)(mb + (size_t)row * D + c); }
#pragma unroll
            for (int m = 0; m < 4; ++m)
#pragma unroll
                for (int bj = 0; bj < 2; ++bj) { const int row = u.pm * 256 + ai * 128 + wr * 64 + m * 16 + fr, c = u.pn * 256 + bj * 128 + wc * 32 + fq * 8;
                    f32x4 g0, g1, m0, m1; unpack8(gv[m][bj], g0, g1); unpack8(mv[m][bj], m0, m1);
                    const f32x4 v0 = g0 * acc[ai][bj][m][0] + m0, v1 = g1 * acc[ai][bj][m][1] + m1;
                    if (F8_OUT) { u32x2 w8; w8.x = pk4_fp8(v0[0] * F8_AO_SCALE, v0[1] * F8_AO_SCALE, v0[2] * F8_AO_SCALE, v0[3] * F8_AO_SCALE); w8.y = pk4_fp8(v1[0] * F8_AO_SCALE, v1[1] * F8_AO_SCALE, v1[2] * F8_AO_SCALE, v1[3] * F8_AO_SCALE); *(u32x2*)((unsigned char*)merged + (size_t)row * D + c) = w8; }
                    else *(u32x4*)(merged + (size_t)row * D + c) = pack8(v0, v1); }
        }
    }
};
struct EpiZPW {
    static constexpr bool PERM = true, AFTER_DRAIN = false;
    EpiZ ez; EpiPw ep;
    __device__ __forceinline__ void operator()(AccRef acc, const Unit& u, int wr, int wc, int fr, int fq) const {
        if (u.tag == 0) ez(acc, u, wr, wc, fr, fq);
        else { asm volatile("s_waitcnt vmcnt(0)" ::: "memory"); ep(acc, u, wr, wc, fr, fq); }
    }
};
struct SchedZPW {
    pg8::StaticOrder o; const char* ys; const char* uc; const char* wglu; const char* wpw;
    __device__ __forceinline__ bool next(int i, Unit& u) const { const int gi = i / 3, sub = i - gi * 3; int pm, pn; if (!o.next(gi, pm, pn)) return false;
        u.pm = pm;
        if (sub < 2) { u.pn = 2 * pn + sub; u.tag = 0; u.A = ys + (size_t)pm * 256 * SW * 2; u.B = wglu + (size_t)u.pn * 256 * SW * 2; }
        else { u.pn = pn; u.tag = 1; u.A = uc + (size_t)pm * 256 * CW * 2; u.B = wpw + (size_t)pn * 256 * CW * 2; }
        return true; }
    __device__ __forceinline__ void a_ready(const Unit&) const {}
    __device__ __forceinline__ void done(const Unit&) const {}
};
template <bool H8OUT = false, bool SCALED = false> struct EpiRes {
    static constexpr bool PERM = true, AFTER_DRAIN = false;
    bf16_t* h; float* stats; bf16_t* hdst; unsigned char* h8; LAS unsigned char* lds;
    __device__ __forceinline__ void operator()(AccRef acc, const Unit& u, int wr, int wc, int fr, int fq) const {
        LAS float* X = (LAS float*)(lds + LDS_AUX);
#pragma unroll
        for (int ai = 0; ai < 2; ++ai) {
            u32x4 hv[4][2];
#pragma unroll
            for (int m = 0; m < 4; ++m)
#pragma unroll
                for (int bj = 0; bj < 2; ++bj) hv[m][bj] = *(const u32x4*)(h + (size_t)(u.pm * 256 + ai * 128 + wr * 64 + m * 16 + fr) * D + u.pn * 256 + bj * 128 + wc * 32 + fq * 8);
#pragma unroll
            for (int m = 0; m < 4; ++m) {
                const int row = u.pm * 256 + ai * 128 + wr * 64 + m * 16 + fr; float ss = 0.f;
#pragma unroll
                for (int bj = 0; bj < 2; ++bj) {
                    const size_t eo = (size_t)row * D + u.pn * 256 + bj * 128 + wc * 32 + fq * 8;
                    f32x4 h0, h1; unpack8(hv[m][bj], h0, h1);
                    constexpr float asc = SCALED ? 1.0f / (F8_WD_SCALE * F8_ACT_SCALE) : 1.0f;
                    h0 = h0 + acc[ai][bj][m][0] * asc; h1 = h1 + acc[ai][bj][m][1] * asc;
                    ss += (h0[0] * h0[0] + h0[1] * h0[1]) + (h0[2] * h0[2] + h0[3] * h0[3]) + (h1[0] * h1[0] + h1[1] * h1[1]) + (h1[2] * h1[2] + h1[3] * h1[3]);
                    *(u32x4*)(hdst + eo) = pack8(h0, h1);
                    if (H8OUT) { u32x2 w8; w8.x = pk4_fp8(h0[0], h0[1], h0[2], h0[3]); w8.y = pk4_fp8(h1[0], h1[1], h1[2], h1[3]); *(u32x2*)(h8 + eo) = w8; }
                }
                ss += __shfl_xor(ss, 16); ss += __shfl_xor(ss, 32);
                if (fq == 0) X[(ai * 128 + wr * 64 + m * 16 + fr) * 4 + wc] = ss;
            }
        }
        LDS_WAIT(); __builtin_amdgcn_s_barrier(); asm volatile("" ::: "memory");
        const int lane = fq * 16 + fr, wid = wr * 4 + wc;
        if (lane < 32) { const int rl = wid * 32 + lane; const f32x4 v = *(const LAS f32x4*)(X + rl * 4); stats[(size_t)(u.pm * 256 + rl) * 4 + u.pn] = (v[0] + v[1]) + (v[2] + v[3]); }
    }
};
struct EpiQ {
    static constexpr bool PERM = true, AFTER_DRAIN = false;
    const float* stats; bf16_t* q; float sc;
    __device__ __forceinline__ void operator()(AccRef acc, const Unit& u, int wr, int wc, int fr, int fq) const {
        float rr[2][4];
#pragma unroll
        for (int ai = 0; ai < 2; ++ai)
#pragma unroll
            for (int m = 0; m < 4; ++m) rr[ai][m] = row_rstd(stats, u.pm * 256 + ai * 128 + wr * 64 + m * 16 + fr) * sc;
#pragma unroll
        for (int ai = 0; ai < 2; ++ai)
#pragma unroll
            for (int m = 0; m < 4; ++m) {
                const int row = u.pm * 256 + ai * 128 + wr * 64 + m * 16 + fr; const float r = rr[ai][m];
#pragma unroll
                for (int bj = 0; bj < 2; ++bj)
                    *(u32x4*)(q + (size_t)row * D + u.pn * 256 + bj * 128 + wc * 32 + fq * 8) = pack8(acc[ai][bj][m][0] * r, acc[ai][bj][m][1] * r);
            }
    }
};
template <bool MOE, bool F8 = false> struct EpiGU {
    static constexpr bool PERM = true, AFTER_DRAIN = false;
    const float* stats;
    const float* gwt;
    bf16_t* act; int ldc;
    __device__ __forceinline__ void operator()(AccRef acc, const Unit& u, int wr, int wc, int fr, int fq) const {
        float rr[2][4], gg[2][4];
#pragma unroll
        for (int ai = 0; ai < 2; ++ai)
#pragma unroll
            for (int m = 0; m < 4; ++m) { const int row = u.pm * 256 + ai * 128 + wr * 64 + m * 16 + fr; gg[ai][m] = 1.f; if (MOE) { rr[ai][m] = stats[row]; gg[ai][m] = gwt[row]; } else rr[ai][m] = row_rstd(stats, row); }
#pragma unroll
        for (int ai = 0; ai < 2; ++ai)
#pragma unroll
            for (int m = 0; m < 4; ++m) {
                const int row = u.pm * 256 + ai * 128 + wr * 64 + m * 16 + fr;
                float r = rr[ai][m], gw = gg[ai][m];
                if (F8) { r *= 1.0f / F8_WGU_SCALE; gw *= F8_ACT_SCALE; }
                f32x4 v[2];
#pragma unroll
                for (int n = 0; n < 2; ++n)
#pragma unroll
                    for (int i = 0; i < 4; ++i) v[n][i] = siluf_(acc[ai][0][m][n][i] * r) * (acc[ai][1][m][n][i] * r) * gw;
                if (F8) { u32x2 w8; w8.x = pk4_fp8(v[0][0], v[0][1], v[0][2], v[0][3]); w8.y = pk4_fp8(v[1][0], v[1][1], v[1][2], v[1][3]); *(u32x2*)((unsigned char*)act + (size_t)row * ldc + u.pn * 128 + wc * 32 + fq * 8) = w8; }
                else *(u32x4*)(act + (size_t)row * ldc + u.pn * 128 + wc * 32 + fq * 8) = pack8(v[0], v[1]);
            }
    }
};
struct EpiPlain {
    static constexpr bool PERM = true, AFTER_DRAIN = false;
    bf16_t* o0; bf16_t* o1; int ld0, ld1; size_t ls0, ls1; float osc = 1.f;
    __device__ __forceinline__ void operator()(AccRef acc, const Unit& u, int wr, int wc, int fr, int fq) const {
        const int which = u.tag & 1, layer = u.tag >> 1; bf16_t* o = which ? o1 + (size_t)layer * ls1 : o0 + (size_t)layer * ls0; const int ld = which ? ld1 : ld0;
#pragma unroll
        for (int ai = 0; ai < 2; ++ai)
#pragma unroll
            for (int m = 0; m < 4; ++m) {
                const int row = u.pm * 256 + ai * 128 + wr * 64 + m * 16 + fr;
#pragma unroll
                for (int bj = 0; bj < 2; ++bj)
                    *(u32x4*)(o + (size_t)row * ld + u.pn * 256 + bj * 128 + wc * 32 + fq * 8) = pack8(acc[ai][bj][m][0] * osc, acc[ai][bj][m][1] * osc);
            }
    }
};
constexpr int MOE_FULL_PANELS = (2 * T) / 256, MOE_TAIL_ROWS = 2048;
struct EpiDown {
    static constexpr bool PERM = true, AFTER_DRAIN = false;
    bf16_t* ye; float* part; float osc;
    __device__ __forceinline__ void operator()(AccRef acc, const Unit& u, int wr, int wc, int fr, int fq) const {
        if (u.tag == 0) {
#pragma unroll
            for (int ai = 0; ai < 2; ++ai)
#pragma unroll
                for (int m = 0; m < 4; ++m) {
                    const int row = u.pm * 256 + ai * 128 + wr * 64 + m * 16 + fr;
#pragma unroll
                    for (int bj = 0; bj < 2; ++bj)
                        *(u32x4*)(ye + (size_t)row * D + u.pn * 256 + bj * 128 + wc * 32 + fq * 8) = pack8(acc[ai][bj][m][0] * osc, acc[ai][bj][m][1] * osc);
                }
        } else {
            float* o = part + (size_t)(u.tag - 1) * MOE_TAIL_ROWS * D;
#pragma unroll
            for (int ai = 0; ai < 2; ++ai)
#pragma unroll
                for (int m = 0; m < 4; ++m) {
                    const int row = (u.pm - MOE_FULL_PANELS) * 256 + ai * 128 + wr * 64 + m * 16 + fr;
#pragma unroll
                    for (int bj = 0; bj < 2; ++bj)
#pragma unroll
                        for (int n = 0; n < 2; ++n)
                            *(f32x4*)(o + (size_t)row * D + u.pn * 256 + bj * 128 + wc * 32 + fq * 8 + n * 4) = acc[ai][bj][m][n] * osc;
                }
        }
    }
};
struct EpiSsm1 {
    static constexpr bool PERM = true, AFTER_DRAIN = true;
    const float* a16;
    bf16_t* xu;
    __device__ __forceinline__ void fused(AccRef acc, const Unit& u, int wr, int wc, int fr, int fq, LAS unsigned char* lds, int wid, int lane) const {
        LAS float* S = (LAS float*)lds;
#pragma unroll
        for (int ai = 0; ai < 2; ++ai)
#pragma unroll
            for (int m = 0; m < 4; ++m) {
                const int row = ai * 128 + wr * 64 + m * 16 + fr;
#pragma unroll
                for (int n = 0; n < 2; ++n) *(LAS f32x4*)(S + row * 128 + wc * 32 + fq * 8 + n * 4) = acc[ai][0][m][n];
            }
        LDS_WAIT(); __builtin_amdgcn_s_barrier(); asm volatile("" ::: "memory");
        LAS f32x2* Sp = (LAS f32x2*)lds; LAS f32x2* E = (LAS f32x2*)(lds + LDS_AUX);
        const int p = lane, seg = wid;
        const f32x2 a = *(const f32x2*)(a16 + 2 * p);
        f32x2 x = {0.f, 0.f};
        for (int c = seg * 32; c < seg * 32 + 32; ++c) { const f32x2 s = Sp[c * 64 + p]; Sp[c * 64 + p] = x; x = (f32x2){a.x * x.x - a.y * x.y + s.x, a.x * x.y + a.y * x.x + s.y}; }
        E[seg * 64 + p] = x;
        LDS_WAIT(); __builtin_amdgcn_s_barrier(); asm volatile("" ::: "memory");
        f32x2 a512 = a;
#pragma unroll
        for (int i = 0; i < 5; ++i) a512 = (f32x2){a512.x * a512.x - a512.y * a512.y, 2.f * a512.x * a512.y};
        f32x2 z = {0.f, 0.f};
        for (int j = 0; j < seg; ++j) { const f32x2 e = E[j * 64 + p]; z = (f32x2){a512.x * z.x - a512.y * z.y + e.x, a512.x * z.y + a512.y * z.x + e.y}; }
        for (int c = seg * 32; c < seg * 32 + 32; ++c) { const f32x2 hl = Sp[c * 64 + p];
            *(unsigned*)(xu + (size_t)c * 384 + 256 + 2 * p) = pk2(hl.x + z.x, hl.y + z.y);
            z = (f32x2){a.x * z.x - a.y * z.y, a.x * z.y + a.y * z.x}; }
    }
};
struct EpiSsm2 {
    static constexpr bool PERM = true, AFTER_DRAIN = false;
    bf16_t* ys; int b, g;
    __device__ __forceinline__ void operator()(AccRef acc, const Unit& u, int wr, int wc, int fr, int fq) const {
#pragma unroll
        for (int ai = 0; ai < 2; ++ai)
#pragma unroll
            for (int m = 0; m < 4; ++m) {
                const int c = ai * 128 + wr * 64 + m * 16 + fr;
#pragma unroll
                for (int bj = 0; bj < 2; ++bj) {
                    const int j = bj * 8 + wc * 2 + (fq >> 1), h0 = (fq & 1) * 8;
                    f32x4 v[2];
#pragma unroll
                    for (int n = 0; n < 2; ++n)
#pragma unroll
                        for (int i = 0; i < 4; ++i) v[n][i] = gelu_tanh_(acc[ai][bj][m][n][i]);
                    *(u32x4*)(ys + ((size_t)b * SEQ + c * 16 + j) * SW + g * 16 + h0) = pack8(v[0], v[1]);
                }
            }
    }
};

#define XB_TMO      128
#define XB_XCNT(j)  (256  + 64 * (j))
#define XB_XSUB(j)  (1280 + 64 * (j))
#define XB_XGEN(j)  (2304 + 64 * (j))
#define XB_TOP      3328
#define XB_TOPGEN   3392
#define XCD_BAR_WORDS 3456
#define XB_SPIN_CAP (1u << 18)
__device__ __forceinline__ unsigned xb_ld(unsigned* p)              { return __hip_atomic_load(p, __ATOMIC_RELAXED, __HIP_MEMORY_SCOPE_AGENT); }
__device__ __forceinline__ unsigned xb_add(unsigned* p, unsigned v) { return __hip_atomic_fetch_add(p, v, __ATOMIC_RELAXED, __HIP_MEMORY_SCOPE_AGENT); }
__device__ __forceinline__ unsigned xb_xcc_id() { return (unsigned)__builtin_amdgcn_s_getreg((3 << 11) | 20) & 0xFu; }
#define XB_SPIN(cond, bar) do { unsigned _sp = 0; while (cond) { __builtin_amdgcn_s_sleep(1); \
    if ((++_sp & 255u) == 0u) { if (xb_ld(&(bar)[XB_TMO])) break; if (_sp > XB_SPIN_CAP) { atomicAdd(&(bar)[XB_TMO], 1u); break; } } } } while (0)
struct XcdBarrier { unsigned* bar; unsigned x; volatile LAS unsigned* st; };
__device__ __forceinline__ XcdBarrier xcd_barrier_post(unsigned* bar, volatile LAS unsigned* st) {
    XcdBarrier b; b.bar = bar; b.x = xb_xcc_id(); b.st = st;
    if (threadIdx.x == 0) (void)xb_add(&bar[XB_XCNT(b.x)], 1u);
    return b;
}
__device__ __forceinline__ void xcd_barrier_complete(unsigned* bar, unsigned x, unsigned& nloc, unsigned& nx) {
    const unsigned G = gridDim.x * gridDim.y * gridDim.z;
    unsigned sum, cnt, mine, sp = 0u;
    for (;;) {
        sum = 0u; cnt = 0u; mine = 0u;
#pragma unroll
        for (unsigned j = 0; j < 16; ++j) { const unsigned c = xb_ld(&bar[XB_XCNT(j)]); sum += c; cnt += (c > 0u) ? 1u : 0u; mine = (j == x) ? c : mine; }
        if (sum == G) break;
        __builtin_amdgcn_s_sleep(1);
        if ((++sp & 255u) == 0u) { if (xb_ld(&bar[XB_TMO])) break; if (sp > XB_SPIN_CAP) { atomicAdd(&bar[XB_TMO], 1u); break; } }
    }
    nloc = mine > 0u ? mine : 1u; nx = cnt > 0u ? cnt : 1u;
}
__device__ __forceinline__ void xcd_barrier(const XcdBarrier& b, const int tid) {
    asm volatile("s_waitcnt vmcnt(0)" ::: "memory");
    __syncthreads();
    if (tid == 0) {
        unsigned* bar = b.bar;
        __builtin_amdgcn_s_waitcnt(0);
        unsigned nloc = b.st[0], nx = b.st[1];
        if (nloc == 0u) { xcd_barrier_complete(bar, b.x, nloc, nx); b.st[0] = nloc; b.st[1] = nx; }
        const unsigned old = xb_add(&bar[XB_XSUB(b.x)], 1u);
        const unsigned gen = old / nloc;
        if (old + 1u == (gen + 1u) * nloc) {
            __builtin_amdgcn_fence(__ATOMIC_RELEASE, "agent");
            asm volatile("s_waitcnt vmcnt(0)" ::: "memory");
            const unsigned og = xb_add(&bar[XB_TOP], 1u);
            const unsigned tg = og / nx;
            if (og + 1u == (tg + 1u) * nx) xb_add(&bar[XB_TOPGEN], 1u);
            else XB_SPIN(xb_ld(&bar[XB_TOPGEN]) == tg, bar);
            __builtin_amdgcn_fence(__ATOMIC_ACQUIRE, "agent");
            xb_add(&bar[XB_XGEN(b.x)], 1u);
            asm volatile("s_waitcnt vmcnt(0)" ::: "memory");
        } else {
            XB_SPIN(xb_ld(&bar[XB_XGEN(b.x)]) == gen, bar);
            __builtin_amdgcn_fence(__ATOMIC_ACQUIRE, "agent");
            asm volatile("s_waitcnt vmcnt(0)" ::: "memory");
        }
    }
    __syncthreads();
}

struct Args {
    const float* in[32];
    float* out; unsigned char* ws;
    int ph_lo, ph_hi;
};
enum { I_X = 0, I_MEM, I_MEMG, I_NMIXG, I_WIN, I_CONVW, I_CONVB, I_LNG, I_LNB, I_WPW, I_LRE, I_LIM, I_LOGDT, I_BRE, I_BIM, I_CRE, I_CIM, I_DSKIP, I_WGLU, I_WOUT,
       I_NXG, I_WQ, I_WKV, I_WO, I_NFG, I_FGU, I_FD, I_RW, I_RB, I_MGU, I_MD, I_FINALG };

struct Frame {
    LAS unsigned char* lds; int tid, lane, wave, c, G;
    unsigned char* ws; const float* const* in; float* out;
};
template <class Tp> __device__ __forceinline__ Tp* wsp(const Frame& F, size_t off) { return (Tp*)(F.ws + off); }

template <bool F8 = false>
__device__ __forceinline__ void xpose_matrix(const Frame& F, const float* W, int K, int Nsrc, int N, bf16_t* WT, int permlimit, int halfN, const float* gk, float sc, unsigned& item_base) {
    LAS float* scr = (LAS float*)(F.lds + F.wave * 16640);
    const int lane = F.lane, NGW = F.G * 8, gw = F.c * 8 + F.wave;
    const int nblk = N / 64, items = (K / 64) * nblk;
    int first = (int)(((unsigned)gw + (unsigned)NGW - (item_base % (unsigned)NGW)) % (unsigned)NGW);
    item_base = (item_base + (unsigned)items) % (unsigned)NGW;
    const int kr = lane >> 4, nc = (lane & 15) * 4;
    for (int it = first; it < items; it += NGW) {
        const int kb = it / nblk, nb = it % nblk, k0 = 64 * kb, n0 = 64 * nb;
        const int c0 = (n0 < permlimit) ? (((n0 >> 7) & 1) * halfN + (n0 >> 8) * 128 + (n0 & 127)) : n0;
        f32x4 v[16];
#pragma unroll
        for (int i = 0; i < 16; ++i) v[i] = *(const f32x4*)(W + (size_t)(k0 + 4 * i + kr) * Nsrc + c0 + nc);
#pragma unroll
        for (int i = 0; i < 16; ++i) { const float g = gk ? gk[k0 + 4 * i + kr] * sc : sc; LAS float* d = scr + (4 * i + kr) * 65 + nc;
            d[0] = v[i][0] * g; d[1] = v[i][1] * g; d[2] = v[i][2] * g; d[3] = v[i][3] * g; }
        LDS_WAIT(); asm volatile("" ::: "memory");
        const int c = lane & 7;
#pragma unroll
        for (int j = 0; j < 8; ++j) { const int n = (lane >> 3) + 8 * j; const LAS float* s = scr + (8 * c) * 65 + n;
            u32x4 o; o.x = pk2(s[0 * 65], s[1 * 65]); o.y = pk2(s[2 * 65], s[3 * 65]); o.z = pk2(s[4 * 65], s[5 * 65]); o.w = pk2(s[6 * 65], s[7 * 65]);
            if (F8) { u32x2 o8; o8.x = pk4_fp8(s[0 * 65], s[1 * 65], s[2 * 65], s[3 * 65]); o8.y = pk4_fp8(s[4 * 65], s[5 * 65], s[6 * 65], s[7 * 65]); *(u32x2*)((unsigned char*)WT + (size_t)(n0 + n) * K + k0 + 8 * c) = o8; }
            else *(u32x4*)(WT + (size_t)(n0 + n) * K + k0 + 8 * c) = o; }
        LDS_WAIT(); asm volatile("" ::: "memory");
    }
}
struct XDesc { unsigned long long src, dst, gk; int K, Nsrc, nblk, permlimit, halfN, f8; float sc; unsigned base; unsigned pad[2]; };
static_assert(sizeof(XDesc) == 64, "XDesc is four 16-byte words");
static_assert(MK_ONE_LAUNCH == 1, "deferred weights are converted inside the grid barriers of the one-launch kernel");
static_assert(F8_GATES && F8_QO && F8_MOE_MASK == 0xA && F8_DENSE_MASK == 0x4, "the deferred-conversion table below is written for this precision configuration");
constexpr int LDS_BGTAB = LDS_MISC + 256, BG_NMAT = 55 + (F8_IN_S ? 3 : 0);
static_assert(LDS_BGTAB + (BG_NMAT + 1) * 64 <= LDS_BYTES, "descriptor table inside the LDS allocation");
constexpr int MI_LCUR = 16, MI_SEQ = 17, MI_THR = 18  , MI_MCUR = 24  ;
__device__ __forceinline__ void xd_store(LAS XDesc* p, const XDesc& v) { const u32x4* q = (const u32x4*)&v; LAS u32x4* d = (LAS u32x4*)p; d[0] = q[0]; d[1] = q[1]; d[2] = q[2]; d[3] = q[3]; }
__device__ __forceinline__ XDesc xd_load(const LAS XDesc* p) { const LAS u32x4* d = (const LAS u32x4*)p; u32x4 q[4] = {d[0], d[1], d[2], d[3]}; return __builtin_bit_cast(XDesc, q); }
__device__ __forceinline__ unsigned xd_base(const LAS XDesc* p) { return ((const volatile LAS unsigned*)p)[13]; }
__device__ __forceinline__ void xpose_item(const Frame& F, const XDesc& d, int it) {
    LAS float* scr = (LAS float*)(F.lds + F.wave * 16640);
    const int lane = F.lane, kr = lane >> 4, nc = (lane & 15) * 4;
    const GAS float* W = (const GAS float*)d.src; const GAS float* gk = (const GAS float*)d.gk;     const int K = d.K, Nsrc = d.Nsrc;
    const int kb = it / d.nblk, nb = it - kb * d.nblk, k0 = 64 * kb, n0 = 64 * nb;
    const int c0 = (n0 < d.permlimit) ? (((n0 >> 7) & 1) * d.halfN + (n0 >> 8) * 128 + (n0 & 127)) : n0;
#pragma unroll
    for (int hh = 0; hh < 2; ++hh) {
        f32x4 v[8];
#pragma unroll
        for (int i = 0; i < 8; ++i) v[i] = *(const GAS f32x4*)(W + (size_t)(k0 + 4 * (8 * hh + i) + kr) * Nsrc + c0 + nc);
#pragma unroll
        for (int i = 0; i < 8; ++i) { const float g = gk ? gk[k0 + 4 * (8 * hh + i) + kr] * d.sc : d.sc; LAS float* q = scr + (4 * (8 * hh + i) + kr) * 65 + nc;
            q[0] = v[i][0] * g; q[1] = v[i][1] * g; q[2] = v[i][2] * g; q[3] = v[i][3] * g; }
    }
    LDS_WAIT(); asm volatile("" ::: "memory");
    const int c = lane & 7;
#pragma unroll
    for (int j = 0; j < 8; ++j) { const int n = (lane >> 3) + 8 * j; const LAS float* s = scr + (8 * c) * 65 + n;
        if (d.f8) { u32x2 o8; o8.x = pk4_fp8(s[0 * 65], s[1 * 65], s[2 * 65], s[3 * 65]); o8.y = pk4_fp8(s[4 * 65], s[5 * 65], s[6 * 65], s[7 * 65]); *(GAS u32x2*)((GAS unsigned char*)d.dst + (size_t)(n0 + n) * K + k0 + 8 * c) = o8; }
        else { u32x4 o; o.x = pk2(s[0 * 65], s[1 * 65]); o.y = pk2(s[2 * 65], s[3 * 65]); o.z = pk2(s[4 * 65], s[5 * 65]); o.w = pk2(s[6 * 65], s[7 * 65]); *(GAS u32x4*)((GAS bf16_t*)d.dst + (size_t)(n0 + n) * K + k0 + 8 * c) = o; } }
    LDS_WAIT(); asm volatile("" ::: "memory");
}
__device__ __forceinline__ bool bg_try(const Frame& F, unsigned limit) {
    volatile LAS unsigned* MISC = (volatile LAS unsigned*)(F.lds + LDS_MISC);
    LAS unsigned* lcur = (LAS unsigned*)(F.lds + LDS_MISC) + MI_LCUR;
    unsigned k = 0u; if (F.lane == 0) k = __hip_atomic_fetch_add(lcur, 1u, __ATOMIC_RELAXED, __HIP_MEMORY_SCOPE_WORKGROUP);
    k = (unsigned)__builtin_amdgcn_readfirstlane((int)k);
    const unsigned g = k * (unsigned)F.G + (unsigned)F.c;
    if (g >= limit) { if (F.lane == 0) __hip_atomic_fetch_sub(lcur, 1u, __ATOMIC_RELAXED, __HIP_MEMORY_SCOPE_WORKGROUP); return false; }
    const LAS XDesc* tab = (const LAS XDesc*)(F.lds + LDS_BGTAB);
    int m = (int)MISC[MI_MCUR + F.wave];
    while (g >= xd_base(tab + m + 1)) ++m;
    if (F.lane == 0) MISC[MI_MCUR + F.wave] = (unsigned)m;
    const XDesc d = xd_load(tab + m);
    xpose_item(F, d, (int)(g - d.base));
    return true;
}
__device__ __forceinline__ void bg_drain(const Frame& F, int which) {
    const unsigned limit = ((volatile LAS unsigned*)(F.lds + LDS_MISC))[MI_THR + which];
    while (bg_try(F, limit)) {}
}
__device__ __forceinline__ void ssm_tables(const Frame& F, int layer, int g) {
    LAS float* L = (LAS float*)F.lds;
    LAS float* AP = L;
    LAS float* BB = L + 17 * 128;
    LAS float* CC = BB + 2048;
    LAS float* KI = CC + 2048;
    const int tid = F.tid;
    const float* lre = F.in[I_LRE] + (size_t)(layer * NG + g) * SP; const float* lim = F.in[I_LIM] + (size_t)(layer * NG + g) * SP;
    const float dt = expf(F.in[I_LOGDT][layer * NG + g]);
    __syncthreads();
    for (int i = tid; i < 17 * 64; i += 512) { const int n = i >> 6, p = i & 63; const float mag = expf((float)n * lre[p] * dt), th = (float)n * (lim[p] * dt); AP[i * 2] = mag * cosf(th); AP[i * 2 + 1] = mag * sinf(th); }
    {
        const float* bre = F.in[I_BRE] + (size_t)(layer * NG + g) * SP * SG; const float* bim = F.in[I_BIM] + (size_t)(layer * NG + g) * SP * SG;
        for (int i = tid; i < 1024; i += 512) { const int p = i >> 4; const float lr = lre[p], li = lim[p];
            const float mag = expf(lr * dt), ar = mag * cosf(li * dt), aim = mag * sinf(li * dt), den = lr * lr + li * li, xr = ar - 1.0f;
            const float kr = (xr * lr + aim * li) / den, ki = (aim * lr - xr * li) / den, br = bre[i], bi = bim[i];
            BB[i * 2] = kr * br - ki * bi; BB[i * 2 + 1] = kr * bi + ki * br; }
        const float* cre = F.in[I_CRE] + (size_t)(layer * NG + g) * SG * SP; const float* cim = F.in[I_CIM] + (size_t)(layer * NG + g) * SG * SP;
        for (int i = tid; i < 1024; i += 512) { CC[i * 2] = cre[i]; CC[i * 2 + 1] = cim[i]; }
    }
    __syncthreads();
    for (int i = tid; i < 4096; i += 512) { const int tau = i >> 8, hp = (i >> 4) & 15, h = i & 15; float s = 0.f;
        for (int p = 0; p < 64; ++p) { const float ar = AP[(tau * 64 + p) * 2], ai = AP[(tau * 64 + p) * 2 + 1], br = BB[(p * 16 + h) * 2], bi = BB[(p * 16 + h) * 2 + 1];
            const float tr = ar * br - ai * bi, ti = ar * bi + ai * br; s += CC[(hp * 64 + p) * 2] * tr - CC[(hp * 64 + p) * 2 + 1] * ti; }
        if (tau == 0 && hp == h) s += F.in[I_DSKIP][(layer * NG + g) * SG + h];
        KI[i] = s; }
    __syncthreads();
    bf16_t* wst = wsp<bf16_t>(F, WS_WST) + (size_t)(layer * NG + g) * 256 * 256;
    bf16_t* tw = wsp<bf16_t>(F, WS_TW) + (size_t)(layer * NG + g) * 256 * 384;
    for (int i = tid; i < 256 * 128; i += 512) { const int row = i >> 7, cp = (i & 127) * 2; unsigned o = 0u;
        if (row < 128) { const int p = row >> 1, ri = row & 1; float v[2];
#pragma unroll
            for (int e = 0; e < 2; ++e) { const int col = cp + e, s = col >> 4, h = col & 15; const float ar = AP[((15 - s) * 64 + p) * 2], ai = AP[((15 - s) * 64 + p) * 2 + 1], br = BB[(p * 16 + h) * 2], bi = BB[(p * 16 + h) * 2 + 1];
                v[e] = ri ? (ar * bi + ai * br) : (ar * br - ai * bi); }
            o = pk2(v[0], v[1]); }
        *(unsigned*)(wst + (size_t)row * 256 + cp) = o; }
    for (int i = tid; i < 256 * 192; i += 512) { const int row = i / 192, cp = (i % 192) * 2, j = row >> 4, hp = row & 15; float v[2];
#pragma unroll
        for (int e = 0; e < 2; ++e) { const int col = cp + e;
            if (col < 256) { const int s = col >> 4, h = col & 15; v[e] = (j >= s) ? KI[((j - s) * 16 + hp) * 16 + h] : 0.f; }
            else { const int q = col - 256, p = q >> 1, ri = q & 1; const float ar = AP[((j + 1) * 64 + p) * 2], ai = AP[((j + 1) * 64 + p) * 2 + 1], cr = CC[(hp * 64 + p) * 2], ci = CC[(hp * 64 + p) * 2 + 1];
                v[e] = ri ? -(cr * ai + ci * ar) : (cr * ar - ci * ai); } }
        *(unsigned*)(tw + (size_t)row * 384 + cp) = pk2(v[0], v[1]); }
    float* a16 = wsp<float>(F, WS_A16) + (size_t)(layer * NG + g) * 128;
    for (int i = tid; i < 128; i += 512) a16[i] = AP[16 * 128 + i];
    __syncthreads();
}

__device__ __forceinline__ void prologue(const Frame& F) {
    if (F.tid == 0) {
        LAS XDesc* tab = (LAS XDesc*)(F.lds + LDS_BGTAB); volatile LAS unsigned* MISC = (volatile LAS unsigned*)(F.lds + LDS_MISC);
        int n = 0; unsigned base = 0u;
#define XQ_ADD(SRC, K_, NSRC_, N_, DST, PERML, HALFN, GK, SC, F8_) do { XDesc xd_; xd_.src = (unsigned long long)(SRC); xd_.dst = (unsigned long long)(DST); xd_.gk = (unsigned long long)(GK); xd_.K = (K_); xd_.Nsrc = (NSRC_); xd_.nblk = (N_) / 64; \
        xd_.permlimit = (PERML); xd_.halfN = (HALFN); xd_.f8 = (F8_) ? 1 : 0; xd_.sc = (SC); xd_.base = base; xd_.pad[0] = 0u; xd_.pad[1] = 0u; xd_store(tab + n, xd_); base += (unsigned)(((K_) / 64) * ((N_) / 64)); ++n; } while (0)
#define XQ_MIXER(l) do { \
        XQ_ADD(F.in[I_WIN] + (size_t)(l) * D * INC, D, INC, (F8_IN_S ? 1024 : 1536), wsp<bf16_t>(F, WS_WIN) + (size_t)(l) * INC * D, 1024, 512, F.in[I_NMIXG] + (l) * D, 1.f, false); \
        if (F8_IN_S) XQ_ADD(F.in[I_WIN] + (size_t)(l) * D * INC + 1024, D, INC, 512, wsp<bf16_t>(F, WS_WIN) + (size_t)(l) * INC * D + (size_t)2560 * D, 0, 0, F.in[I_NMIXG] + (l) * D, F8_WGU_SCALE, true);     \
        XQ_ADD(F.in[I_WIN] + (size_t)(l) * D * INC + 1536, D, INC, 2048, wsp<bf16_t>(F, WS_WIN) + (size_t)(l) * INC * D + (size_t)1536 * D, 0, 0, F.in[I_NMIXG] + (l) * D, F8_WGU_SCALE, true); \
        XQ_ADD(F.in[I_WPW] + (size_t)(l) * CW * D, CW, D, D, wsp<bf16_t>(F, WS_WPW) + (size_t)(l) * D * CW, 0, 0, (const float*)nullptr, 1.f, false); \
        XQ_ADD(F.in[I_WGLU] + (size_t)(l) * SW * 2 * D, SW, 2 * D, 2 * D, wsp<bf16_t>(F, WS_WGLU) + (size_t)(l) * 2 * D * SW, 2 * D, D, (const float*)nullptr, 1.f, false); \
        XQ_ADD(F.in[I_WOUT] + (size_t)(l) * D * D, D, D, D, wsp<bf16_t>(F, WS_WOUT) + (size_t)(l) * D * D, 0, 0, (const float*)nullptr, (F8_OUT ? F8_WO_SCALE : 1.f), (F8_OUT != 0)); \
        XQ_ADD(F.in[I_WQ] + (size_t)(l) * D * D, D, D, D, wsp<bf16_t>(F, WS_WQ) + (size_t)(l) * D * D, 0, 0, F.in[I_NXG] + (l) * D, 0.0625f * F8_WQ_SCALE, true); \
        XQ_ADD(F.in[I_WO] + (size_t)(l) * D * D, D, D, D, wsp<bf16_t>(F, WS_WO) + (size_t)(l) * D * D, 0, 0, (const float*)nullptr, F8_WO_SCALE, true); } while (0)
#define XQ_MOE(j) do { for (int e = 0; e < NE; ++e) { \
        XQ_ADD(F.in[I_MGU] + (size_t)((j) * NE + e) * D * 2 * DFE, D, 2 * DFE, 2 * DFE, (unsigned char*)wsp<bf16_t>(F, WS_WMGU) + (size_t)(j) * NE * 2 * DFE * D * 2 + (size_t)e * 2 * DFE * D, 2 * DFE, DFE, F.in[I_NFG] + (2 * (j) + 1) * D, F8_WGU_SCALE, true); \
        XQ_ADD(F.in[I_MD] + (size_t)((j) * NE + e) * DFE * D, DFE, D, D, (unsigned char*)wsp<bf16_t>(F, WS_WMD) + (size_t)(j) * NE * D * DFE * 2 + (size_t)e * D * DFE, 0, 0, (const float*)nullptr, F8_WD_SCALE, true); } } while (0)
        XQ_MIXER(1); XQ_MOE(0); MISC[MI_THR + 0] = base;
        XQ_MIXER(2);
        XQ_ADD(F.in[I_FGU] + (size_t)1 * D * 2 * DFF, D, 2 * DFF, 2 * DFF, wsp<bf16_t>(F, WS_WFGU) + (size_t)1 * 2 * DFF * D, 2 * DFF, DFF, F.in[I_NFG] + 2 * D, F8_WGU_SCALE, true);
        XQ_ADD(F.in[I_FD] + (size_t)1 * DFF * D, DFF, D, D, wsp<bf16_t>(F, WS_WFD) + (size_t)1 * D * DFF, 0, 0, (const float*)nullptr, F8_WD_SCALE, true);
        MISC[MI_THR + 1] = base;
        XQ_MIXER(3); XQ_MOE(1); MISC[MI_THR + 2] = base;
        XDesc sent{}; sent.base = base; xd_store(tab + n, sent);
#undef XQ_MOE
#undef XQ_MIXER
#undef XQ_ADD
    }
    unsigned ib = 0u;
    {
        const int l = 0;
        xpose_matrix(F, F.in[I_WIN] + (size_t)l * D * INC, D, INC, (F8_IN_S ? 1024 : 1536), wsp<bf16_t>(F, WS_WIN) + (size_t)l * INC * D, 1024, 512, F.in[I_NMIXG] + l * D, 1.f, ib);
        if (F8_IN_S) xpose_matrix<true>(F, F.in[I_WIN] + (size_t)l * D * INC + 1024, D, INC, 512, wsp<bf16_t>(F, WS_WIN) + (size_t)l * INC * D + (size_t)2560 * D, 0, 0, F.in[I_NMIXG] + l * D, F8_WGU_SCALE, ib);
        xpose_matrix<true>(F, F.in[I_WIN] + (size_t)l * D * INC + 1536, D, INC, 2048, wsp<bf16_t>(F, WS_WIN) + (size_t)l * INC * D + (size_t)1536 * D, 0, 0, F.in[I_NMIXG] + l * D, F8_WGU_SCALE, ib);
        xpose_matrix(F, F.in[I_WPW] + (size_t)l * CW * D, CW, D, D, wsp<bf16_t>(F, WS_WPW) + (size_t)l * D * CW, 0, 0, nullptr, 1.f, ib);
        xpose_matrix(F, F.in[I_WGLU] + (size_t)l * SW * 2 * D, SW, 2 * D, 2 * D, wsp<bf16_t>(F, WS_WGLU) + (size_t)l * 2 * D * SW, 2 * D, D, nullptr, 1.f, ib);
        xpose_matrix<(F8_OUT != 0)>(F, F.in[I_WOUT] + (size_t)l * D * D, D, D, D, wsp<bf16_t>(F, WS_WOUT) + (size_t)l * D * D, 0, 0, nullptr, (F8_OUT ? F8_WO_SCALE : 1.f), ib);
        xpose_matrix<true>(F, F.in[I_WQ] + (size_t)l * D * D, D, D, D, wsp<bf16_t>(F, WS_WQ) + (size_t)l * D * D, 0, 0, F.in[I_NXG] + l * D, 0.0625f * F8_WQ_SCALE, ib);
        xpose_matrix<true>(F, F.in[I_WO] + (size_t)l * D * D, D, D, D, wsp<bf16_t>(F, WS_WO) + (size_t)l * D * D, 0, 0, nullptr, F8_WO_SCALE, ib);
    }
    for (int l = 0; l < DEPTH; ++l) xpose_matrix(F, F.in[I_WKV] + (size_t)l * D * 2 * D, D, 2 * D, 2 * D, wsp<bf16_t>(F, WS_WKV) + (size_t)l * 2 * D * D, 0, 0, nullptr, 1.f, ib);
    xpose_matrix(F, F.in[I_FGU], D, 2 * DFF, 2 * DFF, wsp<bf16_t>(F, WS_WFGU), 2 * DFF, DFF, F.in[I_NFG], 1.f, ib);
    xpose_matrix(F, F.in[I_FD], DFF, D, D, wsp<bf16_t>(F, WS_WFD), 0, 0, nullptr, 1.f, ib);
    const int gw = F.c * 8 + F.wave, NGW = F.G * 8, lane = F.lane;
    { const float* gm = F.in[I_MEMG]; bf16_t* mn = wsp<bf16_t>(F, WS_MEMN);
      for (int r = gw; r < NMEM; r += NGW) { const f32x4* xr = (const f32x4*)(F.in[I_MEM] + (size_t)r * D) + lane; f32x4 v[4]; float s = 0.f;
#pragma unroll
          for (int j = 0; j < 4; ++j) { v[j] = xr[64 * j]; s += (v[j][0] * v[j][0] + v[j][1] * v[j][1]) + (v[j][2] * v[j][2] + v[j][3] * v[j][3]); }
          const float rs = __builtin_amdgcn_rsqf(wave_sum(s) * (1.f / D) + RMS_EPS);
#pragma unroll
          for (int j = 0; j < 4; ++j) { const f32x4 gg = ((const f32x4*)gm)[64 * j + lane]; u32x2 o; o.x = pk2(v[j][0] * rs * gg[0], v[j][1] * rs * gg[1]); o.y = pk2(v[j][2] * rs * gg[2], v[j][3] * rs * gg[3]);
              *((u32x2*)(mn + (size_t)r * D) + 64 * j + lane) = o; } } }
    { bf16_t* h = wsp<bf16_t>(F, WS_H); float* st = wsp<float>(F, WS_STATS); unsigned* h8 = wsp<unsigned>(F, WS_H8);
      for (int r = gw; r < T; r += NGW) { const f32x4* xr = (const f32x4*)(F.in[I_X] + (size_t)r * D) + lane; float s = 0.f;
#pragma unroll
          for (int j = 0; j < 4; ++j) { const f32x4 v = xr[64 * j]; s += (v[0] * v[0] + v[1] * v[1]) + (v[2] * v[2] + v[3] * v[3]); u32x2 o; o.x = pk2(v[0], v[1]); o.y = pk2(v[2], v[3]);
              *((u32x2*)(h + (size_t)r * D) + 64 * j + lane) = o; if (F8_GATES) h8[(size_t)r * (D / 4) + 64 * j + lane] = pk4_fp8(v[0], v[1], v[2], v[3]); }
          s = wave_sum(s);
          if (lane < 4) st[(size_t)r * 4 + lane] = (lane == 0) ? s : 0.f; } }
    for (int it = F.c; it < DEPTH * NG; it += F.G) ssm_tables(F, it / NG, it % NG);
}

__device__ __forceinline__ void conv_phase(const Frame& F, int layer) {
    const bf16_t* uin_g = wsp<bf16_t>(F, WS_UCONV); bf16_t* uc = wsp<bf16_t>(F, WS_UC);
    LAS bf16_t* uin = (LAS bf16_t*)F.lds;
    LAS float* yb = (LAS float*)(F.lds + 65536);
    const int tid = F.tid, lane = F.lane, wave = F.wave;
    float w[CK];
#pragma unroll
    for (int k = 0; k < CK; ++k) w[k] = F.in[I_CONVW][(size_t)(layer * CK + k) * CW + tid];
    const float bias = F.in[I_CONVB][layer * CW + tid];
    f32x4 lg0, lg1, lb0, lb1;
    { const f32x4* gp = (const f32x4*)(F.in[I_LNG] + layer * CW + lane * 8); lg0 = gp[0]; lg1 = gp[1]; const f32x4* bp = (const f32x4*)(F.in[I_LNB] + layer * CW + lane * 8); lb0 = bp[0]; lb1 = bp[1]; }
    for (int tile = F.c; tile < T / 32; tile += F.G) {
        const int t0 = tile * 32, p0 = t0 & (SEQ - 1);
        __syncthreads();
#pragma unroll
        for (int it = 0; it < 8; ++it) { const int id = it * 512 + tid;
            if (id < 62 * 64) { const int row = id >> 6, ch = id & 63; u32x4 v = {0u, 0u, 0u, 0u};
                if (p0 - 30 + row >= 0) v = *(const u32x4*)(uin_g + (size_t)(t0 - 30 + row) * CW + ch * 8);
                *(LAS u32x4*)(uin + row * 512 + ch * 8) = v; } }
        __syncthreads();
        float y[32], uu[62];
#pragma unroll
        for (int o = 0; o < 32; ++o) y[o] = bias;
#pragma unroll
        for (int j = 0; j < 62; ++j) uu[j] = __uint_as_float(((unsigned)uin[j * 512 + tid]) << 16);
#pragma unroll
        for (int k = 0; k < CK; ++k)
#pragma unroll
            for (int o = 0; o < 32; ++o) y[o] += w[k] * uu[o + k];
#pragma unroll
        for (int o = 0; o < 32; ++o) yb[o * 512 + tid] = y[o];
        __syncthreads();
#pragma unroll
        for (int q = 0; q < 4; ++q) { const int o = wave + 8 * q; const LAS f32x4* rp = (const LAS f32x4*)(yb + o * 512 + lane * 8); f32x4 a = rp[0], b = rp[1];
            const float mean = wave_sum((a[0] + a[1]) + (a[2] + a[3]) + (b[0] + b[1]) + (b[2] + b[3])) * (1.f / CW);
            a = a - mean; b = b - mean;
            const float var = wave_sum((a[0] * a[0] + a[1] * a[1]) + (a[2] * a[2] + a[3] * a[3]) + (b[0] * b[0] + b[1] * b[1]) + (b[2] * b[2] + b[3] * b[3])) * (1.f / CW);
            const float rs = __builtin_amdgcn_rsqf(var + LN_EPS);
            a = a * rs * lg0 + lb0; b = b * rs * lg1 + lb1;
#pragma unroll
            for (int i = 0; i < 4; ++i) { a[i] = siluf_(a[i]); b[i] = siluf_(b[i]); }
            *(u32x4*)(uc + (size_t)(t0 + o) * CW + lane * 8) = pack8(a, b); }
    }
    __syncthreads();
}

#define MFMA32(a, b, c) __builtin_amdgcn_mfma_f32_32x32x16_bf16((a), (b), (c), 0, 0, 0)
#define ATT_LOAD16(dst, ptr0, stride_bytes) do { unsigned long long _p = (unsigned long long)(ptr0); _Pragma("unroll") for (int it = 0; it < 16; ++it) { dst[it] = *(const GAS u32x4*)_p; _p += (stride_bytes); asm volatile("" : "+v"(_p)); } } while (0)
#define ATT_STORE16(src) do { LAS char* _w0 = (LAS char*)Ks + (tid >> 5) * 528 + (tid & 31) * 16; asm volatile("" : "+v"(_w0)); LAS char* _w1 = _w0 + 8 * 8448; _Pragma("unroll") for (int it = 0; it < 8; ++it) { *(LAS u32x4*)(_w0 + it * 8448) = src[it]; *(LAS u32x4*)(_w1 + it * 8448) = src[it + 8]; } } while (0)
__device__ __forceinline__ void attn_phase(const Frame& F, int layer) {
    const bf16_t* Q = wsp<bf16_t>(F, WS_Q); const bf16_t* Km = wsp<bf16_t>(F, WS_KMAT) + (size_t)layer * NMEM * D; const bf16_t* Vt = wsp<bf16_t>(F, WS_VT) + (size_t)layer * D * NMEM;
    bf16_t* AO = wsp<bf16_t>(F, WS_AO);
    LAS bf16_t* Ks = (LAS bf16_t*)F.lds;
    const int tid = F.tid, lane = F.lane, wave = F.wave, l31 = lane & 31, lh = lane >> 5;
    constexpr int NU = BATCH * HEADS * (SEQ / 256);
    u32x4 Kr[16];
    if (F.c < NU) { const int bh = F.c & 31, b = bh >> 2, hd = bh & 3;
        ATT_LOAD16(Kr, Km + (size_t)(b * MEM + (tid >> 5)) * D + hd * HD + (tid & 31) * 8, 16 * D * 2); }
    for (int unit = F.c; unit < NU; unit += F.G) {
        const int bh = unit & 31, qt = unit >> 5, b = bh >> 2, hd = bh & 3;
        const size_t qrow = (size_t)b * SEQ + qt * 256 + wave * 32 + l31;
        bf16x8 Qf[16];
#pragma unroll
        for (int db = 0; db < 16; ++db) Qf[db] = *(const bf16x8*)(Q + qrow * D + hd * HD + db * 16 + lh * 8);
        __syncthreads();
        ATT_STORE16(Kr);
        ATT_LOAD16(Kr, Vt + (size_t)(hd * HD + (tid >> 5)) * NMEM + b * MEM + (tid & 31) * 8, 16 * NMEM * 2);
        __syncthreads();
        u32x4 sp[8][2];
        float mx = -3.0e38f;
#pragma unroll
        for (int kb = 0; kb < 8; ++kb) {
            f32x16 sc;
#pragma unroll
            for (int i = 0; i < 16; ++i) sc[i] = 0.f;
#pragma unroll
            for (int db = 0; db < 16; ++db) { const bf16x8 a = *(const LAS bf16x8*)(Ks + (kb * 32 + l31) * 264 + db * 16 + lh * 8); sc = MFMA32(a, Qf[db], sc); }
#pragma unroll
            for (int i = 0; i < 16; ++i) mx = fmaxf(mx, sc[i]);
#pragma unroll
            for (int hh = 0; hh < 2; ++hh) { sp[kb][hh].x = pk2(sc[8 * hh + 0], sc[8 * hh + 1]); sp[kb][hh].y = pk2(sc[8 * hh + 2], sc[8 * hh + 3]); sp[kb][hh].z = pk2(sc[8 * hh + 4], sc[8 * hh + 5]); sp[kb][hh].w = pk2(sc[8 * hh + 6], sc[8 * hh + 7]); }
        }
        mx = fmaxf(mx, __shfl_xor(mx, 32));
        float sum = 0.f;
        bf16x8 Pf[16];
#pragma unroll
        for (int kb = 0; kb < 8; ++kb)
#pragma unroll
            for (int hh = 0; hh < 2; ++hh) { f32x4 a, bq; unpack8(sp[kb][hh], a, bq);
#pragma unroll
                for (int i = 0; i < 4; ++i) { a[i] = fast_exp2((a[i] - mx) * 1.44269504f); bq[i] = fast_exp2((bq[i] - mx) * 1.44269504f); sum += a[i] + bq[i]; }
                Pf[kb * 2 + hh] = __builtin_bit_cast(bf16x8, pack8(a, bq)); }
        sum += __shfl_xor(sum, 32);
        const float inv = 1.0f / sum;
        __syncthreads();
        ATT_STORE16(Kr);
        if (unit + F.G < NU) { const int nbh = (unit + F.G) & 31, nb = nbh >> 2, nhd = nbh & 3;
            ATT_LOAD16(Kr, Km + (size_t)(nb * MEM + (tid >> 5)) * D + nhd * HD + (tid & 31) * 8, 16 * D * 2); }
        __syncthreads();
#pragma unroll
        for (int db = 0; db < 8; ++db) {
            f32x16 o;
#pragma unroll
            for (int i = 0; i < 16; ++i) o[i] = 0.f;
#pragma unroll
            for (int kk = 0; kk < 16; ++kk) { const LAS bf16_t* base = Ks + (db * 32 + l31) * 264 + kk * 16 + 4 * lh;
                const u32x2 lo = *(const LAS u32x2*)base, hi = *(const LAS u32x2*)(base + 8);
                u32x4 w; w.x = lo.x; w.y = lo.y; w.z = hi.x; w.w = hi.y;
                o = MFMA32(__builtin_bit_cast(bf16x8, w), Pf[kk], o); }
#pragma unroll
            for (int g4 = 0; g4 < 4; ++g4) {
                if (F8_QO) *(unsigned*)((unsigned char*)AO + qrow * D + hd * HD + db * 32 + 8 * g4 + 4 * lh) = pk4_fp8(o[4 * g4 + 0] * (inv * F8_AO_SCALE), o[4 * g4 + 1] * (inv * F8_AO_SCALE), o[4 * g4 + 2] * (inv * F8_AO_SCALE), o[4 * g4 + 3] * (inv * F8_AO_SCALE));
                else { u32x2 w; w.x = pk2(o[4 * g4 + 0] * inv, o[4 * g4 + 1] * inv); w.y = pk2(o[4 * g4 + 2] * inv, o[4 * g4 + 3] * inv); *(u32x2*)(AO + qrow * D + hd * HD + db * 32 + 8 * g4 + 4 * lh) = w; } }
        }
    }
    __syncthreads();
}

__device__ __forceinline__ void router_phase(const Frame& F, int layer, int j) {
    const bf16_t* h = wsp<bf16_t>(F, WS_H);
    unsigned* toke = (unsigned*)(F.ws + WS_META + MT_TOKE); float* tokw = (float*)(F.ws + WS_META + MT_TOKW); float* tokr = (float*)(F.ws + WS_META + MT_TOKR); int* wgcnt = (int*)(F.ws + WS_META + MT_WGCNT);
    LAS int* cnt = (LAS int*)(F.lds + LDS_AUX);
    const int lane = F.lane, wave = F.wave, tid = F.tid;
    float wr_[16][8];
    { const float* rw = F.in[I_RW] + (size_t)j * D * NE; const float* gg = F.in[I_NFG] + (size_t)layer * D;
#pragma unroll
      for (int kk = 0; kk < 16; ++kk) { const int k = lane * 16 + kk; const f32x4 a = *(const f32x4*)(rw + (size_t)k * NE), b = *(const f32x4*)(rw + (size_t)k * NE + 4); const float g = gg[k];
#pragma unroll
          for (int e = 0; e < 4; ++e) { wr_[kk][e] = a[e] * g; wr_[kk][4 + e] = b[e] * g; } } }
    float rb[8];
#pragma unroll
    for (int e = 0; e < 8; ++e) rb[e] = F.in[I_RB][j * NE + e];
    for (int chunk = F.c; chunk < T / 128; chunk += F.G) {
        __syncthreads();
        if (tid < 8) cnt[tid] = 0;
        __syncthreads();
        for (int ib = 0; ib < 16; ib += 4) {
          u32x4 qa[4], qb[4];
#pragma unroll
          for (int ii = 0; ii < 4; ++ii) { const int tk = chunk * 128 + wave * 16 + ib + ii; qa[ii] = *(const u32x4*)(h + (size_t)tk * D + lane * 16); qb[ii] = *(const u32x4*)(h + (size_t)tk * D + lane * 16 + 8); }
#pragma unroll
          for (int ii = 0; ii < 4; ++ii) {
            const int tok = chunk * 128 + wave * 16 + ib + ii;
            const u32x4 q0 = qa[ii], q1 = qb[ii];
            float x[16]; { f32x4 a, b, c, d; unpack8(q0, a, b); unpack8(q1, c, d);
#pragma unroll
                for (int e = 0; e < 4; ++e) { x[e] = a[e]; x[4 + e] = b[e]; x[8 + e] = c[e]; x[12 + e] = d[e]; } }
            float ss = 0.f, dt[8];
#pragma unroll
            for (int e = 0; e < 8; ++e) dt[e] = 0.f;
#pragma unroll
            for (int kk = 0; kk < 16; ++kk) { ss += x[kk] * x[kk];
#pragma unroll
                for (int e = 0; e < 8; ++e) dt[e] += x[kk] * wr_[kk][e]; }
            ss = wave_sum(ss);
#pragma unroll
            for (int e = 0; e < 8; ++e) dt[e] = wave_sum(dt[e]);
            const float r = __builtin_amdgcn_rsqf(ss * (1.f / D) + RMS_EPS);
            float v1 = -3.0e38f, v2 = -3.0e38f; int e1 = 0, e2 = 0;
#pragma unroll
            for (int e = 0; e < 8; ++e) { const float lg = dt[e] * r + rb[e]; if (lg > v1) { v2 = v1; e2 = e1; v1 = lg; e1 = e; } else if (lg > v2) { v2 = lg; e2 = e; } }
            const float w1 = 1.0f / (1.0f + __expf(v2 - v1)), w2 = 1.0f - w1;
            if (lane == 0) { toke[tok] = (unsigned)e1 | ((unsigned)e2 << 8); tokw[2 * tok] = w1; tokw[2 * tok + 1] = w2; tokr[tok] = r;
                atomicAdd((int*)&cnt[e1], 1); atomicAdd((int*)&cnt[e2], 1); }
          }
        }
        __syncthreads();
        if (tid < 8) wgcnt[chunk * 8 + tid] = cnt[tid];
    }
    __syncthreads();
}
template <bool F8>
__device__ __forceinline__ void assign_phase(const Frame& F) {
    const bf16_t* h = wsp<bf16_t>(F, WS_H); bf16_t* hs = wsp<bf16_t>(F, WS_HS);
    const unsigned* toke = (const unsigned*)(F.ws + WS_META + MT_TOKE); const float* tokw = (const float*)(F.ws + WS_META + MT_TOKW); const float* tokr = (const float*)(F.ws + WS_META + MT_TOKR);
    int* tokslot = (int*)(F.ws + WS_META + MT_TOKSLOT); float* rscale = (float*)(F.ws + WS_META + MT_RSCALE); float* gwt = (float*)(F.ws + WS_META + MT_GWT);
    const int* wgcnt = (const int*)(F.ws + WS_META + MT_WGCNT); int* pexp = (int*)(F.ws + WS_META + MT_PEXP); unsigned* ctl = (unsigned*)(F.ws + WS_CTL);
    LAS int* cl = (LAS int*)(F.lds);
    LAS int* tot = (LAS int*)(F.lds + 8192);
    LAS int* sl = (LAS int*)(F.lds + 8192 + 256);
    const int tid = F.tid, lane = F.lane, wave = F.wave;
    for (int chunk = F.c; chunk < T / 128; chunk += F.G) {
        __syncthreads();
        if (tid < 16) tot[tid] = 0;
        __syncthreads();
        if (tid < 256) {
            const u32x4 c0 = *(const u32x4*)(wgcnt + tid * 8), c1 = *(const u32x4*)(wgcnt + tid * 8 + 4);
            const int my[8] = {(int)c0.x, (int)c0.y, (int)c0.z, (int)c0.w, (int)c1.x, (int)c1.y, (int)c1.z, (int)c1.w};
#pragma unroll
            for (int e = 0; e < 8; ++e) { int a = my[e], p = (tid < chunk) ? my[e] : 0;
#pragma unroll
                for (int o = 1; o < 64; o <<= 1) { a += __shfl_xor(a, o); p += __shfl_xor(p, o); }
                if (lane == 0) { atomicAdd((int*)&tot[e], a); atomicAdd((int*)&tot[8 + e], p); } }
        }
        __syncthreads();
        if (tid == 0) { int base = 0; for (int e = 0; e < 8; ++e) { tot[16 + e] = base; tot[24 + e] = base + tot[8 + e]; base += (tot[e] + 255) & ~255; }
            if (chunk == 0) { ctl[CW_PTOTAL] = (unsigned)(base >> 8); int pp = 0; for (int e = 0; e < 8; ++e) { ctl[CW_PBASE + e] = (unsigned)(tot[16 + e] >> 8); const int np = (tot[e] + 255) >> 8; for (int q = 0; q < np; ++q) pexp[pp++] = e; } } }
        __syncthreads();
        if (chunk == 0) {
            for (int e = 0; e < 8; ++e) { const int lo = tot[16 + e] + tot[e], hi = tot[16 + e] + ((tot[e] + 255) & ~255);
                for (int s = lo + tid; s < hi; s += 512) { rscale[s] = 0.f; gwt[s] = 0.f; } } }
        if (wave == 0) {
            for (int it = 0; it < 2; ++it) { const int li = it * 64 + lane, tok = chunk * 128 + li; const unsigned ee = toke[tok]; const int e1 = ee & 255, e2 = (ee >> 8) & 255; int s1 = 0, s2 = 0;
                const unsigned long long ltmask = (1ull << lane) - 1ull;
#pragma unroll
                for (int e = 0; e < 8; ++e) { const unsigned long long m1 = __ballot(e1 == e), m2 = __ballot(e2 == e); const int off = tot[24 + e];
                    if (e1 == e) s1 = off + __popcll(m1 & ltmask);
                    if (e2 == e) s2 = off + __popcll(m1) + __popcll(m2 & ltmask);
                    __builtin_amdgcn_s_waitcnt(0);
                    if (lane == 0) tot[24 + e] = off + __popcll(m1) + __popcll(m2);
                    __builtin_amdgcn_s_waitcnt(0); }
                sl[li * 2] = s1; sl[li * 2 + 1] = s2; tokslot[2 * tok] = s1; tokslot[2 * tok + 1] = s2;
                const float r = tokr[tok]; rscale[s1] = r; rscale[s2] = r; gwt[s1] = tokw[2 * tok]; gwt[s2] = tokw[2 * tok + 1]; }
        }
        __syncthreads();
        for (int q = wave; q < 256; q += 8) { const int li = q >> 1, tok = chunk * 128 + li, s = sl[q];
            const u32x4 a = *(const u32x4*)(h + (size_t)tok * D + lane * 16), b = *(const u32x4*)(h + (size_t)tok * D + lane * 16 + 8);
            if (F8) { f32x4 x0, x1, x2, x3; unpack8(a, x0, x1); unpack8(b, x2, x3); u32x4 o8; o8.x = pk4_fp8(x0[0], x0[1], x0[2], x0[3]); o8.y = pk4_fp8(x1[0], x1[1], x1[2], x1[3]); o8.z = pk4_fp8(x2[0], x2[1], x2[2], x2[3]); o8.w = pk4_fp8(x3[0], x3[1], x3[2], x3[3]);
                *(u32x4*)((unsigned char*)hs + (size_t)s * D + lane * 16) = o8; }
            else { *(u32x4*)(hs + (size_t)s * D + lane * 16) = a; *(u32x4*)(hs + (size_t)s * D + lane * 16 + 8) = b; } }
    }
    __syncthreads();
}
__device__ __forceinline__ void combine_phase(const Frame& F, bool final_) {
    bf16_t* h = wsp<bf16_t>(F, WS_H); const bf16_t* ye = wsp<bf16_t>(F, WS_YE); const float* part = wsp<float>(F, WS_MPART); const int* tokslot = (const int*)(F.ws + WS_META + MT_TOKSLOT); float* st = wsp<float>(F, WS_STATS);
    const int gw = F.c * 8 + F.wave, NGW = F.G * 8, lane = F.lane;
    for (int tok = gw; tok < T; tok += NGW) {
        const int s1 = __builtin_amdgcn_readfirstlane(tokslot[2 * tok]), s2 = __builtin_amdgcn_readfirstlane(tokslot[2 * tok + 1]);
        f32x4 x[4], y[4], z[4];
        unpack8(*(const u32x4*)(h + (size_t)tok * D + lane * 16), x[0], x[1]); unpack8(*(const u32x4*)(h + (size_t)tok * D + lane * 16 + 8), x[2], x[3]);
        if (s1 < 2 * T) { unpack8(*(const u32x4*)(ye + (size_t)s1 * D + lane * 16), y[0], y[1]); unpack8(*(const u32x4*)(ye + (size_t)s1 * D + lane * 16 + 8), y[2], y[3]); }
        else { const f32x4* p = (const f32x4*)(part + (size_t)(s1 - 2 * T) * D + lane * 16);
#pragma unroll
            for (int q = 0; q < 4; ++q) y[q] = (p[q] + p[q + (size_t)MOE_TAIL_ROWS * D / 4]) + (p[q + (size_t)2 * MOE_TAIL_ROWS * D / 4] + p[q + (size_t)3 * MOE_TAIL_ROWS * D / 4]); }
        if (s2 < 2 * T) { unpack8(*(const u32x4*)(ye + (size_t)s2 * D + lane * 16), z[0], z[1]); unpack8(*(const u32x4*)(ye + (size_t)s2 * D + lane * 16 + 8), z[2], z[3]); }
        else { const f32x4* p = (const f32x4*)(part + (size_t)(s2 - 2 * T) * D + lane * 16);
#pragma unroll
            for (int q = 0; q < 4; ++q) z[q] = (p[q] + p[q + (size_t)MOE_TAIL_ROWS * D / 4]) + (p[q + (size_t)2 * MOE_TAIL_ROWS * D / 4] + p[q + (size_t)3 * MOE_TAIL_ROWS * D / 4]); }
        float ss = 0.f;
#pragma unroll
        for (int q = 0; q < 4; ++q) { x[q] = x[q] + y[q] + z[q]; ss += (x[q][0] * x[q][0] + x[q][1] * x[q][1]) + (x[q][2] * x[q][2] + x[q][3] * x[q][3]); }
        ss = wave_sum(ss);
        if (final_) { const float r = __builtin_amdgcn_rsqf(ss * (1.f / D) + RMS_EPS); const f32x4* gp = (const f32x4*)(F.in[I_FINALG] + lane * 16); f32x4* op = (f32x4*)(F.out + (size_t)tok * D + lane * 16);
#pragma unroll
            for (int q = 0; q < 4; ++q) op[q] = x[q] * r * gp[q]; }
        else { *(u32x4*)(h + (size_t)tok * D + lane * 16) = pack8(x[0], x[1]); *(u32x4*)(h + (size_t)tok * D + lane * 16 + 8) = pack8(x[2], x[3]);
            if (F8_GATES) { u32x4 o8; o8.x = pk4_fp8(x[0][0], x[0][1], x[0][2], x[0][3]); o8.y = pk4_fp8(x[1][0], x[1][1], x[1][2], x[1][3]); o8.z = pk4_fp8(x[2][0], x[2][1], x[2][2], x[2][3]); o8.w = pk4_fp8(x[3][0], x[3][1], x[3][2], x[3][3]); *(u32x4*)(F.ws + WS_H8 + (size_t)tok * D + lane * 16) = o8; }
            if (lane < 4) st[(size_t)tok * 4 + lane] = (lane == 0) ? ss : 0.f; }
    }
}

struct SchedKV {
    int G, c; const char* memn; const char* wkv;
    __device__ __forceinline__ bool next(int i, Unit& u) const { const int L = i * G + c; if (L >= 256) return false; const int layer = L >> 6, r = L & 63; const char* w = wkv + (size_t)layer * 2 * D * D * 2;
        if (r < 32) { u.pm = r >> 2; u.pn = r & 3; u.tag = layer * 2; u.A = memn + (size_t)u.pm * 256 * D * 2; u.B = w + (size_t)u.pn * 256 * D * 2; }
        else { const int q = r - 32; u.pm = q >> 3; u.pn = q & 7; u.tag = layer * 2 + 1; u.A = w + (size_t)(D + u.pm * 256) * D * 2; u.B = memn + (size_t)u.pn * 256 * D * 2; }
        return true; }
    __device__ __forceinline__ void a_ready(const Unit&) const {}
    __device__ __forceinline__ void done(const Unit&) const {}
};
struct SchedMoe {
    pg8::StaticOrder o; const char* A; const char* B; size_t sA, sB, sE; int pb1, pb2, pb3, pb4, pb5, pb6, pb7;
    __device__ __forceinline__ void load_bases(const unsigned* ctl) {
        pb1 = __builtin_amdgcn_readfirstlane((int)ctl[CW_PBASE + 1]); pb2 = __builtin_amdgcn_readfirstlane((int)ctl[CW_PBASE + 2]); pb3 = __builtin_amdgcn_readfirstlane((int)ctl[CW_PBASE + 3]); pb4 = __builtin_amdgcn_readfirstlane((int)ctl[CW_PBASE + 4]);
        pb5 = __builtin_amdgcn_readfirstlane((int)ctl[CW_PBASE + 5]); pb6 = __builtin_amdgcn_readfirstlane((int)ctl[CW_PBASE + 6]); pb7 = __builtin_amdgcn_readfirstlane((int)ctl[CW_PBASE + 7]); }
    __device__ __forceinline__ bool next(int i, Unit& u) const { int pm, pn; if (!o.next(i, pm, pn)) return false;
        const int e = (pm >= pb1) + (pm >= pb2) + (pm >= pb3) + (pm >= pb4) + (pm >= pb5) + (pm >= pb6) + (pm >= pb7);
        u.pm = pm; u.pn = pn; u.tag = 0; u.A = A + (size_t)pm * sA; u.B = B + (size_t)e * sE + (size_t)pn * sB; return true; }
    __device__ __forceinline__ void a_ready(const Unit&) const {}
    __device__ __forceinline__ void done(const Unit&) const {}
};

struct SchedMoeD {
    pg8::StaticOrder o; const char* A; const char* B; size_t sA, sB, sE; int pb1, pb2, pb3, pb4, pb5, pb6, pb7, ptot;
    __device__ __forceinline__ void load_bases(const unsigned* ctl) {
        pb1 = __builtin_amdgcn_readfirstlane((int)ctl[CW_PBASE + 1]); pb2 = __builtin_amdgcn_readfirstlane((int)ctl[CW_PBASE + 2]); pb3 = __builtin_amdgcn_readfirstlane((int)ctl[CW_PBASE + 3]); pb4 = __builtin_amdgcn_readfirstlane((int)ctl[CW_PBASE + 4]);
        pb5 = __builtin_amdgcn_readfirstlane((int)ctl[CW_PBASE + 5]); pb6 = __builtin_amdgcn_readfirstlane((int)ctl[CW_PBASE + 6]); pb7 = __builtin_amdgcn_readfirstlane((int)ctl[CW_PBASE + 7]); }
    __device__ __forceinline__ bool next(int i, Unit& u) const { int pm, pn, kq = -1;
        if (!o.next(i, pm, pn)) { const long q = (long)i * o.G + o.c - o.nwg; if (q >= (long)(ptot - MOE_FULL_PANELS) * 16) return false; pm = MOE_FULL_PANELS + (int)(q >> 4); pn = ((int)q >> 2) & 3; kq = (int)q & 3; }
        const int e = (pm >= pb1) + (pm >= pb2) + (pm >= pb3) + (pm >= pb4) + (pm >= pb5) + (pm >= pb6) + (pm >= pb7);
        const int koff = kq <= 0 ? 0 : (kq == 1 ? 8 : (kq == 2 ? 16 : 22));
        u.pm = pm; u.pn = pn; u.tag = kq + 1; u.A = A + (size_t)pm * sA + koff * 128; u.B = B + (size_t)e * sE + (size_t)pn * sB + koff * 128; return true; }
    __device__ __forceinline__ int nt_of(const Unit& u, int nt) const { return u.tag == 0 ? nt : (u.tag <= 2 ? 8 : 6); }
    __device__ __forceinline__ void a_ready(const Unit&) const {}
    __device__ __forceinline__ void done(const Unit&) const {}
};
template <> struct pg8::SchedVarK<SchedMoeD> { static constexpr bool v = true; };

__device__ __forceinline__ void xcd_barrier_bg(const XcdBarrier& b, const Frame& F) {
    volatile LAS unsigned* MISC = (volatile LAS unsigned*)(F.lds + LDS_MISC);
    const unsigned want = MISC[MI_SEQ] + 1u;
    asm volatile("s_waitcnt vmcnt(0)" ::: "memory");
    __syncthreads();
    const unsigned limit = MISC[MI_THR + 2];
    if (F.wave == 0) {
        if (F.tid == 0) {
            unsigned* bar = b.bar;
            __builtin_amdgcn_s_waitcnt(0);
            unsigned nloc = b.st[0], nx = b.st[1];
            if (nloc == 0u) { xcd_barrier_complete(bar, b.x, nloc, nx); b.st[0] = nloc; b.st[1] = nx; }
            const unsigned old = xb_add(&bar[XB_XSUB(b.x)], 1u);
            const unsigned gen = old / nloc;
            if (old + 1u == (gen + 1u) * nloc) {
                __builtin_amdgcn_fence(__ATOMIC_RELEASE, "agent");
                asm volatile("s_waitcnt vmcnt(0)" ::: "memory");
                const unsigned og = xb_add(&bar[XB_TOP], 1u);
                const unsigned tg = og / nx;
                if (og + 1u == (tg + 1u) * nx) xb_add(&bar[XB_TOPGEN], 1u);
                else XB_SPIN(xb_ld(&bar[XB_TOPGEN]) == tg, bar);
                __builtin_amdgcn_fence(__ATOMIC_ACQUIRE, "agent");
                xb_add(&bar[XB_XGEN(b.x)], 1u);
                asm volatile("s_waitcnt vmcnt(0)" ::: "memory");
            } else {
                XB_SPIN(xb_ld(&bar[XB_XGEN(b.x)]) == gen, bar);
                __builtin_amdgcn_fence(__ATOMIC_ACQUIRE, "agent");
                asm volatile("s_waitcnt vmcnt(0)" ::: "memory");
            }
            MISC[MI_SEQ] = want;
        }
    } else {
        while (MISC[MI_SEQ] != want) { if (!bg_try(F, limit)) break; }
    }
    __syncthreads();
}

constexpr int NPH_LAYER = 13, PH_LAYER0 = 2, NPHASES = PH_LAYER0 + DEPTH * NPH_LAYER;
extern __shared__ __attribute__((aligned(16))) unsigned char lds_raw[];
struct PA { unsigned char* ws; const float* const* in; float* out; int layer; int wave; };
__device__ __forceinline__ unsigned long long uni64(unsigned long long v) { const unsigned lo = __builtin_amdgcn_readfirstlane((unsigned)v), hi = __builtin_amdgcn_readfirstlane((unsigned)(v >> 32)); return ((unsigned long long)hi << 32) | lo; }
__device__ __forceinline__ Frame mkframe(const PA a) {
    Frame P; P.lds = (LAS unsigned char*)lds_raw; P.tid = a.wave * 64 + (int)__builtin_amdgcn_mbcnt_hi(~0u, __builtin_amdgcn_mbcnt_lo(~0u, 0u)); asm volatile("" : "+v"(P.tid));     P.lane = P.tid & 63; P.wave = __builtin_amdgcn_readfirstlane(P.tid >> 6); P.c = blockIdx.x; P.G = gridDim.x;
    { typedef __attribute__((address_space(4))) const char* kptr_t; kptr_t kp = (kptr_t)__builtin_amdgcn_kernarg_segment_ptr(); asm volatile("" : "+s"(kp));
      P.ws = *(unsigned char* const __attribute__((address_space(4)))*)(kp + __builtin_offsetof(Args, ws)); (void)a.ws; }
    P.in = a.in; P.out = a.out; return P;
}
#define ST_A (wsp<float>(P, WS_STATS))
#define ST_B (wsp<float>(P, WS_STATS) + (size_t)T * 16)
#define ST_C (wsp<float>(P, WS_STATS) + (size_t)T * 32)
#define H_ (wsp<bf16_t>(P, WS_H))
#define PH_HEAD const Frame P = mkframe(a); const int layer = a.layer, c = P.c, G = P.G, jj = layer >> 1; LAS unsigned char* lds = P.lds; (void)layer; (void)c; (void)G; (void)jj; (void)lds;

__device__ __forceinline__ void ph_prologue(const PA a) { PH_HEAD prologue(P); }
__device__ __forceinline__ void ph_kv(const PA a) { PH_HEAD
    SchedKV S{G, c, (const char*)wsp<bf16_t>(P, WS_MEMN), (const char*)wsp<bf16_t>(P, WS_WKV)};
    EpiPlain E{wsp<bf16_t>(P, WS_KMAT), wsp<bf16_t>(P, WS_VT), D, NMEM, (size_t)NMEM * D, (size_t)D * NMEM};
    pg8::gemm_phase<EpiPlain, SchedKV, false, true>(lds, D, D, D, S, E, (const char*)P.ws, P.tid);
}
__device__ __forceinline__ void ph_inproj(const PA a) { PH_HEAD
    pg8::SchedStd S; S.o.init(T / 256, (F8_GATES ? (F8_IN_S ? 1024 : 1536) : INC) / 256, G, c); S.A = (const char*)H_; S.B = (const char*)(wsp<bf16_t>(P, WS_WIN) + (size_t)layer * INC * D); S.sA = (size_t)256 * D * 2; S.sB = (size_t)256 * D * 2;
    EpiInproj E{ST_A, wsp<bf16_t>(P, WS_UCONV), wsp<bf16_t>(P, WS_XU), wsp<bf16_t>(P, WS_GATES)};
    pg8::gemm_phase<EpiInproj, pg8::SchedStd, true, true>(lds, D, D, D, S, E, (const char*)P.ws, P.tid);
}
__device__ __forceinline__ void ph_inproj_gates(const PA a) { PH_HEAD
    pg8::SchedStd S; S.o.init(T / 256, (F8_IN_S ? 2560 : 2048) / 256, G, c); S.A = (const char*)wsp<unsigned char>(P, WS_H8); S.B = (const char*)(wsp<bf16_t>(P, WS_WIN) + (size_t)layer * INC * D + (size_t)1536 * D); S.sA = (size_t)256 * D; S.sB = (size_t)256 * D;
    EpiGates E{ST_A, wsp<bf16_t>(P, WS_GATES), 1.0f / F8_WGU_SCALE, wsp<bf16_t>(P, WS_XU)};
    pg8::gemm_phase<EpiGates, pg8::SchedStd, true, true, true>(lds, D, D, D, S, E, (const char*)P.ws, P.tid);
}
__device__ __forceinline__ void ph_conv(const PA a) { PH_HEAD conv_phase(P, layer); }
__device__ __forceinline__ void ph_ssm1(const PA a) { PH_HEAD
    if (c < BATCH * NG) {
        const int unit = c, g = (unit & 7) * 4 + ((unit >> 3) & 3), b = unit >> 5, ug = b * NG + g;
        bf16_t* xu = wsp<bf16_t>(P, WS_XU) + (size_t)ug * 256 * 384;
        pg8::SchedOne S; S.u0.pm = 0; S.u0.pn = 0; S.u0.tag = 0; S.u0.A = (const char*)xu; S.u0.B = (const char*)(wsp<bf16_t>(P, WS_WST) + (size_t)(layer * NG + g) * 256 * 256);
        EpiSsm1 E{wsp<float>(P, WS_A16) + (size_t)(layer * NG + g) * 128, xu};
        pg8::gemm_phase<EpiSsm1, pg8::SchedOne, false, true>(lds, 256, 384, 256, S, E, (const char*)P.ws, P.tid);
        VM_WAIT(); __syncthreads(); __builtin_amdgcn_fence(__ATOMIC_ACQUIRE, "agent"); VM_WAIT(); __syncthreads();
    }
}
__device__ __forceinline__ void ph_ssm2(const PA a) { PH_HEAD
    if (c < BATCH * NG) {
        const int unit = c, g = (unit & 7) * 4 + ((unit >> 3) & 3), b = unit >> 5, ug = b * NG + g;
        bf16_t* xu = wsp<bf16_t>(P, WS_XU) + (size_t)ug * 256 * 384;
        pg8::SchedOne S; S.u0.pm = 0; S.u0.pn = 0; S.u0.tag = 0; S.u0.A = (const char*)xu; S.u0.B = (const char*)(wsp<bf16_t>(P, WS_TW) + (size_t)(layer * NG + g) * 256 * 384);
        EpiSsm2 E{wsp<bf16_t>(P, WS_YS), b, g};
        pg8::gemm_phase<EpiSsm2, pg8::SchedOne, false, true>(lds, 384, 384, 384, S, E, (const char*)P.ws, P.tid);
        __syncthreads();
    }
}
__device__ __forceinline__ void ph_zpw(const PA a) { PH_HEAD
    SchedZPW S; S.o.init(T / 256, D / 256, G, c); S.ys = (const char*)wsp<bf16_t>(P, WS_YS); S.uc = (const char*)wsp<bf16_t>(P, WS_UC);
    S.wglu = (const char*)(wsp<bf16_t>(P, WS_WGLU) + (size_t)layer * 2 * D * SW); S.wpw = (const char*)(wsp<bf16_t>(P, WS_WPW) + (size_t)layer * D * CW);
    EpiZPW E{EpiZ{wsp<bf16_t>(P, WS_GATES), wsp<bf16_t>(P, WS_MB)}, EpiPw{wsp<bf16_t>(P, WS_GATES), wsp<bf16_t>(P, WS_MB), wsp<bf16_t>(P, WS_MERGED)}};
    pg8::gemm_phase<EpiZPW, SchedZPW, true, true>(lds, SW, SW, SW, S, E, (const char*)P.ws, P.tid);
}
template <bool H8OUT> __device__ __forceinline__ void ph_res_out(const PA a) { PH_HEAD
    constexpr bool F8 = F8_OUT != 0; constexpr int ES = F8 ? 1 : 2;
    pg8::SchedStd S; S.o.init(T / 256, D / 256, G, c); S.A = (const char*)wsp<bf16_t>(P, WS_MERGED); S.B = (const char*)(wsp<bf16_t>(P, WS_WOUT) + (size_t)layer * D * D); S.sA = (size_t)256 * D * ES; S.sB = (size_t)256 * D * ES;
    EpiRes<H8OUT, F8> E{H_, ST_B, H_, wsp<unsigned char>(P, WS_H8), lds};
    pg8::gemm_phase<EpiRes<H8OUT, F8>, pg8::SchedStd, true, true, F8>(lds, D, D, D, S, E, (const char*)P.ws, P.tid);
}
template <bool H8OUT> __device__ __forceinline__ void ph_res_o(const PA a) { PH_HEAD
    constexpr bool F8 = F8_QO != 0; constexpr int ES = F8 ? 1 : 2;
    pg8::SchedStd S; S.o.init(T / 256, D / 256, G, c); S.A = (const char*)wsp<bf16_t>(P, WS_AO); S.B = (const char*)(wsp<bf16_t>(P, WS_WO) + (size_t)layer * D * D); S.sA = (size_t)256 * D * ES; S.sB = (size_t)256 * D * ES;
    EpiRes<H8OUT, F8> E{H_, ST_C, H_, wsp<unsigned char>(P, WS_H8), lds};
    pg8::gemm_phase<EpiRes<H8OUT, F8>, pg8::SchedStd, true, true, F8>(lds, D, D, D, S, E, (const char*)P.ws, P.tid);
}
struct SchedQ {
    int G, c; const char* h; const char* wq; int es;
    __device__ __forceinline__ bool next(int i, Unit& u) const { const int L = i * G + c; if (L >= BATCH * HEADS * (SEQ / 256)) return false; const int bh = L & 31, qt = L >> 5, b = bh >> 2, hd = bh & 3;
        u.pm = b * 16 + qt; u.pn = hd; u.tag = 0; u.A = h + (size_t)u.pm * 256 * D * es; u.B = wq + (size_t)hd * 256 * D * es; return true; }
    __device__ __forceinline__ void a_ready(const Unit&) const {}
    __device__ __forceinline__ void done(const Unit&) const {}
};
__device__ __forceinline__ void ph_q(const PA a) { PH_HEAD
    constexpr bool F8 = F8_QO != 0;
    SchedQ S{G, c, F8 ? (const char*)wsp<unsigned char>(P, WS_H8) : (const char*)H_, (const char*)(wsp<bf16_t>(P, WS_WQ) + (size_t)layer * D * D), F8 ? 1 : 2};
    EpiQ E{ST_B, wsp<bf16_t>(P, WS_Q), F8 ? 1.0f / F8_WQ_SCALE : 1.0f};
    pg8::gemm_phase<EpiQ, SchedQ, true, true, F8>(lds, D, D, D, S, E, (const char*)P.ws, P.tid);
    VM_WAIT(); __syncthreads();
}
__device__ __forceinline__ void ph_attn(const PA a) { PH_HEAD attn_phase(P, layer); }
template <bool F8> __device__ __forceinline__ void ph_fgu(const PA a) { PH_HEAD
    constexpr int ES = F8 ? 1 : 2;
    pg8::SchedStd S; S.o.init(T / 256, 2 * DFF / 256, G, c); S.A = F8 ? (const char*)wsp<unsigned char>(P, WS_H8) : (const char*)H_; S.B = (const char*)(wsp<bf16_t>(P, WS_WFGU) + (size_t)jj * 2 * DFF * D); S.sA = (size_t)256 * D * ES; S.sB = (size_t)256 * D * ES;
    EpiGU<false, F8> E{ST_C, nullptr, wsp<bf16_t>(P, WS_ACT), DFF};
    pg8::gemm_phase<EpiGU<false, F8>, pg8::SchedStd, true, true, F8>(lds, D, D, D, S, E, (const char*)P.ws, P.tid);
}
template <bool F8> __device__ __forceinline__ void ph_fdown(const PA a, const bool dry = false) { PH_HEAD
    constexpr int ES = F8 ? 1 : 2;
    pg8::SchedStd S; S.o.init(T / 256, D / 256, G, c); S.A = (const char*)wsp<bf16_t>(P, WS_ACT); S.B = (const char*)(wsp<bf16_t>(P, WS_WFD) + (size_t)jj * D * DFF); S.sA = (size_t)256 * DFF * ES; S.sB = (size_t)256 * DFF * ES;
    EpiRes<(F8_GATES != 0), F8> E{H_, dry ? wsp<float>(P, WS_UCONV) : ST_A, dry ? wsp<bf16_t>(P, WS_Q) : H_, wsp<unsigned char>(P, WS_H8), lds};
    pg8::gemm_phase<EpiRes<(F8_GATES != 0), F8>, pg8::SchedStd, true, true, F8>(lds, DFF, DFF, DFF, S, E, (const char*)P.ws, P.tid);
}
__device__ __forceinline__ void ph_router(const PA a) { PH_HEAD router_phase(P, layer, jj); }
template <bool F8> __device__ __forceinline__ void ph_assign(const PA a) { PH_HEAD assign_phase<F8>(P); }
template <bool F8> __device__ __forceinline__ void ph_mgu(const PA a) { PH_HEAD
    constexpr int ES = F8 ? 1 : 2;
    const int ptot = (int)__hip_atomic_load((unsigned*)(P.ws + WS_CTL) + CW_PTOTAL, __ATOMIC_RELAXED, __HIP_MEMORY_SCOPE_AGENT);
    SchedMoe S; S.o.init(__builtin_amdgcn_readfirstlane(ptot), 2 * DFE / 256, G, c); S.A = (const char*)wsp<bf16_t>(P, WS_HS); S.B = (const char*)(wsp<bf16_t>(P, WS_WMGU) + (size_t)jj * NE * 2 * DFE * D);
    S.sA = (size_t)256 * D * ES; S.sB = (size_t)256 * D * ES; S.sE = (size_t)2 * DFE * D * ES; S.load_bases((const unsigned*)(P.ws + WS_CTL));
    EpiGU<true, F8> E{(const float*)(P.ws + WS_META + MT_RSCALE), (const float*)(P.ws + WS_META + MT_GWT), wsp<bf16_t>(P, WS_ACT), DFE};
    pg8::gemm_phase<EpiGU<true, F8>, SchedMoe, true, true, F8>(lds, D, D, D, S, E, (const char*)P.ws, P.tid);
}
template <bool F8> __device__ __forceinline__ void ph_mdown(const PA a) { PH_HEAD
    constexpr int ES = F8 ? 1 : 2;
    const int ptot = (int)__hip_atomic_load((unsigned*)(P.ws + WS_CTL) + CW_PTOTAL, __ATOMIC_RELAXED, __HIP_MEMORY_SCOPE_AGENT);
    static_assert(!F8 || DFE * ES / 128 == 28, "the K-split of the tail panels is laid out for 28 K-tiles (the bf16 instantiation is never run: F8_MOE_MASK covers both MoE layers)");
    SchedMoeD S; S.o.init(MOE_FULL_PANELS, D / 256, G, c); S.ptot = __builtin_amdgcn_readfirstlane(ptot); S.A = (const char*)wsp<bf16_t>(P, WS_ACT); S.B = (const char*)(wsp<bf16_t>(P, WS_WMD) + (size_t)jj * NE * D * DFE);
    S.sA = (size_t)256 * DFE * ES; S.sB = (size_t)256 * DFE * ES; S.sE = (size_t)D * DFE * ES; S.load_bases((const unsigned*)(P.ws + WS_CTL));
    EpiDown E{wsp<bf16_t>(P, WS_YE), wsp<float>(P, WS_MPART), F8 ? 1.0f / (F8_WD_SCALE * F8_ACT_SCALE) : 1.0f};
    pg8::gemm_phase<EpiDown, SchedMoeD, true, true, F8>(lds, DFE, DFE, DFE, S, E, (const char*)P.ws, P.tid);
}
__device__ __forceinline__ void ph_combine(const PA a) { PH_HEAD combine_phase(P, layer == DEPTH - 1); }

__global__ void __launch_bounds__(512, 2) fwd(Args args) {
    LAS unsigned char* lds = (LAS unsigned char*)lds_raw;
    volatile LAS unsigned* MISC = (volatile LAS unsigned*)(lds + LDS_MISC);
    if (threadIdx.x < 64) MISC[threadIdx.x] = 0u;
    __syncthreads();
    const int lo = args.ph_lo, hi = args.ph_hi;
    unsigned* barw = (unsigned*)(args.ws + WS_CTL) + CW_BAR;
    XcdBarrier bar; bar.bar = barw; bar.x = 0; bar.st = MISC + 8;
    if (hi - lo > 1) bar = xcd_barrier_post(barw, MISC + 8);
#ifndef PROBE_DUP
#define PROBE_DUP 0
#endif
#define DUPB(b) ((PROBE_DUP >> (b)) & 1)
#define IN(k) (lo <= (k) && (k) < hi)
#define SEAM(k) do { if (IN(k) && IN((k) + 1)) { if ((k) < PH_LAYER0 + 3 * NPH_LAYER - 1) { const Frame BF_ = mkframe(a); xcd_barrier_bg(bar, BF_); } else { const Frame BF_ = mkframe(a); xcd_barrier(bar, BF_.tid); } } } while (0)
#define SEAMX(k, kn) do { if (IN(k) && IN(kn)) { if ((k) < PH_LAYER0 + 3 * NPH_LAYER - 1) { const Frame BF_ = mkframe(a); xcd_barrier_bg(bar, BF_); } else { const Frame BF_ = mkframe(a); xcd_barrier(bar, BF_.tid); } } } while (0)
    PA a; a.ws = args.ws; a.in = args.in; a.out = args.out; a.layer = 0; a.wave = __builtin_amdgcn_readfirstlane((int)(threadIdx.x >> 6));
    if (IN(0)) { ph_prologue(a); if (DUPB(0)) ph_prologue(a); } SEAMX(0, 2);
#define LAYER_BODY(LYR) { \
        constexpr int layer = (LYR), pb = PH_LAYER0 + layer * NPH_LAYER; a.layer = layer; \
        if (IN(pb + 0)) { if (layer == 0) ph_kv(a); ph_inproj(a); if (F8_GATES) ph_inproj_gates(a); } SEAM(pb + 0); \
        if (IN(pb + 1)) { ph_conv(a); ph_ssm1(a); ph_ssm2(a); if (DUPB(3)) { ph_conv(a); ph_ssm1(a); ph_ssm2(a); } if (DUPB(11)) ph_conv(a); if (DUPB(12)) { ph_ssm1(a); ph_ssm2(a); } if (DUPB(13)) ph_ssm1(a); } SEAM(pb + 1); \
        if (IN(pb + 2)) { ph_zpw(a); if (DUPB(4)) ph_zpw(a); } SEAMX(pb + 2, pb + 4); \
        if (IN(pb + 4)) { ph_res_out<(F8_QO != 0)>(a); } SEAM(pb + 4); \
        if (IN(pb + 5)) { ph_q(a); ph_attn(a); if (DUPB(5)) { ph_q(a); ph_attn(a); } } SEAMX(pb + 5, pb + 7); \
        if (IN(pb + 7)) { ph_res_o<F8_DENSE(layer)>(a); } SEAM(pb + 7); \
        if ((layer & 1) == 0) { \
            if (IN(pb + 8)) { ph_fgu<F8_DENSE(layer)>(a); } SEAM(pb + 8); \
            if (IN(pb + 9)) { ph_fdown<F8_DENSE(layer)>(a); if (layer < DEPTH - 1) { const Frame DF_ = mkframe(a); bg_drain(DF_, layer); } } do { if (IN(pb + 9) && IN(pb + 13)) { if ((pb + 12) < PH_LAYER0 + 3 * NPH_LAYER - 1) { const Frame BF_ = mkframe(a); xcd_barrier_bg(bar, BF_); } else { const Frame BF_ = mkframe(a); xcd_barrier(bar, BF_.tid); } } } while (0); \
        } else { \
            if (IN(pb + 8)) { ph_router(a); if (DUPB(8)) ph_router(a); } SEAM(pb + 8); \
            if (IN(pb + 9)) { ph_assign<F8_MOE(layer)>(a); } SEAM(pb + 9); \
            if (IN(pb + 10)) { ph_mgu<F8_MOE(layer)>(a); } SEAM(pb + 10); \
            if (IN(pb + 11)) { ph_mdown<F8_MOE(layer)>(a); } SEAM(pb + 11); \
            if (IN(pb + 12)) { ph_combine(a); if (layer < DEPTH - 1) { const Frame DF_ = mkframe(a); bg_drain(DF_, layer); } } SEAM(pb + 12); \
        } }
    LAYER_BODY(0) LAYER_BODY(1) LAYER_BODY(2) LAYER_BODY(3)
#undef LAYER_BODY
#undef IN
#undef SEAM
#undef SEAMX
}

extern "C" void kernel_launch(void* const* d_in, const int* in_sizes, int n_in, void* d_out, int out_size, void* d_ws, size_t ws_size, hipStream_t stream) {
    static int grid = 0;
    if (grid == 0) {
        if (n_in != 32 || out_size != T * D || ws_size < WS_END) { fprintf(stderr, "kernel_launch: unexpected problem (n_in %d out %d ws %zu need %zu)\n", n_in, out_size, ws_size, (size_t)WS_END); grid = -1; return; }
        int dev = 0, cus = 0, per_cu = 0;
        if (hipGetDevice(&dev) != hipSuccess || hipDeviceGetAttribute(&cus, hipDeviceAttributeMultiprocessorCount, dev) != hipSuccess) { grid = -1; return; }
        if (hipFuncSetAttribute((const void*)fwd, hipFuncAttributeMaxDynamicSharedMemorySize, LDS_BYTES) != hipSuccess) { fprintf(stderr, "kernel_launch: hipFuncSetAttribute failed\n"); grid = -1; return; }
        if (hipOccupancyMaxActiveBlocksPerMultiprocessor(&per_cu, (const void*)fwd, 512, LDS_BYTES) != hipSuccess || per_cu < 1) { fprintf(stderr, "kernel_launch: occupancy query says %d\n", per_cu); }
        (void)hipGetLastError();
        grid = cus < 256 ? cus : 256;
    }
    if (grid < 0) return;
    if (hipMemsetAsync((char*)d_ws + WS_CTL, 0, CTL_BYTES, stream) != hipSuccess) return;
    Args a{};
    for (int i = 0; i < 32; ++i) a.in[i] = (const float*)d_in[i];
    a.out = (float*)d_out; a.ws = (unsigned char*)d_ws;
#if MK_ONE_LAUNCH
    a.ph_lo = 0; a.ph_hi = NPHASES;
    hipLaunchKernelGGL(fwd, dim3(grid), dim3(512), LDS_BYTES, stream, a);
#else
    for (int p = 0; p < NPHASES; ++p) {
        if (p >= PH_LAYER0) { const int layer = (p - PH_LAYER0) / NPH_LAYER, k = (p - PH_LAYER0) % NPH_LAYER; if ((layer & 1) == 0 && k >= 10) continue; }
        a.ph_lo = p; a.ph_hi = p + 1;
        hipLaunchKernelGGL(fwd, dim3(grid), dim3(512), LDS_BYTES, stream, a);
    }
#endif
}
```

```cpp
#include <hip/hip_runtime.h>
#include <cstdio>
#include <cstdint>

#ifndef MK_ONE_LAUNCH
#define MK_ONE_LAUNCH 1
#endif

#define GAS __attribute__((address_space(1)))
#define LAS __attribute__((address_space(3)))
typedef unsigned short bf16_t;
typedef short bf16x8 __attribute__((ext_vector_type(8)));
typedef float f32x4 __attribute__((ext_vector_type(4)));
typedef float f32x2 __attribute__((ext_vector_type(2)));
typedef float f32x16 __attribute__((ext_vector_type(16)));
typedef unsigned u32x4 __attribute__((ext_vector_type(4)));
typedef unsigned u32x2 __attribute__((ext_vector_type(2)));
typedef __bf16 bf2_t __attribute__((ext_vector_type(2)));

constexpr int D = 1024, BATCH = 8, SEQ = 4096, T = BATCH * SEQ, DEPTH = 4, MEM = 256, NMEM = BATCH * MEM;
constexpr int CW = 512, CK = 31, SW = 512, SG = 16, NG = 32, SP = 64, HEADS = 4, HD = 256;
constexpr int DFF = 2816, NE = 8, DFE = 3584, INC = 3584;
constexpr int NSLOT = 2 * T + NE * 256;
constexpr float RMS_EPS = 1e-6f, LN_EPS = 1e-5f;

constexpr size_t MiB = 1u << 20;
constexpr size_t WS_CTL = 0, CTL_BYTES = 1 * MiB;
constexpr size_t WS_A16 = 1 * MiB;
constexpr size_t WS_META = 2 * MiB;
constexpr size_t WS_STATS = 4 * MiB;
constexpr size_t WS_MEMN = 10 * MiB, WS_KMAT = 14 * MiB, WS_VT = 30 * MiB, WS_H = 46 * MiB;
constexpr size_t WS_WIN = 110 * MiB, WS_WPW = 138 * MiB, WS_WGLU = 142 * MiB, WS_WOUT = 150 * MiB, WS_WQ = 158 * MiB, WS_WKV = 166 * MiB, WS_WO = 182 * MiB;
constexpr size_t WS_WFGU = 190 * MiB, WS_WFD = 212 * MiB, WS_WMGU = 224 * MiB, WS_WMD = 448 * MiB, WS_WST = 560 * MiB, WS_TW = 576 * MiB;
constexpr size_t WS_R = 600 * MiB;
constexpr size_t WS_UCONV = WS_R, WS_XU = WS_R + 32 * MiB, WS_GATES = WS_R + 80 * MiB, WS_UC = WS_R + 208 * MiB, WS_YS = WS_R + 240 * MiB;
constexpr size_t WS_MB = WS_R + 272 * MiB, WS_MERGED = WS_R + 336 * MiB, WS_Q = WS_R + 400 * MiB, WS_AO = WS_R + 464 * MiB;
constexpr size_t WS_H8 = WS_R + 300 * MiB;
constexpr size_t WS_ACT = WS_R, WS_HS = WS_R + 462 * MiB, WS_YE = WS_R + 594 * MiB, WS_END = WS_R + 726 * MiB;
constexpr size_t WS_MPART = WS_R + 530 * MiB;
static_assert((size_t)NSLOT * DFE * 2 <= 462 * MiB && (size_t)NSLOT * D * 2 <= 132 * MiB, "moe buffers");
constexpr size_t MT_TOKE = 0, MT_TOKW = 128 * 1024, MT_TOKR = 384 * 1024, MT_TOKSLOT = 512 * 1024, MT_RSCALE = 768 * 1024, MT_GWT = 1088 * 1024, MT_WGCNT = 1408 * 1024, MT_PEXP = 1424 * 1024;
constexpr int CW_PTOTAL = 16, CW_PBASE = 32;
constexpr int CW_BAR = 4096;

constexpr int LDS_AUX = 131072;
constexpr int LDS_MISC = 131072 + 8192;
constexpr int LDS_BYTES = 147456;

#ifndef F8_MOE_MASK
#define F8_MOE_MASK 0xA
#endif
#define F8_MOE(l) (((F8_MOE_MASK >> (l)) & 1) != 0)
#ifndef F8_QO
#define F8_QO 1
#endif
#ifndef F8_Z
#define F8_Z 1
#endif
constexpr float F8_YS_SCALE = 8.f, F8_WGLU_SCALE = 32.f;
#ifndef F8_IN_S
#define F8_IN_S 1
#endif
#ifndef F8_GATES
#define F8_GATES 1
#endif
#ifndef F8_DENSE_MASK
#define F8_DENSE_MASK 0x4
#endif
#define F8_DENSE(l) (((F8_DENSE_MASK >> (l)) & 1) != 0)
__device__ __forceinline__ unsigned pk2(float lo, float hi) { f32x2 v = {lo, hi}; bf2_t r = __builtin_convertvector(v, bf2_t); return __builtin_bit_cast(unsigned, r); }
__device__ __forceinline__ float bflo(unsigned u) { return __uint_as_float(u << 16); }
__device__ __forceinline__ float bfhi(unsigned u) { return __uint_as_float(u & 0xffff0000u); }
__device__ __forceinline__ float fast_rcp(float x) { return __builtin_amdgcn_rcpf(x); }
__device__ __forceinline__ float fast_exp2(float x) { return __builtin_amdgcn_exp2f(x); }
__device__ __forceinline__ float sigmoidf_(float x) { return fast_rcp(1.0f + fast_exp2(-1.44269504f * x)); }
__device__ __forceinline__ float siluf_(float x) { return x * sigmoidf_(x); }
__device__ __forceinline__ float gelu_tanh_(float x) { const float z = 0.7978845608f * (x + 0.044715f * x * x * x); return x * fast_rcp(1.0f + fast_exp2(-2.88539008f * z)); }
__device__ __forceinline__ float wave_sum(float v) {
#pragma unroll
    for (int o = 1; o < 64; o <<= 1) v += __shfl_xor(v, o);
    return v;
}
__device__ __forceinline__ float row_rstd(const float* stats, int row) {
    const f32x4 a = *(const f32x4*)(stats + (size_t)row * 4);
    return __builtin_amdgcn_rsqf(((a[0] + a[1]) + (a[2] + a[3])) * (1.0f / D) + RMS_EPS);
}
__device__ __forceinline__ unsigned pk4_fp8(float a, float b, float c, float d) { int w = 0; w = __builtin_amdgcn_cvt_pk_fp8_f32(a, b, w, false); w = __builtin_amdgcn_cvt_pk_fp8_f32(c, d, w, true); return (unsigned)w; }
constexpr float F8_WGU_SCALE = 32.f, F8_WD_SCALE = 64.f, F8_ACT_SCALE = 4.f, F8_WQ_SCALE = 512.f, F8_WO_SCALE = 32.f, F8_AO_SCALE = 8.f;
#define LDS_WAIT() asm volatile("s_waitcnt lgkmcnt(0)" ::: "memory")
#define VM_WAIT() asm volatile("s_waitcnt vmcnt(0)" ::: "memory")

namespace pg8 {
constexpr int BM = 256, BK = 64, HALF = 128, HTB = HALF * BK * 2, STAGE_BYTES = 8 * HTB, NXCD = 8, WGM = 4;
__host__ __device__ __forceinline__ int lds_byte(int r, int c) { const int st = (r >> 4) * 2 + (c >> 5), rr = r & 15, cc = c & 31, ob = rr * 64 + cc * 2; return st * 1024 + (ob ^ (((ob >> 9) & 1) << 5)); }
__host__ __device__ __forceinline__ void stage_rc(int b, int& R, int& C) { const int st = b / 1024, sb = b % 1024, swz = sb ^ (((sb >> 9) & 1) << 5); R = (st >> 1) * 16 + swz / 64; C = (st & 1) * 32 + (swz % 64) / 2; }
__host__ __device__ __forceinline__ int perm32(int rho) { const int n = rho >> 4, i = rho & 15; return 8 * (i >> 2) + 4 * n + (i & 3); }

struct Unit { int pm, pn, tag; const char* A; const char* B; };

struct StaticOrder {
    int nM, nN, nwg, G, c;
    __device__ __forceinline__ void init(int nM_, int nN_, int G_, int c_) { nM = nM_; nN = nN_; nwg = nM * nN; G = G_; c = c_; }
    __device__ __forceinline__ bool next(int i, int& pm, int& pn) const {
        const long L = (long)i * G + c; if (L >= nwg) return false;
        int wgid = (int)L; { const int q = nwg / NXCD, r = nwg % NXCD, xcd = wgid % NXCD, off = wgid / NXCD; wgid = (xcd < r ? xcd * (q + 1) : r * (q + 1) + (xcd - r) * q) + off; }
        const int nig = WGM * nN, gid = wgid / nig, fm = gid * WGM, gsz = (nM - fm) < WGM ? (nM - fm) : WGM;
        pm = fm + ((wgid % nig) % gsz); pn = (wgid % nig) / gsz; return true;
    }
};
struct SchedStd {
    StaticOrder o; const char* A; const char* B; size_t sA, sB;
    __device__ __forceinline__ bool next(int i, Unit& u) const { int pm, pn; if (!o.next(i, pm, pn)) return false; u.pm = pm; u.pn = pn; u.tag = 0; u.A = A + (size_t)pm * sA; u.B = B + (size_t)pn * sB; return true; }
    __device__ __forceinline__ void a_ready(const Unit&) const {}
    __device__ __forceinline__ void done(const Unit&) const {}
};
struct SchedOne {
    Unit u0;
    __device__ __forceinline__ bool next(int i, Unit& u) const { if (i) return false; u = u0; return true; }
    __device__ __forceinline__ void a_ready(const Unit&) const {}
    __device__ __forceinline__ void done(const Unit&) const {}
};

template <class S_> struct SchedVarK { static constexpr bool v = false; };
template <class Epi, class Sched, bool ALIGN_EPI, bool SP2, bool F8 = false>
__device__ __forceinline__ void gemm_phase(LAS unsigned char* lds, const int K, const int lda, const int ldb, const Sched& S, const Epi& E, const char* wsb, const int tid_in) {
    int tid_ = tid_in; asm volatile("" : "+v"(tid_));
    const int tid = tid_, wid = __builtin_amdgcn_readfirstlane(tid >> 6), lane = tid & 63, wr = wid >> 2, wc = wid & 3, fr = lane & 15, fq = lane >> 4;
    constexpr int ES = F8 ? 1 : 2;
    const int nt = K * ES / (BK * 2);
    unsigned voffA[2], voffB[2];
#pragma unroll
    for (int i = 0; i < 2; ++i) { int R, C; stage_rc(tid * 16 + i * 8192, R, C); const int Rb = Epi::PERM ? ((R & ~31) + perm32(R & 31)) : R;
        voffA[i] = (unsigned)(R * lda * ES + C * 2); voffB[i] = (unsigned)(Rb * ldb * ES + C * 2); }
    const unsigned kstep = (unsigned)(BK * 2);
    const unsigned hstepA = (unsigned)(HALF * lda * ES), hstepB = (unsigned)(HALF * ldb * ES);
    const __amdgpu_buffer_rsrc_t rs = __builtin_amdgcn_make_buffer_rsrc((void*)wsb, (short)0, 0x7fffffff, 0x00020000);
    const unsigned ldsw = (unsigned)wid * 1024u;
    const int aoff = lds_byte(wr * 64 + fr, fq * 8), boff = lds_byte(wc * 32 + fr, fq * 8);
#define PG8_SA(b, h) (((b) * 2 + (h)) * HTB)
#define PG8_SB(b, h) ((4 + (b) * 2 + (h)) * HTB)
#define PG8_STAGE(bufoff, goff, voff) do { _Pragma("unroll") for (int _i = 0; _i < 2; ++_i) \
        __builtin_amdgcn_raw_ptr_buffer_load_lds(rs, (LAS unsigned*)(lds + (bufoff) + ldsw + _i * 8192), 16, (voff)[_i], (int)(goff), 0, 0); } while (0)
#define PG8_LD16(off) (*(const LAS bf16x8*)(lds + (off)))
#define PG8_CAT(x, y) __builtin_shufflevector(__builtin_bit_cast(i32x4_, (x)), __builtin_bit_cast(i32x4_, (y)), 0, 1, 2, 3, 4, 5, 6, 7)
#define PG8_LDA(dst, b, h) do { _Pragma("unroll") for (int m = 0; m < 4; ++m) { if constexpr (F8) dst##8[m] = PG8_CAT(PG8_LD16(PG8_SA(b, h) + aoff + m * 2048), PG8_LD16(PG8_SA(b, h) + aoff + m * 2048 + 1024)); \
        else { _Pragma("unroll") for (int k = 0; k < 2; ++k) dst[m][k] = PG8_LD16(PG8_SA(b, h) + aoff + m * 2048 + k * 1024); } } } while (0)
#define PG8_LDB(dst, b, h) do { _Pragma("unroll") for (int n = 0; n < 2; ++n) { if constexpr (F8) dst##8[n] = PG8_CAT(PG8_LD16(PG8_SB(b, h) + boff + n * 2048), PG8_LD16(PG8_SB(b, h) + boff + n * 2048 + 1024)); \
        else { _Pragma("unroll") for (int k = 0; k < 2; ++k) dst[n][k] = PG8_LD16(PG8_SB(b, h) + boff + n * 2048 + k * 1024); } } } while (0)
#define PG8_MMA_ASM8(C0, C1, C2, C3, C4, C5, C6, C7, OUTC) \
            asm volatile("s_nop 1\n\t" \
                "v_mfma_f32_16x16x128_f8f6f4 %0, %8, %10, " C0 "\n\tv_mfma_f32_16x16x128_f8f6f4 %1, %9, %10, " C1 "\n\t" \
                "v_mfma_f32_16x16x128_f8f6f4 %2, %8, %11, " C2 "\n\tv_mfma_f32_16x16x128_f8f6f4 %3, %9, %11, " C3 "\n\t" \
                "v_mfma_f32_16x16x128_f8f6f4 %4, %8, %12, " C4 "\n\tv_mfma_f32_16x16x128_f8f6f4 %5, %9, %12, " C5 "\n\t" \
                "v_mfma_f32_16x16x128_f8f6f4 %6, %8, %13, " C6 "\n\tv_mfma_f32_16x16x128_f8f6f4 %7, %9, %13, " C7
#define PG8_MMA(ai, bj, Af, Bf, Z) do { __builtin_amdgcn_s_setprio(1); \
        if constexpr (F8) {   \
            if (Z) { PG8_MMA_ASM8("0", "0", "0", "0", "0", "0", "0", "0", 0) \
                : "=&v"(acc[ai][bj][0][0]), "=&v"(acc[ai][bj][0][1]), "=&v"(acc[ai][bj][1][0]), "=&v"(acc[ai][bj][1][1]), "=&v"(acc[ai][bj][2][0]), "=&v"(acc[ai][bj][2][1]), "=&v"(acc[ai][bj][3][0]), "=&v"(acc[ai][bj][3][1]) \
                : "v"(Bf##8[0]), "v"(Bf##8[1]), "v"(Af##8[0]), "v"(Af##8[1]), "v"(Af##8[2]), "v"(Af##8[3])); } \
            else { PG8_MMA_ASM8("%0", "%1", "%2", "%3", "%4", "%5", "%6", "%7", 1) \
                : "+v"(acc[ai][bj][0][0]), "+v"(acc[ai][bj][0][1]), "+v"(acc[ai][bj][1][0]), "+v"(acc[ai][bj][1][1]), "+v"(acc[ai][bj][2][0]), "+v"(acc[ai][bj][2][1]), "+v"(acc[ai][bj][3][0]), "+v"(acc[ai][bj][3][1]) \
                : "v"(Bf##8[0]), "v"(Bf##8[1]), "v"(Af##8[0]), "v"(Af##8[1]), "v"(Af##8[2]), "v"(Af##8[3])); } } \
        else {   \
            if (Z) { asm volatile("s_nop 1\n\t" \
                "v_mfma_f32_16x16x32_bf16 %0, %8, %12, 0\n\t" \
                "v_mfma_f32_16x16x32_bf16 %1, %9, %12, 0\n\t" \
                "v_mfma_f32_16x16x32_bf16 %2, %8, %13, 0\n\t" \
                "v_mfma_f32_16x16x32_bf16 %3, %9, %13, 0\n\t" \
                "v_mfma_f32_16x16x32_bf16 %4, %8, %14, 0\n\t" \
                "v_mfma_f32_16x16x32_bf16 %5, %9, %14, 0\n\t" \
                "v_mfma_f32_16x16x32_bf16 %6, %8, %15, 0\n\t" \
                "v_mfma_f32_16x16x32_bf16 %7, %9, %15, 0\n\t" \
                "v_mfma_f32_16x16x32_bf16 %0, %10, %16, %0\n\t" \
                "v_mfma_f32_16x16x32_bf16 %1, %11, %16, %1\n\t" \
                "v_mfma_f32_16x16x32_bf16 %2, %10, %17, %2\n\t" \
                "v_mfma_f32_16x16x32_bf16 %3, %11, %17, %3\n\t" \
                "v_mfma_f32_16x16x32_bf16 %4, %10, %18, %4\n\t" \
                "v_mfma_f32_16x16x32_bf16 %5, %11, %18, %5\n\t" \
                "v_mfma_f32_16x16x32_bf16 %6, %10, %19, %6\n\t" \
                "v_mfma_f32_16x16x32_bf16 %7, %11, %19, %7" \
                : "=&v"(acc[ai][bj][0][0]), "=&v"(acc[ai][bj][0][1]), "=&v"(acc[ai][bj][1][0]), "=&v"(acc[ai][bj][1][1]), "=&v"(acc[ai][bj][2][0]), "=&v"(acc[ai][bj][2][1]), "=&v"(acc[ai][bj][3][0]), "=&v"(acc[ai][bj][3][1]) \
                : "v"(Bf[0][0]), "v"(Bf[1][0]), "v"(Bf[0][1]), "v"(Bf[1][1]), "v"(Af[0][0]), "v"(Af[1][0]), "v"(Af[2][0]), "v"(Af[3][0]), "v"(Af[0][1]), "v"(Af[1][1]), "v"(Af[2][1]), "v"(Af[3][1])); } \
            else { asm volatile("s_nop 1\n\t" \
                "v_mfma_f32_16x16x32_bf16 %0, %8, %12, %0\n\t" \
                "v_mfma_f32_16x16x32_bf16 %1, %9, %12, %1\n\t" \
                "v_mfma_f32_16x16x32_bf16 %2, %8, %13, %2\n\t" \
                "v_mfma_f32_16x16x32_bf16 %3, %9, %13, %3\n\t" \
                "v_mfma_f32_16x16x32_bf16 %4, %8, %14, %4\n\t" \
                "v_mfma_f32_16x16x32_bf16 %5, %9, %14, %5\n\t" \
                "v_mfma_f32_16x16x32_bf16 %6, %8, %15, %6\n\t" \
                "v_mfma_f32_16x16x32_bf16 %7, %9, %15, %7\n\t" \
                "v_mfma_f32_16x16x32_bf16 %0, %10, %16, %0\n\t" \
                "v_mfma_f32_16x16x32_bf16 %1, %11, %16, %1\n\t" \
                "v_mfma_f32_16x16x32_bf16 %2, %10, %17, %2\n\t" \
                "v_mfma_f32_16x16x32_bf16 %3, %11, %17, %3\n\t" \
                "v_mfma_f32_16x16x32_bf16 %4, %10, %18, %4\n\t" \
                "v_mfma_f32_16x16x32_bf16 %5, %11, %18, %5\n\t" \
                "v_mfma_f32_16x16x32_bf16 %6, %10, %19, %6\n\t" \
                "v_mfma_f32_16x16x32_bf16 %7, %11, %19, %7" \
                : "+v"(acc[ai][bj][0][0]), "+v"(acc[ai][bj][0][1]), "+v"(acc[ai][bj][1][0]), "+v"(acc[ai][bj][1][1]), "+v"(acc[ai][bj][2][0]), "+v"(acc[ai][bj][2][1]), "+v"(acc[ai][bj][3][0]), "+v"(acc[ai][bj][3][1]) \
                : "v"(Bf[0][0]), "v"(Bf[1][0]), "v"(Bf[0][1]), "v"(Bf[1][1]), "v"(Af[0][0]), "v"(Af[1][0]), "v"(Af[2][0]), "v"(Af[3][0]), "v"(Af[0][1]), "v"(Af[1][1]), "v"(Af[2][1]), "v"(Af[3][1])); } } \
        __builtin_amdgcn_s_setprio(0); } while (0)
#define PG8_WAIT_V(n) asm volatile("s_waitcnt vmcnt(" #n ")" ::: "memory")
#define PG8_WAIT_L(n) asm volatile("s_waitcnt lgkmcnt(" #n ")" ::: "memory")
#define PG8_BAR __builtin_amdgcn_s_barrier()
#define PG8_SCHED __builtin_amdgcn_sched_barrier(0)
    Unit cur, nxt; int ui = 0;
    if (!S.next(0, cur)) return;
    f32x4 acc[2][2][4][2];
    typedef int i32x4_ __attribute__((ext_vector_type(4))); typedef int i32x8_ __attribute__((ext_vector_type(8)));
    bf16x8 At[4][2], B0[2][2], B1[2][2]; i32x8_ At8[4], B08[2], B18[2];
    unsigned cA = (unsigned)(cur.A - wsb), cB = (unsigned)(cur.B - wsb);
    int ntc = nt; if constexpr (SchedVarK<Sched>::v) ntc = S.nt_of(cur, nt);
    S.a_ready(cur);
    if constexpr (SP2) {
        PG8_STAGE(PG8_SB(0, 0), cB, voffB); PG8_STAGE(PG8_SB(0, 1), cB + hstepB, voffB); PG8_STAGE(PG8_SA(0, 0), cA, voffA); PG8_STAGE(PG8_SA(0, 1), cA + hstepA, voffA);
        if (wr == 1) PG8_BAR;
        PG8_WAIT_V(2); PG8_BAR;
        PG8_STAGE(PG8_SB(1, 0), cB + kstep, voffB); PG8_STAGE(PG8_SA(1, 0), cA + kstep, voffA); PG8_STAGE(PG8_SB(1, 1), cB + hstepB + kstep, voffB);
        PG8_WAIT_V(6); PG8_BAR;
    } else {
        PG8_STAGE(PG8_SB(0, 0), cB, voffB); PG8_STAGE(PG8_SA(0, 0), cA, voffA); PG8_STAGE(PG8_SB(0, 1), cB + hstepB, voffB); PG8_STAGE(PG8_SA(0, 1), cA + hstepA, voffA);
        if (wr == 1) PG8_BAR;
        PG8_WAIT_V(4); PG8_BAR;
        PG8_STAGE(PG8_SB(1, 0), cB + kstep, voffB); PG8_STAGE(PG8_SA(1, 0), cA + kstep, voffA); PG8_STAGE(PG8_SB(1, 1), cB + hstepB + kstep, voffB);
        PG8_WAIT_V(6); PG8_BAR;
    }
    for (;;) {
        const bool has_next = S.next(ui + 1, nxt);
        const unsigned nA = has_next ? (unsigned)(nxt.A - wsb) : cA, nB = has_next ? (unsigned)(nxt.B - wsb) : cB;
        for (int t = 0; t < ntc; t += 2) {
            const bool last = (t == ntc - 2), z0 = (t == 0);
            const unsigned a1 = cA + (unsigned)(t + 1) * kstep;
            const unsigned a2 = last ? nA : cA + (unsigned)(t + 2) * kstep, b2 = last ? nB : cB + (unsigned)(t + 2) * kstep;
            const unsigned a3 = a2 + kstep, b3 = b2 + kstep;
            if (last && has_next) S.a_ready(nxt);
            if constexpr (SP2) {
            PG8_LDB(B0, 0, 0); PG8_LDB(B1, 0, 1); PG8_SCHED; PG8_LDA(At, 0, 0); PG8_STAGE(PG8_SA(1, 1), a1 + hstepA, voffA);
            PG8_WAIT_V(8); PG8_WAIT_L(0); PG8_BAR; PG8_MMA(0, 0, At, B0, z0); PG8_MMA(0, 1, At, B1, z0); PG8_BAR; PG8_SCHED;
            PG8_LDA(At, 0, 1); PG8_STAGE(PG8_SB(0, 0), b2, voffB); PG8_STAGE(PG8_SB(0, 1), b2 + hstepB, voffB); PG8_STAGE(PG8_SA(0, 0), a2, voffA);
            PG8_WAIT_V(8); PG8_WAIT_L(0); PG8_BAR; PG8_MMA(1, 0, At, B0, z0); PG8_MMA(1, 1, At, B1, z0); PG8_BAR; PG8_SCHED;
            PG8_LDB(B0, 1, 0); PG8_LDB(B1, 1, 1); PG8_SCHED; PG8_LDA(At, 1, 0); PG8_STAGE(PG8_SA(0, 1), a2 + hstepA, voffA);
            PG8_WAIT_V(8); PG8_WAIT_L(0); PG8_BAR; PG8_MMA(0, 0, At, B0, false); PG8_MMA(0, 1, At, B1, false); PG8_BAR; PG8_SCHED;
            PG8_LDA(At, 1, 1); PG8_STAGE(PG8_SB(1, 0), b3, voffB); PG8_STAGE(PG8_SB(1, 1), b3 + hstepB, voffB); PG8_STAGE(PG8_SA(1, 0), a3, voffA);
            PG8_WAIT_V(8); PG8_WAIT_L(0); PG8_BAR; PG8_MMA(1, 0, At, B0, false); PG8_MMA(1, 1, At, B1, false); PG8_BAR; PG8_SCHED;
            } else {
            PG8_LDB(B0, 0, 0); PG8_SCHED; PG8_LDA(At, 0, 0); PG8_STAGE(PG8_SA(1, 1), a1 + hstepA, voffA);
            PG8_WAIT_L(8); PG8_BAR; PG8_WAIT_L(0); PG8_MMA(0, 0, At, B0, z0); PG8_BAR; PG8_SCHED;
            PG8_LDB(B1, 0, 1); PG8_STAGE(PG8_SB(0, 0), b2, voffB);
            PG8_BAR; PG8_WAIT_L(0); PG8_MMA(0, 1, At, B1, z0); PG8_BAR;
            PG8_LDA(At, 0, 1); PG8_STAGE(PG8_SA(0, 0), a2, voffA);
            PG8_BAR; PG8_WAIT_L(0); PG8_MMA(1, 0, At, B0, z0); PG8_BAR; PG8_SCHED;
            PG8_STAGE(PG8_SB(0, 1), b2 + hstepB, voffB);
            PG8_WAIT_V(6); PG8_BAR; PG8_MMA(1, 1, At, B1, z0); PG8_BAR;
            PG8_LDB(B0, 1, 0); PG8_SCHED; PG8_LDA(At, 1, 0); PG8_STAGE(PG8_SA(0, 1), a2 + hstepA, voffA);
            PG8_WAIT_L(8); PG8_BAR; PG8_WAIT_L(0); PG8_MMA(0, 0, At, B0, false); PG8_BAR; PG8_SCHED;
            PG8_LDB(B1, 1, 1); PG8_STAGE(PG8_SB(1, 0), b3, voffB);
            PG8_BAR; PG8_WAIT_L(0); PG8_MMA(0, 1, At, B1, false); PG8_BAR;
            PG8_LDA(At, 1, 1); PG8_STAGE(PG8_SA(1, 0), a3, voffA);
            PG8_BAR; PG8_WAIT_L(0); PG8_MMA(1, 0, At, B0, false); PG8_BAR; PG8_SCHED;
            PG8_STAGE(PG8_SB(1, 1), b3 + hstepB, voffB);
            PG8_WAIT_V(6); PG8_BAR; PG8_MMA(1, 1, At, B1, false); PG8_BAR;
            }
        }
        asm volatile("s_nop 15\n\ts_nop 7" ::: "memory");
        if constexpr (ALIGN_EPI) { if (wr == 0) PG8_BAR; }
        if constexpr (!Epi::AFTER_DRAIN) { int fr2 = fr, fq2 = fq; asm volatile("" : "+v"(fr2), "+v"(fq2));
            E(acc, cur, wr, wc, fr2, fq2); S.done(cur); }
        if (!has_next) break;
        cur = nxt; cA = nA; cB = nB; ++ui;
        if constexpr (SchedVarK<Sched>::v) ntc = S.nt_of(cur, nt);
        if constexpr (ALIGN_EPI) { if (wr == 1) PG8_BAR; }
    }
    PG8_WAIT_V(0);
    if constexpr (!ALIGN_EPI) { if (wr == 0) PG8_BAR; }
    PG8_BAR;
    if constexpr (Epi::AFTER_DRAIN) { int fr2 = fr, fq2 = fq, lane2 = lane; asm volatile("" : "+v"(fr2), "+v"(fq2), "+v"(lane2)); E.fused(acc, cur, wr, wc, fr2, fq2, lds, wid, lane2); S.done(cur); }
#undef PG8_SA
#undef PG8_SB
#undef PG8_STAGE
#undef PG8_LDA
#undef PG8_LD16
#undef PG8_CAT
#undef PG8_LDB
#undef PG8_MMA
#undef PG8_MMA_ASM8
#undef PG8_WAIT_V
#undef PG8_WAIT_L
#undef PG8_BAR
#undef PG8_SCHED
}
}
using pg8::Unit;
typedef const f32x4 (&AccRef)[2][2][4][2];

__device__ __forceinline__ u32x4 pack8(const f32x4 a, const f32x4 b) { u32x4 w; w.x = pk2(a[0], a[1]); w.y = pk2(a[2], a[3]); w.z = pk2(b[0], b[1]); w.w = pk2(b[2], b[3]); return w; }
__device__ __forceinline__ void unpack8(const u32x4 w, f32x4& a, f32x4& b) { a = (f32x4){bflo(w.x), bfhi(w.x), bflo(w.y), bfhi(w.y)}; b = (f32x4){bflo(w.z), bfhi(w.z), bflo(w.w), bfhi(w.w)}; }

struct EpiInproj {
    static constexpr bool PERM = true, AFTER_DRAIN = false;
    const float* stats; bf16_t* uconv; bf16_t* xu; bf16_t* gates;
    __device__ __forceinline__ void operator()(AccRef acc, const Unit& u, int wr, int wc, int fr, int fq) const {
        float rr[2][4];
#pragma unroll
        for (int ai = 0; ai < 2; ++ai)
#pragma unroll
            for (int m = 0; m < 4; ++m) rr[ai][m] = row_rstd(stats, u.pm * 256 + ai * 128 + wr * 64 + m * 16 + fr);
#pragma unroll
        for (int ai = 0; ai < 2; ++ai)
#pragma unroll
            for (int m = 0; m < 4; ++m) {
                const int row = u.pm * 256 + ai * 128 + wr * 64 + m * 16 + fr;
                const float r = rr[ai][m];
                if (u.pn < 4) {
                    f32x4 v[2];
#pragma unroll
                    for (int n = 0; n < 2; ++n)
#pragma unroll
                        for (int i = 0; i < 4; ++i) v[n][i] = (acc[ai][0][m][n][i] * r) * sigmoidf_(acc[ai][1][m][n][i] * r);
                    *(u32x4*)(uconv + (size_t)row * CW + u.pn * 128 + wc * 32 + fq * 8) = pack8(v[0], v[1]);
                } else if (u.pn < 6) {
                    const int b = row >> 12, t = row & 4095;
#pragma unroll
                    for (int bj = 0; bj < 2; ++bj) {
                        const int ch = (u.pn - 4) * 256 + bj * 128 + wc * 32 + fq * 8, g = ch >> 4, h0 = ch & 15;
                        const size_t off = ((size_t)((b * NG + g) * 256 + (t >> 4))) * 384 + (t & 15) * 16 + h0;
                        *(u32x4*)(xu + off) = pack8(acc[ai][bj][m][0] * r, acc[ai][bj][m][1] * r);
                    }
                } else {
#pragma unroll
                    for (int bj = 0; bj < 2; ++bj) {
                        f32x4 v[2];
#pragma unroll
                        for (int n = 0; n < 2; ++n)
#pragma unroll
                            for (int i = 0; i < 4; ++i) v[n][i] = sigmoidf_(acc[ai][bj][m][n][i] * r);
                        *(u32x4*)(gates + (size_t)row * 2048 + (u.pn - 6) * 256 + bj * 128 + wc * 32 + fq * 8) = pack8(v[0], v[1]);
                    }
                }
            }
    }
};
struct EpiGates {
    static constexpr bool PERM = true, AFTER_DRAIN = false;
    const float* stats; bf16_t* gates; float sc; bf16_t* xu;
    __device__ __forceinline__ void operator()(AccRef acc, const Unit& u, int wr, int wc, int fr, int fq) const {
        float rr[2][4];
#pragma unroll
        for (int ai = 0; ai < 2; ++ai)
#pragma unroll
            for (int m = 0; m < 4; ++m) rr[ai][m] = row_rstd(stats, u.pm * 256 + ai * 128 + wr * 64 + m * 16 + fr) * sc;
#pragma unroll
        for (int ai = 0; ai < 2; ++ai)
#pragma unroll
            for (int m = 0; m < 4; ++m) {
                const int row = u.pm * 256 + ai * 128 + wr * 64 + m * 16 + fr; const float r = rr[ai][m];
                if (F8_IN_S && u.pn >= 8) {
                    const int b = row >> 12, t = row & 4095;
#pragma unroll
                    for (int bj = 0; bj < 2; ++bj) {
                        const int ch = (u.pn - 8) * 256 + bj * 128 + wc * 32 + fq * 8, g = ch >> 4, h0 = ch & 15;
                        const size_t off = ((size_t)((b * NG + g) * 256 + (t >> 4))) * 384 + (t & 15) * 16 + h0;
                        *(u32x4*)(xu + off) = pack8(acc[ai][bj][m][0] * r, acc[ai][bj][m][1] * r);
                    }
                    continue;
                }
#pragma unroll
                for (int bj = 0; bj < 2; ++bj) {
                    f32x4 v[2];
#pragma unroll
                    for (int n = 0; n < 2; ++n)
#pragma unroll
                        for (int i = 0; i < 4; ++i) v[n][i] = sigmoidf_(acc[ai][bj][m][n][i] * r);
                    *(u32x4*)(gates + (size_t)row * 2048 + u.pn * 256 + bj * 128 + wc * 32 + fq * 8) = pack8(v[0], v[1]);
                }
            }
    }
};
struct EpiZ {
    static constexpr bool PERM = true, AFTER_DRAIN = false;
    const bf16_t* gates; bf16_t* mb; float sc = 1.f;
    __device__ __forceinline__ void operator()(AccRef acc, const Unit& u, int wr, int wc, int fr, int fq) const {
        const int oc = u.pn * 128 + wc * 32 + fq * 8;
        u32x4 gv[2][4];
#pragma unroll
        for (int ai = 0; ai < 2; ++ai)
#pragma unroll
            for (int m = 0; m < 4; ++m) gv[ai][m] = *(const u32x4*)(gates + (size_t)(u.pm * 256 + ai * 128 + wr * 64 + m * 16 + fr) * 2048 + 1024 + oc);
#pragma unroll
        for (int ai = 0; ai < 2; ++ai)
#pragma unroll
            for (int m = 0; m < 4; ++m) {
                const int row = u.pm * 256 + ai * 128 + wr * 64 + m * 16 + fr;
                f32x4 g0, g1; unpack8(gv[ai][m], g0, g1);
                f32x4 v[2];
#pragma unroll
                for (int i = 0; i < 4; ++i) { v[0][i] = g0[i] * (acc[ai][0][m][0][i] * sc) * sigmoidf_(acc[ai][1][m][0][i] * sc); v[1][i] = g1[i] * (acc[ai][0][m][1][i] * sc) * sigmoidf_(acc[ai][1][m][1][i] * sc); }
                *(u32x4*)(mb + (size_t)row * D + oc) = pack8(v[0], v[1]);
            }
    }
};
struct EpiPw {
    static constexpr bool PERM = true, AFTER_DRAIN = false;
    const bf16_t* gates; const bf16_t* mb; bf16_t* merged;
    __device__ __forceinline__ void operator()(AccRef acc, const Unit& u, int wr, int wc, int fr, int fq) const {
#pragma unroll
        for (int ai = 0; ai < 2; ++ai) {
            u32x4 gv[4][2], mv[4][2];
#pragma unroll
            for (int m = 0; m < 4; ++m)
#pragma unroll
                for (int bj = 0; bj < 2; ++bj) { const int row = u.pm * 256 + ai * 128 + wr * 64 + m * 16 + fr, c = u.pn * 256 + bj * 128 + wc * 32 + fq * 8;
                    gv[m][bj] = *(const u32x4*)(gates + (size_t)row * 2048 + c); mv[m][bj] = *(const u32x4*)(mb + (size_t)row * D + c); }
#pragma unroll
            for (int m = 0; m < 4; ++m)
#pragma unroll
                for (int bj = 0; bj < 2; ++bj) { const int row = u.pm * 256 + ai * 128 + wr * 64 + m * 16 + fr, c = u.pn * 256 + bj * 128 + wc * 32 + fq * 8;
                    f32x4 g0, g1, m0, m1; unpack8(gv[m][bj], g0, g1); unpack8(mv[m][bj], m0, m1);
                    *(u32x4*)(merged + (size_t)row * D + c) = pack8(g0 * acc[ai][bj][m][0] + m0, g1 * acc[ai][bj][m][1] + m1); }
        }
    }
};
struct EpiZPW {
    static constexpr bool PERM = true, AFTER_DRAIN = false;
    EpiZ ez; EpiPw ep;
    __device__ __forceinline__ void operator()(AccRef acc, const Unit& u, int wr, int wc, int fr, int fq) const {
        if (u.tag == 0) ez(acc, u, wr, wc, fr, fq);
        else { asm volatile("s_waitcnt vmcnt(0)" ::: "memory"); ep(acc, u, wr, wc, fr, fq); }
    }
};
struct SchedZPW {
    pg8::StaticOrder o; const char* ys; const char* uc; const char* wglu; const char* wpw;
    __device__ __forceinline__ bool next(int i, Unit& u) const { const int gi = i / 3, sub = i - gi * 3; int pm, pn; if (!o.next(gi, pm, pn)) return false;
        u.pm = pm;
        if (sub < 2) { u.pn = 2 * pn + sub; u.tag = 0; u.A = ys + (size_t)pm * 256 * SW * 2; u.B = wglu + (size_t)u.pn * 256 * SW * 2; }
        else { u.pn = pn; u.tag = 1; u.A = uc + (size_t)pm * 256 * CW * 2; u.B = wpw + (size_t)pn * 256 * CW * 2; }
        return true; }
    __device__ __forceinline__ void a_ready(const Unit&) const {}
    __device__ __forceinline__ void done(const Unit&) const {}
};
template <bool H8OUT = false, bool SCALED = false> struct EpiRes {
    static constexpr bool PERM = true, AFTER_DRAIN = false;
    bf16_t* h; float* stats; bf16_t* hdst; unsigned char* h8; LAS unsigned char* lds;
    __device__ __forceinline__ void operator()(AccRef acc, const Unit& u, int wr, int wc, int fr, int fq) const {
        LAS float* X = (LAS float*)(lds + LDS_AUX);
#pragma unroll
        for (int ai = 0; ai < 2; ++ai) {
            u32x4 hv[4][2];
#pragma unroll
            for (int m = 0; m < 4; ++m)
#pragma unroll
                for (int bj = 0; bj < 2; ++bj) hv[m][bj] = *(const u32x4*)(h + (size_t)(u.pm * 256 + ai * 128 + wr * 64 + m * 16 + fr) * D + u.pn * 256 + bj * 128 + wc * 32 + fq * 8);
#pragma unroll
            for (int m = 0; m < 4; ++m) {
                const int row = u.pm * 256 + ai * 128 + wr * 64 + m * 16 + fr; float ss = 0.f;
#pragma unroll
                for (int bj = 0; bj < 2; ++bj) {
                    const size_t eo = (size_t)row * D + u.pn * 256 + bj * 128 + wc * 32 + fq * 8;
                    f32x4 h0, h1; unpack8(hv[m][bj], h0, h1);
                    constexpr float asc = SCALED ? 1.0f / (F8_WD_SCALE * F8_ACT_SCALE) : 1.0f;
                    h0 = h0 + acc[ai][bj][m][0] * asc; h1 = h1 + acc[ai][bj][m][1] * asc;
                    ss += (h0[0] * h0[0] + h0[1] * h0[1]) + (h0[2] * h0[2] + h0[3] * h0[3]) + (h1[0] * h1[0] + h1[1] * h1[1]) + (h1[2] * h1[2] + h1[3] * h1[3]);
                    *(u32x4*)(hdst + eo) = pack8(h0, h1);
                    if (H8OUT) { u32x2 w8; w8.x = pk4_fp8(h0[0], h0[1], h0[2], h0[3]); w8.y = pk4_fp8(h1[0], h1[1], h1[2], h1[3]); *(u32x2*)(h8 + eo) = w8; }
                }
                ss += __shfl_xor(ss, 16); ss += __shfl_xor(ss, 32);
                if (fq == 0) X[(ai * 128 + wr * 64 + m * 16 + fr) * 4 + wc] = ss;
            }
        }
        LDS_WAIT(); __builtin_amdgcn_s_barrier(); asm volatile("" ::: "memory");
        const int lane = fq * 16 + fr, wid = wr * 4 + wc;
        if (lane < 32) { const int rl = wid * 32 + lane; const f32x4 v = *(const LAS f32x4*)(X + rl * 4); stats[(size_t)(u.pm * 256 + rl) * 4 + u.pn] = (v[0] + v[1]) + (v[2] + v[3]); }
    }
};
struct EpiQ {
    static constexpr bool PERM = true, AFTER_DRAIN = false;
    const float* stats; bf16_t* q; float sc;
    __device__ __forceinline__ void operator()(AccRef acc, const Unit& u, int wr, int wc, int fr, int fq) const {
        float rr[2][4];
#pragma unroll
        for (int ai = 0; ai < 2; ++ai)
#pragma unroll
            for (int m = 0; m < 4; ++m) rr[ai][m] = row_rstd(stats, u.pm * 256 + ai * 128 + wr * 64 + m * 16 + fr) * sc;
#pragma unroll
        for (int ai = 0; ai < 2; ++ai)
#pragma unroll
            for (int m = 0; m < 4; ++m) {
                const int row = u.pm * 256 + ai * 128 + wr * 64 + m * 16 + fr; const float r = rr[ai][m];
#pragma unroll
                for (int bj = 0; bj < 2; ++bj)
                    *(u32x4*)(q + (size_t)row * D + u.pn * 256 + bj * 128 + wc * 32 + fq * 8) = pack8(acc[ai][bj][m][0] * r, acc[ai][bj][m][1] * r);
            }
    }
};
template <bool MOE, bool F8 = false> struct EpiGU {
    static constexpr bool PERM = true, AFTER_DRAIN = false;
    const float* stats;
    const float* gwt;
    bf16_t* act; int ldc;
    __device__ __forceinline__ void operator()(AccRef acc, const Unit& u, int wr, int wc, int fr, int fq) const {
        float rr[2][4], gg[2][4];
#pragma unroll
        for (int ai = 0; ai < 2; ++ai)
#pragma unroll
            for (int m = 0; m < 4; ++m) { const int row = u.pm * 256 + ai * 128 + wr * 64 + m * 16 + fr; gg[ai][m] = 1.f; if (MOE) { rr[ai][m] = stats[row]; gg[ai][m] = gwt[row]; } else rr[ai][m] = row_rstd(stats, row); }
#pragma unroll
        for (int ai = 0; ai < 2; ++ai)
#pragma unroll
            for (int m = 0; m < 4; ++m) {
                const int row = u.pm * 256 + ai * 128 + wr * 64 + m * 16 + fr;
                float r = rr[ai][m], gw = gg[ai][m];
                if (F8) { r *= 1.0f / F8_WGU_SCALE; gw *= F8_ACT_SCALE; }
                f32x4 v[2];
#pragma unroll
                for (int n = 0; n < 2; ++n)
#pragma unroll
                    for (int i = 0; i < 4; ++i) v[n][i] = siluf_(acc[ai][0][m][n][i] * r) * (acc[ai][1][m][n][i] * r) * gw;
                if (F8) { u32x2 w8; w8.x = pk4_fp8(v[0][0], v[0][1], v[0][2], v[0][3]); w8.y = pk4_fp8(v[1][0], v[1][1], v[1][2], v[1][3]); *(u32x2*)((unsigned char*)act + (size_t)row * ldc + u.pn * 128 + wc * 32 + fq * 8) = w8; }
                else *(u32x4*)(act + (size_t)row * ldc + u.pn * 128 + wc * 32 + fq * 8) = pack8(v[0], v[1]);
            }
    }
};
struct EpiPlain {
    static constexpr bool PERM = true, AFTER_DRAIN = false;
    bf16_t* o0; bf16_t* o1; int ld0, ld1; size_t ls0, ls1; float osc = 1.f;
    __device__ __forceinline__ void operator()(AccRef acc, const Unit& u, int wr, int wc, int fr, int fq) const {
        const int which = u.tag & 1, layer = u.tag >> 1; bf16_t* o = which ? o1 + (size_t)layer * ls1 : o0 + (size_t)layer * ls0; const int ld = which ? ld1 : ld0;
#pragma unroll
        for (int ai = 0; ai < 2; ++ai)
#pragma unroll
            for (int m = 0; m < 4; ++m) {
                const int row = u.pm * 256 + ai * 128 + wr * 64 + m * 16 + fr;
#pragma unroll
                for (int bj = 0; bj < 2; ++bj)
                    *(u32x4*)(o + (size_t)row * ld + u.pn * 256 + bj * 128 + wc * 32 + fq * 8) = pack8(acc[ai][bj][m][0] * osc, acc[ai][bj][m][1] * osc);
            }
    }
};
constexpr int MOE_FULL_PANELS = (2 * T) / 256, MOE_TAIL_ROWS = 2048;
struct EpiDown {
    static constexpr bool PERM = true, AFTER_DRAIN = false;
    bf16_t* ye; float* part; float osc;
    __device__ __forceinline__ void operator()(AccRef acc, const Unit& u, int wr, int wc, int fr, int fq) const {
        if (u.tag == 0) {
#pragma unroll
            for (int ai = 0; ai < 2; ++ai)
#pragma unroll
                for (int m = 0; m < 4; ++m) {
                    const int row = u.pm * 256 + ai * 128 + wr * 64 + m * 16 + fr;
#pragma unroll
                    for (int bj = 0; bj < 2; ++bj)
                        *(u32x4*)(ye + (size_t)row * D + u.pn * 256 + bj * 128 + wc * 32 + fq * 8) = pack8(acc[ai][bj][m][0] * osc, acc[ai][bj][m][1] * osc);
                }
        } else {
            float* o = part + (size_t)(u.tag - 1) * MOE_TAIL_ROWS * D;
#pragma unroll
            for (int ai = 0; ai < 2; ++ai)
#pragma unroll
                for (int m = 0; m < 4; ++m) {
                    const int row = (u.pm - MOE_FULL_PANELS) * 256 + ai * 128 + wr * 64 + m * 16 + fr;
#pragma unroll
                    for (int bj = 0; bj < 2; ++bj)
#pragma unroll
                        for (int n = 0; n < 2; ++n)
                            *(f32x4*)(o + (size_t)row * D + u.pn * 256 + bj * 128 + wc * 32 + fq * 8 + n * 4) = acc[ai][bj][m][n] * osc;
                }
        }
    }
};
struct EpiSsm1 {
    static constexpr bool PERM = true, AFTER_DRAIN = true;
    const float* a16;
    bf16_t* xu;
    __device__ __forceinline__ void fused(AccRef acc, const Unit& u, int wr, int wc, int fr, int fq, LAS unsigned char* lds, int wid, int lane) const {
        LAS float* S = (LAS float*)lds;
#pragma unroll
        for (int ai = 0; ai < 2; ++ai)
#pragma unroll
            for (int m = 0; m < 4; ++m) {
                const int row = ai * 128 + wr * 64 + m * 16 + fr;
#pragma unroll
                for (int n = 0; n < 2; ++n) *(LAS f32x4*)(S + row * 128 + wc * 32 + fq * 8 + n * 4) = acc[ai][0][m][n];
            }
        LDS_WAIT(); __builtin_amdgcn_s_barrier(); asm volatile("" ::: "memory");
        LAS f32x2* Sp = (LAS f32x2*)lds; LAS f32x2* E = (LAS f32x2*)(lds + LDS_AUX);
        const int p = lane, seg = wid;
        const f32x2 a = *(const f32x2*)(a16 + 2 * p);
        f32x2 x = {0.f, 0.f};
        for (int c = seg * 32; c < seg * 32 + 32; ++c) { const f32x2 s = Sp[c * 64 + p]; Sp[c * 64 + p] = x; x = (f32x2){a.x * x.x - a.y * x.y + s.x, a.x * x.y + a.y * x.x + s.y}; }
        E[seg * 64 + p] = x;
        LDS_WAIT(); __builtin_amdgcn_s_barrier(); asm volatile("" ::: "memory");
        f32x2 a512 = a;
#pragma unroll
        for (int i = 0; i < 5; ++i) a512 = (f32x2){a512.x * a512.x - a512.y * a512.y, 2.f * a512.x * a512.y};
        f32x2 z = {0.f, 0.f};
        for (int j = 0; j < seg; ++j) { const f32x2 e = E[j * 64 + p]; z = (f32x2){a512.x * z.x - a512.y * z.y + e.x, a512.x * z.y + a512.y * z.x + e.y}; }
        for (int c = seg * 32; c < seg * 32 + 32; ++c) { const f32x2 hl = Sp[c * 64 + p];
            *(unsigned*)(xu + (size_t)c * 384 + 256 + 2 * p) = pk2(hl.x + z.x, hl.y + z.y);
            z = (f32x2){a.x * z.x - a.y * z.y, a.x * z.y + a.y * z.x}; }
    }
};
struct EpiSsm2 {
    static constexpr bool PERM = true, AFTER_DRAIN = false;
    bf16_t* ys; int b, g;
    __device__ __forceinline__ void operator()(AccRef acc, const Unit& u, int wr, int wc, int fr, int fq) const {
#pragma unroll
        for (int ai = 0; ai < 2; ++ai)
#pragma unroll
            for (int m = 0; m < 4; ++m) {
                const int c = ai * 128 + wr * 64 + m * 16 + fr;
#pragma unroll
                for (int bj = 0; bj < 2; ++bj) {
                    const int j = bj * 8 + wc * 2 + (fq >> 1), h0 = (fq & 1) * 8;
                    f32x4 v[2];
#pragma unroll
                    for (int n = 0; n < 2; ++n)
#pragma unroll
                        for (int i = 0; i < 4; ++i) v[n][i] = gelu_tanh_(acc[ai][bj][m][n][i]);
                    if (F8_Z) { u32x2 w8; w8.x = pk4_fp8(v[0][0] * F8_YS_SCALE, v[0][1] * F8_YS_SCALE, v[0][2] * F8_YS_SCALE, v[0][3] * F8_YS_SCALE); w8.y = pk4_fp8(v[1][0] * F8_YS_SCALE, v[1][1] * F8_YS_SCALE, v[1][2] * F8_YS_SCALE, v[1][3] * F8_YS_SCALE);
                        *(u32x2*)((unsigned char*)ys + ((size_t)b * SEQ + c * 16 + j) * SW + g * 16 + h0) = w8; }
                    else *(u32x4*)(ys + ((size_t)b * SEQ + c * 16 + j) * SW + g * 16 + h0) = pack8(v[0], v[1]);
                }
            }
    }
};

#define XB_TMO      128
#define XB_XCNT(j)  (256  + 64 * (j))
#define XB_XSUB(j)  (1280 + 64 * (j))
#define XB_XGEN(j)  (2304 + 64 * (j))
#define XB_TOP      3328
#define XB_TOPGEN   3392
#define XCD_BAR_WORDS 3456
#define XB_SPIN_CAP (1u << 18)
__device__ __forceinline__ unsigned xb_ld(unsigned* p)              { return __hip_atomic_load(p, __ATOMIC_RELAXED, __HIP_MEMORY_SCOPE_AGENT); }
__device__ __forceinline__ unsigned xb_add(unsigned* p, unsigned v) { return __hip_atomic_fetch_add(p, v, __ATOMIC_RELAXED, __HIP_MEMORY_SCOPE_AGENT); }
__device__ __forceinline__ unsigned xb_xcc_id() { return (unsigned)__builtin_amdgcn_s_getreg((3 << 11) | 20) & 0xFu; }
#define XB_SPIN(cond, bar) do { unsigned _sp = 0; while (cond) { __builtin_amdgcn_s_sleep(1); \
    if ((++_sp & 255u) == 0u) { if (xb_ld(&(bar)[XB_TMO])) break; if (_sp > XB_SPIN_CAP) { atomicAdd(&(bar)[XB_TMO], 1u); break; } } } } while (0)
struct XcdBarrier { unsigned* bar; unsigned x; volatile LAS unsigned* st; };
__device__ __forceinline__ XcdBarrier xcd_barrier_post(unsigned* bar, volatile LAS unsigned* st) {
    XcdBarrier b; b.bar = bar; b.x = xb_xcc_id(); b.st = st;
    if (threadIdx.x == 0) (void)xb_add(&bar[XB_XCNT(b.x)], 1u);
    return b;
}
__device__ __forceinline__ void xcd_barrier_complete(unsigned* bar, unsigned x, unsigned& nloc, unsigned& nx) {
    const unsigned G = gridDim.x * gridDim.y * gridDim.z;
    unsigned sum, cnt, mine, sp = 0u;
    for (;;) {
        sum = 0u; cnt = 0u; mine = 0u;
#pragma unroll
        for (unsigned j = 0; j < 16; ++j) { const unsigned c = xb_ld(&bar[XB_XCNT(j)]); sum += c; cnt += (c > 0u) ? 1u : 0u; mine = (j == x) ? c : mine; }
        if (sum == G) break;
        __builtin_amdgcn_s_sleep(1);
        if ((++sp & 255u) == 0u) { if (xb_ld(&bar[XB_TMO])) break; if (sp > XB_SPIN_CAP) { atomicAdd(&bar[XB_TMO], 1u); break; } }
    }
    nloc = mine > 0u ? mine : 1u; nx = cnt > 0u ? cnt : 1u;
}
__device__ __forceinline__ void xcd_barrier(const XcdBarrier& b, const int tid) {
    asm volatile("s_waitcnt vmcnt(0)" ::: "memory");
    __syncthreads();
    if (tid == 0) {
        unsigned* bar = b.bar;
        __builtin_amdgcn_s_waitcnt(0);
        unsigned nloc = b.st[0], nx = b.st[1];
        if (nloc == 0u) { xcd_barrier_complete(bar, b.x, nloc, nx); b.st[0] = nloc; b.st[1] = nx; }
        const unsigned old = xb_add(&bar[XB_XSUB(b.x)], 1u);
        const unsigned gen = old / nloc;
        if (old + 1u == (gen + 1u) * nloc) {
            __builtin_amdgcn_fence(__ATOMIC_RELEASE, "agent");
            asm volatile("s_waitcnt vmcnt(0)" ::: "memory");
            const unsigned og = xb_add(&bar[XB_TOP], 1u);
            const unsigned tg = og / nx;
            if (og + 1u == (tg + 1u) * nx) xb_add(&bar[XB_TOPGEN], 1u);
            else XB_SPIN(xb_ld(&bar[XB_TOPGEN]) == tg, bar);
            __builtin_amdgcn_fence(__ATOMIC_ACQUIRE, "agent");
            xb_add(&bar[XB_XGEN(b.x)], 1u);
            asm volatile("s_waitcnt vmcnt(0)" ::: "memory");
        } else {
            XB_SPIN(xb_ld(&bar[XB_XGEN(b.x)]) == gen, bar);
            __builtin_amdgcn_fence(__ATOMIC_ACQUIRE, "agent");
            asm volatile("s_waitcnt vmcnt(0)" ::: "memory");
        }
    }
    __syncthreads();
}

struct Args {
    const float* in[32];
    float* out; unsigned char* ws;
    int ph_lo, ph_hi;
};
enum { I_X = 0, I_MEM, I_MEMG, I_NMIXG, I_WIN, I_CONVW, I_CONVB, I_LNG, I_LNB, I_WPW, I_LRE, I_LIM, I_LOGDT, I_BRE, I_BIM, I_CRE, I_CIM, I_DSKIP, I_WGLU, I_WOUT,
       I_NXG, I_WQ, I_WKV, I_WO, I_NFG, I_FGU, I_FD, I_RW, I_RB, I_MGU, I_MD, I_FINALG };

struct Frame {
    LAS unsigned char* lds; int tid, lane, wave, c, G;
    unsigned char* ws; const float* const* in; float* out;
};
template <class Tp> __device__ __forceinline__ Tp* wsp(const Frame& F, size_t off) { return (Tp*)(F.ws + off); }

template <bool F8 = false>
__device__ __forceinline__ void xpose_matrix(const Frame& F, const float* W, int K, int Nsrc, int N, bf16_t* WT, int permlimit, int halfN, const float* gk, float sc, unsigned& item_base) {
    LAS float* scr = (LAS float*)(F.lds + F.wave * 16640);
    const int lane = F.lane, NGW = F.G * 8, gw = F.c * 8 + F.wave;
    const int nblk = N / 64, items = (K / 64) * nblk;
    int first = (int)(((unsigned)gw + (unsigned)NGW - (item_base % (unsigned)NGW)) % (unsigned)NGW);
    item_base = (item_base + (unsigned)items) % (unsigned)NGW;
    const int kr = lane >> 4, nc = (lane & 15) * 4;
    for (int it = first; it < items; it += NGW) {
        const int kb = it / nblk, nb = it % nblk, k0 = 64 * kb, n0 = 64 * nb;
        const int c0 = (n0 < permlimit) ? (((n0 >> 7) & 1) * halfN + (n0 >> 8) * 128 + (n0 & 127)) : n0;
        f32x4 v[16];
#pragma unroll
        for (int i = 0; i < 16; ++i) v[i] = *(const f32x4*)(W + (size_t)(k0 + 4 * i + kr) * Nsrc + c0 + nc);
#pragma unroll
        for (int i = 0; i < 16; ++i) { const float g = gk ? gk[k0 + 4 * i + kr] * sc : sc; LAS float* d = scr + (4 * i + kr) * 65 + nc;
            d[0] = v[i][0] * g; d[1] = v[i][1] * g; d[2] = v[i][2] * g; d[3] = v[i][3] * g; }
        LDS_WAIT(); asm volatile("" ::: "memory");
        const int c = lane & 7;
#pragma unroll
        for (int j = 0; j < 8; ++j) { const int n = (lane >> 3) + 8 * j; const LAS float* s = scr + (8 * c) * 65 + n;
            u32x4 o; o.x = pk2(s[0 * 65], s[1 * 65]); o.y = pk2(s[2 * 65], s[3 * 65]); o.z = pk2(s[4 * 65], s[5 * 65]); o.w = pk2(s[6 * 65], s[7 * 65]);
            if (F8) { u32x2 o8; o8.x = pk4_fp8(s[0 * 65], s[1 * 65], s[2 * 65], s[3 * 65]); o8.y = pk4_fp8(s[4 * 65], s[5 * 65], s[6 * 65], s[7 * 65]); *(u32x2*)((unsigned char*)WT + (size_t)(n0 + n) * K + k0 + 8 * c) = o8; }
            else *(u32x4*)(WT + (size_t)(n0 + n) * K + k0 + 8 * c) = o; }
        LDS_WAIT(); asm volatile("" ::: "memory");
    }
}
struct XDesc { unsigned long long src, dst, gk; int K, Nsrc, nblk, permlimit, halfN, f8; float sc; unsigned base; unsigned pad[2]; };
static_assert(sizeof(XDesc) == 64, "XDesc is four 16-byte words");
static_assert(MK_ONE_LAUNCH == 1, "deferred weights are converted inside the grid barriers of the one-launch kernel");
static_assert(F8_GATES && F8_QO && F8_MOE_MASK == 0xA && F8_DENSE_MASK == 0x4, "the deferred-conversion table below is written for this precision configuration");
constexpr int LDS_BGTAB = LDS_MISC + 256, BG_NMAT = 55 + (F8_IN_S ? 3 : 0);
static_assert(LDS_BGTAB + (BG_NMAT + 1) * 64 <= LDS_BYTES, "descriptor table inside the LDS allocation");
constexpr int MI_LCUR = 16, MI_SEQ = 17, MI_THR = 18  , MI_MCUR = 24  ;
__device__ __forceinline__ void xd_store(LAS XDesc* p, const XDesc& v) { const u32x4* q = (const u32x4*)&v; LAS u32x4* d = (LAS u32x4*)p; d[0] = q[0]; d[1] = q[1]; d[2] = q[2]; d[3] = q[3]; }
__device__ __forceinline__ XDesc xd_load(const LAS XDesc* p) { const LAS u32x4* d = (const LAS u32x4*)p; u32x4 q[4] = {d[0], d[1], d[2], d[3]}; return __builtin_bit_cast(XDesc, q); }
__device__ __forceinline__ unsigned xd_base(const LAS XDesc* p) { return ((const volatile LAS unsigned*)p)[13]; }
__device__ __forceinline__ void xpose_item(const Frame& F, const XDesc& d, int it) {
    LAS float* scr = (LAS float*)(F.lds + F.wave * 16640);
    const int lane = F.lane, kr = lane >> 4, nc = (lane & 15) * 4;
    const GAS float* W = (const GAS float*)d.src; const GAS float* gk = (const GAS float*)d.gk;     const int K = d.K, Nsrc = d.Nsrc;
    const int kb = it / d.nblk, nb = it - kb * d.nblk, k0 = 64 * kb, n0 = 64 * nb;
    const int c0 = (n0 < d.permlimit) ? (((n0 >> 7) & 1) * d.halfN + (n0 >> 8) * 128 + (n0 & 127)) : n0;
#pragma unroll
    for (int hh = 0; hh < 2; ++hh) {
        f32x4 v[8];
#pragma unroll
        for (int i = 0; i < 8; ++i) v[i] = *(const GAS f32x4*)(W + (size_t)(k0 + 4 * (8 * hh + i) + kr) * Nsrc + c0 + nc);
#pragma unroll
        for (int i = 0; i < 8; ++i) { const float g = gk ? gk[k0 + 4 * (8 * hh + i) + kr] * d.sc : d.sc; LAS float* q = scr + (4 * (8 * hh + i) + kr) * 65 + nc;
            q[0] = v[i][0] * g; q[1] = v[i][1] * g; q[2] = v[i][2] * g; q[3] = v[i][3] * g; }
    }
    LDS_WAIT(); asm volatile("" ::: "memory");
    const int c = lane & 7;
#pragma unroll
    for (int j = 0; j < 8; ++j) { const int n = (lane >> 3) + 8 * j; const LAS float* s = scr + (8 * c) * 65 + n;
        if (d.f8) { u32x2 o8; o8.x = pk4_fp8(s[0 * 65], s[1 * 65], s[2 * 65], s[3 * 65]); o8.y = pk4_fp8(s[4 * 65], s[5 * 65], s[6 * 65], s[7 * 65]); *(GAS u32x2*)((GAS unsigned char*)d.dst + (size_t)(n0 + n) * K + k0 + 8 * c) = o8; }
        else { u32x4 o; o.x = pk2(s[0 * 65], s[1 * 65]); o.y = pk2(s[2 * 65], s[3 * 65]); o.z = pk2(s[4 * 65], s[5 * 65]); o.w = pk2(s[6 * 65], s[7 * 65]); *(GAS u32x4*)((GAS bf16_t*)d.dst + (size_t)(n0 + n) * K + k0 + 8 * c) = o; } }
    LDS_WAIT(); asm volatile("" ::: "memory");
}
__device__ __forceinline__ bool bg_try(const Frame& F, unsigned limit) {
    volatile LAS unsigned* MISC = (volatile LAS unsigned*)(F.lds + LDS_MISC);
    LAS unsigned* lcur = (LAS unsigned*)(F.lds + LDS_MISC) + MI_LCUR;
    unsigned k = 0u; if (F.lane == 0) k = __hip_atomic_fetch_add(lcur, 1u, __ATOMIC_RELAXED, __HIP_MEMORY_SCOPE_WORKGROUP);
    k = (unsigned)__builtin_amdgcn_readfirstlane((int)k);
    const unsigned g = k * (unsigned)F.G + (unsigned)F.c;
    if (g >= limit) { if (F.lane == 0) __hip_atomic_fetch_sub(lcur, 1u, __ATOMIC_RELAXED, __HIP_MEMORY_SCOPE_WORKGROUP); return false; }
    const LAS XDesc* tab = (const LAS XDesc*)(F.lds + LDS_BGTAB);
    int m = (int)MISC[MI_MCUR + F.wave];
    while (g >= xd_base(tab + m + 1)) ++m;
    if (F.lane == 0) MISC[MI_MCUR + F.wave] = (unsigned)m;
    const XDesc d = xd_load(tab + m);
    xpose_item(F, d, (int)(g - d.base));
    return true;
}
__device__ __forceinline__ void bg_drain(const Frame& F, int which) {
    const unsigned limit = ((volatile LAS unsigned*)(F.lds + LDS_MISC))[MI_THR + which];
    while (bg_try(F, limit)) {}
}
__device__ __forceinline__ void ssm_tables(const Frame& F, int layer, int g) {
    LAS float* L = (LAS float*)F.lds;
    LAS float* AP = L;
    LAS float* BB = L + 17 * 128;
    LAS float* CC = BB + 2048;
    LAS float* KI = CC + 2048;
    const int tid = F.tid;
    const float* lre = F.in[I_LRE] + (size_t)(layer * NG + g) * SP; const float* lim = F.in[I_LIM] + (size_t)(layer * NG + g) * SP;
    const float dt = expf(F.in[I_LOGDT][layer * NG + g]);
    __syncthreads();
    for (int i = tid; i < 17 * 64; i += 512) { const int n = i >> 6, p = i & 63; const float mag = expf((float)n * lre[p] * dt), th = (float)n * (lim[p] * dt); AP[i * 2] = mag * cosf(th); AP[i * 2 + 1] = mag * sinf(th); }
    {
        const float* bre = F.in[I_BRE] + (size_t)(layer * NG + g) * SP * SG; const float* bim = F.in[I_BIM] + (size_t)(layer * NG + g) * SP * SG;
        for (int i = tid; i < 1024; i += 512) { const int p = i >> 4; const float lr = lre[p], li = lim[p];
            const float mag = expf(lr * dt), ar = mag * cosf(li * dt), aim = mag * sinf(li * dt), den = lr * lr + li * li, xr = ar - 1.0f;
            const float kr = (xr * lr + aim * li) / den, ki = (aim * lr - xr * li) / den, br = bre[i], bi = bim[i];
            BB[i * 2] = kr * br - ki * bi; BB[i * 2 + 1] = kr * bi + ki * br; }
        const float* cre = F.in[I_CRE] + (size_t)(layer * NG + g) * SG * SP; const float* cim = F.in[I_CIM] + (size_t)(layer * NG + g) * SG * SP;
        for (int i = tid; i < 1024; i += 512) { CC[i * 2] = cre[i]; CC[i * 2 + 1] = cim[i]; }
    }
    __syncthreads();
    for (int i = tid; i < 4096; i += 512) { const int tau = i >> 8, hp = (i >> 4) & 15, h = i & 15; float s = 0.f;
        for (int p = 0; p < 64; ++p) { const float ar = AP[(tau * 64 + p) * 2], ai = AP[(tau * 64 + p) * 2 + 1], br = BB[(p * 16 + h) * 2], bi = BB[(p * 16 + h) * 2 + 1];
            const float tr = ar * br - ai * bi, ti = ar * bi + ai * br; s += CC[(hp * 64 + p) * 2] * tr - CC[(hp * 64 + p) * 2 + 1] * ti; }
        if (tau == 0 && hp == h) s += F.in[I_DSKIP][(layer * NG + g) * SG + h];
        KI[i] = s; }
    __syncthreads();
    bf16_t* wst = wsp<bf16_t>(F, WS_WST) + (size_t)(layer * NG + g) * 256 * 256;
    bf16_t* tw = wsp<bf16_t>(F, WS_TW) + (size_t)(layer * NG + g) * 256 * 384;
    for (int i = tid; i < 256 * 128; i += 512) { const int row = i >> 7, cp = (i & 127) * 2; unsigned o = 0u;
        if (row < 128) { const int p = row >> 1, ri = row & 1; float v[2];
#pragma unroll
            for (int e = 0; e < 2; ++e) { const int col = cp + e, s = col >> 4, h = col & 15; const float ar = AP[((15 - s) * 64 + p) * 2], ai = AP[((15 - s) * 64 + p) * 2 + 1], br = BB[(p * 16 + h) * 2], bi = BB[(p * 16 + h) * 2 + 1];
                v[e] = ri ? (ar * bi + ai * br) : (ar * br - ai * bi); }
            o = pk2(v[0], v[1]); }
        *(unsigned*)(wst + (size_t)row * 256 + cp) = o; }
    for (int i = tid; i < 256 * 192; i += 512) { const int row = i / 192, cp = (i % 192) * 2, j = row >> 4, hp = row & 15; float v[2];
#pragma unroll
        for (int e = 0; e < 2; ++e) { const int col = cp + e;
            if (col < 256) { const int s = col >> 4, h = col & 15; v[e] = (j >= s) ? KI[((j - s) * 16 + hp) * 16 + h] : 0.f; }
            else { const int q = col - 256, p = q >> 1, ri = q & 1; const float ar = AP[((j + 1) * 64 + p) * 2], ai = AP[((j + 1) * 64 + p) * 2 + 1], cr = CC[(hp * 64 + p) * 2], ci = CC[(hp * 64 + p) * 2 + 1];
                v[e] = ri ? -(cr * ai + ci * ar) : (cr * ar - ci * ai); } }
        *(unsigned*)(tw + (size_t)row * 384 + cp) = pk2(v[0], v[1]); }
    float* a16 = wsp<float>(F, WS_A16) + (size_t)(layer * NG + g) * 128;
    for (int i = tid; i < 128; i += 512) a16[i] = AP[16 * 128 + i];
    __syncthreads();
}

__device__ __forceinline__ void prologue(const Frame& F) {
    if (F.tid == 0) {
        LAS XDesc* tab = (LAS XDesc*)(F.lds + LDS_BGTAB); volatile LAS unsigned* MISC = (volatile LAS unsigned*)(F.lds + LDS_MISC);
        int n = 0; unsigned base = 0u;
#define XQ_ADD(SRC, K_, NSRC_, N_, DST, PERML, HALFN, GK, SC, F8_) do { XDesc xd_; xd_.src = (unsigned long long)(SRC); xd_.dst = (unsigned long long)(DST); xd_.gk = (unsigned long long)(GK); xd_.K = (K_); xd_.Nsrc = (NSRC_); xd_.nblk = (N_) / 64; \
        xd_.permlimit = (PERML); xd_.halfN = (HALFN); xd_.f8 = (F8_) ? 1 : 0; xd_.sc = (SC); xd_.base = base; xd_.pad[0] = 0u; xd_.pad[1] = 0u; xd_store(tab + n, xd_); base += (unsigned)(((K_) / 64) * ((N_) / 64)); ++n; } while (0)
#define XQ_MIXER(l) do { \
        XQ_ADD(F.in[I_WIN] + (size_t)(l) * D * INC, D, INC, (F8_IN_S ? 1024 : 1536), wsp<bf16_t>(F, WS_WIN) + (size_t)(l) * INC * D, 1024, 512, F.in[I_NMIXG] + (l) * D, 1.f, false); \
        if (F8_IN_S) XQ_ADD(F.in[I_WIN] + (size_t)(l) * D * INC + 1024, D, INC, 512, wsp<bf16_t>(F, WS_WIN) + (size_t)(l) * INC * D + (size_t)2560 * D, 0, 0, F.in[I_NMIXG] + (l) * D, F8_WGU_SCALE, true);     \
        XQ_ADD(F.in[I_WIN] + (size_t)(l) * D * INC + 1536, D, INC, 2048, wsp<bf16_t>(F, WS_WIN) + (size_t)(l) * INC * D + (size_t)1536 * D, 0, 0, F.in[I_NMIXG] + (l) * D, F8_WGU_SCALE, true); \
        XQ_ADD(F.in[I_WPW] + (size_t)(l) * CW * D, CW, D, D, wsp<bf16_t>(F, WS_WPW) + (size_t)(l) * D * CW, 0, 0, (const float*)nullptr, 1.f, false); \
        XQ_ADD(F.in[I_WGLU] + (size_t)(l) * SW * 2 * D, SW, 2 * D, 2 * D, wsp<bf16_t>(F, WS_WGLU) + (size_t)(l) * 2 * D * SW, 2 * D, D, (const float*)nullptr, (F8_Z ? F8_WGLU_SCALE : 1.f), (F8_Z != 0)); \
        XQ_ADD(F.in[I_WOUT] + (size_t)(l) * D * D, D, D, D, wsp<bf16_t>(F, WS_WOUT) + (size_t)(l) * D * D, 0, 0, (const float*)nullptr, 1.f, false); \
        XQ_ADD(F.in[I_WQ] + (size_t)(l) * D * D, D, D, D, wsp<bf16_t>(F, WS_WQ) + (size_t)(l) * D * D, 0, 0, F.in[I_NXG] + (l) * D, 0.0625f * F8_WQ_SCALE, true); \
        XQ_ADD(F.in[I_WO] + (size_t)(l) * D * D, D, D, D, wsp<bf16_t>(F, WS_WO) + (size_t)(l) * D * D, 0, 0, (const float*)nullptr, F8_WO_SCALE, true); } while (0)
#define XQ_MOE(j) do { for (int e = 0; e < NE; ++e) { \
        XQ_ADD(F.in[I_MGU] + (size_t)((j) * NE + e) * D * 2 * DFE, D, 2 * DFE, 2 * DFE, (unsigned char*)wsp<bf16_t>(F, WS_WMGU) + (size_t)(j) * NE * 2 * DFE * D * 2 + (size_t)e * 2 * DFE * D, 2 * DFE, DFE, F.in[I_NFG] + (2 * (j) + 1) * D, F8_WGU_SCALE, true); \
        XQ_ADD(F.in[I_MD] + (size_t)((j) * NE + e) * DFE * D, DFE, D, D, (unsigned char*)wsp<bf16_t>(F, WS_WMD) + (size_t)(j) * NE * D * DFE * 2 + (size_t)e * D * DFE, 0, 0, (const float*)nullptr, F8_WD_SCALE, true); } } while (0)
        XQ_MIXER(1); XQ_MOE(0); MISC[MI_THR + 0] = base;
        XQ_MIXER(2);
        XQ_ADD(F.in[I_FGU] + (size_t)1 * D * 2 * DFF, D, 2 * DFF, 2 * DFF, wsp<bf16_t>(F, WS_WFGU) + (size_t)1 * 2 * DFF * D, 2 * DFF, DFF, F.in[I_NFG] + 2 * D, F8_WGU_SCALE, true);
        XQ_ADD(F.in[I_FD] + (size_t)1 * DFF * D, DFF, D, D, wsp<bf16_t>(F, WS_WFD) + (size_t)1 * D * DFF, 0, 0, (const float*)nullptr, F8_WD_SCALE, true);
        MISC[MI_THR + 1] = base;
        XQ_MIXER(3); XQ_MOE(1); MISC[MI_THR + 2] = base;
        XDesc sent{}; sent.base = base; xd_store(tab + n, sent);
#undef XQ_MOE
#undef XQ_MIXER
#undef XQ_ADD
    }
    unsigned ib = 0u;
    {
        const int l = 0;
        xpose_matrix(F, F.in[I_WIN] + (size_t)l * D * INC, D, INC, (F8_IN_S ? 1024 : 1536), wsp<bf16_t>(F, WS_WIN) + (size_t)l * INC * D, 1024, 512, F.in[I_NMIXG] + l * D, 1.f, ib);
        if (F8_IN_S) xpose_matrix<true>(F, F.in[I_WIN] + (size_t)l * D * INC + 1024, D, INC, 512, wsp<bf16_t>(F, WS_WIN) + (size_t)l * INC * D + (size_t)2560 * D, 0, 0, F.in[I_NMIXG] + l * D, F8_WGU_SCALE, ib);
        xpose_matrix<true>(F, F.in[I_WIN] + (size_t)l * D * INC + 1536, D, INC, 2048, wsp<bf16_t>(F, WS_WIN) + (size_t)l * INC * D + (size_t)1536 * D, 0, 0, F.in[I_NMIXG] + l * D, F8_WGU_SCALE, ib);
        xpose_matrix(F, F.in[I_WPW] + (size_t)l * CW * D, CW, D, D, wsp<bf16_t>(F, WS_WPW) + (size_t)l * D * CW, 0, 0, nullptr, 1.f, ib);
        xpose_matrix<(F8_Z != 0)>(F, F.in[I_WGLU] + (size_t)l * SW * 2 * D, SW, 2 * D, 2 * D, wsp<bf16_t>(F, WS_WGLU) + (size_t)l * 2 * D * SW, 2 * D, D, nullptr, (F8_Z ? F8_WGLU_SCALE : 1.f), ib);
        xpose_matrix(F, F.in[I_WOUT] + (size_t)l * D * D, D, D, D, wsp<bf16_t>(F, WS_WOUT) + (size_t)l * D * D, 0, 0, nullptr, 1.f, ib);
        xpose_matrix<true>(F, F.in[I_WQ] + (size_t)l * D * D, D, D, D, wsp<bf16_t>(F, WS_WQ) + (size_t)l * D * D, 0, 0, F.in[I_NXG] + l * D, 0.0625f * F8_WQ_SCALE, ib);
        xpose_matrix<true>(F, F.in[I_WO] + (size_t)l * D * D, D, D, D, wsp<bf16_t>(F, WS_WO) + (size_t)l * D * D, 0, 0, nullptr, F8_WO_SCALE, ib);
    }
    for (int l = 0; l < DEPTH; ++l) xpose_matrix(F, F.in[I_WKV] + (size_t)l * D * 2 * D, D, 2 * D, 2 * D, wsp<bf16_t>(F, WS_WKV) + (size_t)l * 2 * D * D, 0, 0, nullptr, 1.f, ib);
    xpose_matrix(F, F.in[I_FGU], D, 2 * DFF, 2 * DFF, wsp<bf16_t>(F, WS_WFGU), 2 * DFF, DFF, F.in[I_NFG], 1.f, ib);
    xpose_matrix(F, F.in[I_FD], DFF, D, D, wsp<bf16_t>(F, WS_WFD), 0, 0, nullptr, 1.f, ib);
    const int gw = F.c * 8 + F.wave, NGW = F.G * 8, lane = F.lane;
    { const float* gm = F.in[I_MEMG]; bf16_t* mn = wsp<bf16_t>(F, WS_MEMN);
      for (int r = gw; r < NMEM; r += NGW) { const f32x4* xr = (const f32x4*)(F.in[I_MEM] + (size_t)r * D) + lane; f32x4 v[4]; float s = 0.f;
#pragma unroll
          for (int j = 0; j < 4; ++j) { v[j] = xr[64 * j]; s += (v[j][0] * v[j][0] + v[j][1] * v[j][1]) + (v[j][2] * v[j][2] + v[j][3] * v[j][3]); }
          const float rs = __builtin_amdgcn_rsqf(wave_sum(s) * (1.f / D) + RMS_EPS);
#pragma unroll
          for (int j = 0; j < 4; ++j) { const f32x4 gg = ((const f32x4*)gm)[64 * j + lane]; u32x2 o; o.x = pk2(v[j][0] * rs * gg[0], v[j][1] * rs * gg[1]); o.y = pk2(v[j][2] * rs * gg[2], v[j][3] * rs * gg[3]);
              *((u32x2*)(mn + (size_t)r * D) + 64 * j + lane) = o; } } }
    { bf16_t* h = wsp<bf16_t>(F, WS_H); float* st = wsp<float>(F, WS_STATS); unsigned* h8 = wsp<unsigned>(F, WS_H8);
      for (int r = gw; r < T; r += NGW) { const f32x4* xr = (const f32x4*)(F.in[I_X] + (size_t)r * D) + lane; float s = 0.f;
#pragma unroll
          for (int j = 0; j < 4; ++j) { const f32x4 v = xr[64 * j]; s += (v[0] * v[0] + v[1] * v[1]) + (v[2] * v[2] + v[3] * v[3]); u32x2 o; o.x = pk2(v[0], v[1]); o.y = pk2(v[2], v[3]);
              *((u32x2*)(h + (size_t)r * D) + 64 * j + lane) = o; if (F8_GATES) h8[(size_t)r * (D / 4) + 64 * j + lane] = pk4_fp8(v[0], v[1], v[2], v[3]); }
          s = wave_sum(s);
          if (lane < 4) st[(size_t)r * 4 + lane] = (lane == 0) ? s : 0.f; } }
    for (int it = F.c; it < DEPTH * NG; it += F.G) ssm_tables(F, it / NG, it % NG);
}

__device__ __forceinline__ void conv_phase(const Frame& F, int layer) {
    const bf16_t* uin_g = wsp<bf16_t>(F, WS_UCONV); bf16_t* uc = wsp<bf16_t>(F, WS_UC);
    LAS bf16_t* uin = (LAS bf16_t*)F.lds;
    LAS float* yb = (LAS float*)(F.lds + 65536);
    const int tid = F.tid, lane = F.lane, wave = F.wave;
    float w[CK];
#pragma unroll
    for (int k = 0; k < CK; ++k) w[k] = F.in[I_CONVW][(size_t)(layer * CK + k) * CW + tid];
    const float bias = F.in[I_CONVB][layer * CW + tid];
    f32x4 lg0, lg1, lb0, lb1;
    { const f32x4* gp = (const f32x4*)(F.in[I_LNG] + layer * CW + lane * 8); lg0 = gp[0]; lg1 = gp[1]; const f32x4* bp = (const f32x4*)(F.in[I_LNB] + layer * CW + lane * 8); lb0 = bp[0]; lb1 = bp[1]; }
    for (int tile = F.c; tile < T / 32; tile += F.G) {
        const int t0 = tile * 32, p0 = t0 & (SEQ - 1);
        __syncthreads();
#pragma unroll
        for (int it = 0; it < 8; ++it) { const int id = it * 512 + tid;
            if (id < 62 * 64) { const int row = id >> 6, ch = id & 63; u32x4 v = {0u, 0u, 0u, 0u};
                if (p0 - 30 + row >= 0) v = *(const u32x4*)(uin_g + (size_t)(t0 - 30 + row) * CW + ch * 8);
                *(LAS u32x4*)(uin + row * 512 + ch * 8) = v; } }
        __syncthreads();
        float y[32], uu[62];
#pragma unroll
        for (int o = 0; o < 32; ++o) y[o] = bias;
#pragma unroll
        for (int j = 0; j < 62; ++j) uu[j] = __uint_as_float(((unsigned)uin[j * 512 + tid]) << 16);
#pragma unroll
        for (int k = 0; k < CK; ++k)
#pragma unroll
            for (int o = 0; o < 32; ++o) y[o] += w[k] * uu[o + k];
#pragma unroll
        for (int o = 0; o < 32; ++o) yb[o * 512 + tid] = y[o];
        __syncthreads();
#pragma unroll
        for (int q = 0; q < 4; ++q) { const int o = wave + 8 * q; const LAS f32x4* rp = (const LAS f32x4*)(yb + o * 512 + lane * 8); f32x4 a = rp[0], b = rp[1];
            const float mean = wave_sum((a[0] + a[1]) + (a[2] + a[3]) + (b[0] + b[1]) + (b[2] + b[3])) * (1.f / CW);
            a = a - mean; b = b - mean;
            const float var = wave_sum((a[0] * a[0] + a[1] * a[1]) + (a[2] * a[2] + a[3] * a[3]) + (b[0] * b[0] + b[1] * b[1]) + (b[2] * b[2] + b[3] * b[3])) * (1.f / CW);
            const float rs = __builtin_amdgcn_rsqf(var + LN_EPS);
            a = a * rs * lg0 + lb0; b = b * rs * lg1 + lb1;
#pragma unroll
            for (int i = 0; i < 4; ++i) { a[i] = siluf_(a[i]); b[i] = siluf_(b[i]); }
            *(u32x4*)(uc + (size_t)(t0 + o) * CW + lane * 8) = pack8(a, b); }
    }
    __syncthreads();
}

#define MFMA32(a, b, c) __builtin_amdgcn_mfma_f32_32x32x16_bf16((a), (b), (c), 0, 0, 0)
#define ATT_LOAD16(dst, ptr0, stride_bytes) do { unsigned long long _p = (unsigned long long)(ptr0); _Pragma("unroll") for (int it = 0; it < 16; ++it) { dst[it] = *(const GAS u32x4*)_p; _p += (stride_bytes); asm volatile("" : "+v"(_p)); } } while (0)
#define ATT_STORE16(src) do { LAS char* _w0 = (LAS char*)Ks + (tid >> 5) * 528 + (tid & 31) * 16; asm volatile("" : "+v"(_w0)); LAS char* _w1 = _w0 + 8 * 8448; _Pragma("unroll") for (int it = 0; it < 8; ++it) { *(LAS u32x4*)(_w0 + it * 8448) = src[it]; *(LAS u32x4*)(_w1 + it * 8448) = src[it + 8]; } } while (0)
__device__ __forceinline__ void attn_phase(const Frame& F, int layer) {
    const bf16_t* Q = wsp<bf16_t>(F, WS_Q); const bf16_t* Km = wsp<bf16_t>(F, WS_KMAT) + (size_t)layer * NMEM * D; const bf16_t* Vt = wsp<bf16_t>(F, WS_VT) + (size_t)layer * D * NMEM;
    bf16_t* AO = wsp<bf16_t>(F, WS_AO);
    LAS bf16_t* Ks = (LAS bf16_t*)F.lds;
    const int tid = F.tid, lane = F.lane, wave = F.wave, l31 = lane & 31, lh = lane >> 5;
    constexpr int NU = BATCH * HEADS * (SEQ / 256);
    u32x4 Kr[16];
    if (F.c < NU) { const int bh = F.c & 31, b = bh >> 2, hd = bh & 3;
        ATT_LOAD16(Kr, Km + (size_t)(b * MEM + (tid >> 5)) * D + hd * HD + (tid & 31) * 8, 16 * D * 2); }
    for (int unit = F.c; unit < NU; unit += F.G) {
        const int bh = unit & 31, qt = unit >> 5, b = bh >> 2, hd = bh & 3;
        const size_t qrow = (size_t)b * SEQ + qt * 256 + wave * 32 + l31;
        bf16x8 Qf[16];
#pragma unroll
        for (int db = 0; db < 16; ++db) Qf[db] = *(const bf16x8*)(Q + qrow * D + hd * HD + db * 16 + lh * 8);
        __syncthreads();
        ATT_STORE16(Kr);
        ATT_LOAD16(Kr, Vt + (size_t)(hd * HD + (tid >> 5)) * NMEM + b * MEM + (tid & 31) * 8, 16 * NMEM * 2);
        __syncthreads();
        u32x4 sp[8][2];
        float mx = -3.0e38f;
#pragma unroll
        for (int kb = 0; kb < 8; ++kb) {
            f32x16 sc;
#pragma unroll
            for (int i = 0; i < 16; ++i) sc[i] = 0.f;
#pragma unroll
            for (int db = 0; db < 16; ++db) { const bf16x8 a = *(const LAS bf16x8*)(Ks + (kb * 32 + l31) * 264 + db * 16 + lh * 8); sc = MFMA32(a, Qf[db], sc); }
#pragma unroll
            for (int i = 0; i < 16; ++i) mx = fmaxf(mx, sc[i]);
#pragma unroll
            for (int hh = 0; hh < 2; ++hh) { sp[kb][hh].x = pk2(sc[8 * hh + 0], sc[8 * hh + 1]); sp[kb][hh].y = pk2(sc[8 * hh + 2], sc[8 * hh + 3]); sp[kb][hh].z = pk2(sc[8 * hh + 4], sc[8 * hh + 5]); sp[kb][hh].w = pk2(sc[8 * hh + 6], sc[8 * hh + 7]); }
        }
        mx = fmaxf(mx, __shfl_xor(mx, 32));
        float sum = 0.f;
        bf16x8 Pf[16];
#pragma unroll
        for (int kb = 0; kb < 8; ++kb)
#pragma unroll
            for (int hh = 0; hh < 2; ++hh) { f32x4 a, bq; unpack8(sp[kb][hh], a, bq);
#pragma unroll
                for (int i = 0; i < 4; ++i) { a[i] = fast_exp2((a[i] - mx) * 1.44269504f); bq[i] = fast_exp2((bq[i] - mx) * 1.44269504f); sum += a[i] + bq[i]; }
                Pf[kb * 2 + hh] = __builtin_bit_cast(bf16x8, pack8(a, bq)); }
        sum += __shfl_xor(sum, 32);
        const float inv = 1.0f / sum;
        __syncthreads();
        ATT_STORE16(Kr);
        if (unit + F.G < NU) { const int nbh = (unit + F.G) & 31, nb = nbh >> 2, nhd = nbh & 3;
            ATT_LOAD16(Kr, Km + (size_t)(nb * MEM + (tid >> 5)) * D + nhd * HD + (tid & 31) * 8, 16 * D * 2); }
        __syncthreads();
#pragma unroll
        for (int db = 0; db < 8; ++db) {
            f32x16 o;
#pragma unroll
            for (int i = 0; i < 16; ++i) o[i] = 0.f;
#pragma unroll
            for (int kk = 0; kk < 16; ++kk) { const LAS bf16_t* base = Ks + (db * 32 + l31) * 264 + kk * 16 + 4 * lh;
                const u32x2 lo = *(const LAS u32x2*)base, hi = *(const LAS u32x2*)(base + 8);
                u32x4 w; w.x = lo.x; w.y = lo.y; w.z = hi.x; w.w = hi.y;
                o = MFMA32(__builtin_bit_cast(bf16x8, w), Pf[kk], o); }
#pragma unroll
            for (int g4 = 0; g4 < 4; ++g4) {
                if (F8_QO) *(unsigned*)((unsigned char*)AO + qrow * D + hd * HD + db * 32 + 8 * g4 + 4 * lh) = pk4_fp8(o[4 * g4 + 0] * (inv * F8_AO_SCALE), o[4 * g4 + 1] * (inv * F8_AO_SCALE), o[4 * g4 + 2] * (inv * F8_AO_SCALE), o[4 * g4 + 3] * (inv * F8_AO_SCALE));
                else { u32x2 w; w.x = pk2(o[4 * g4 + 0] * inv, o[4 * g4 + 1] * inv); w.y = pk2(o[4 * g4 + 2] * inv, o[4 * g4 + 3] * inv); *(u32x2*)(AO + qrow * D + hd * HD + db * 32 + 8 * g4 + 4 * lh) = w; } }
        }
    }
    __syncthreads();
}

__device__ __forceinline__ void router_phase(const Frame& F, int layer, int j) {
    const bf16_t* h = wsp<bf16_t>(F, WS_H);
    unsigned* toke = (unsigned*)(F.ws + WS_META + MT_TOKE); float* tokw = (float*)(F.ws + WS_META + MT_TOKW); float* tokr = (float*)(F.ws + WS_META + MT_TOKR); int* wgcnt = (int*)(F.ws + WS_META + MT_WGCNT);
    LAS int* cnt = (LAS int*)(F.lds + LDS_AUX);
    const int lane = F.lane, wave = F.wave, tid = F.tid;
    float wr_[16][8];
    { const float* rw = F.in[I_RW] + (size_t)j * D * NE; const float* gg = F.in[I_NFG] + (size_t)layer * D;
#pragma unroll
      for (int kk = 0; kk < 16; ++kk) { const int k = lane * 16 + kk; const f32x4 a = *(const f32x4*)(rw + (size_t)k * NE), b = *(const f32x4*)(rw + (size_t)k * NE + 4); const float g = gg[k];
#pragma unroll
          for (int e = 0; e < 4; ++e) { wr_[kk][e] = a[e] * g; wr_[kk][4 + e] = b[e] * g; } } }
    float rb[8];
#pragma unroll
    for (int e = 0; e < 8; ++e) rb[e] = F.in[I_RB][j * NE + e];
    for (int chunk = F.c; chunk < T / 128; chunk += F.G) {
        __syncthreads();
        if (tid < 8) cnt[tid] = 0;
        __syncthreads();
        for (int ib = 0; ib < 16; ib += 4) {
          u32x4 qa[4], qb[4];
#pragma unroll
          for (int ii = 0; ii < 4; ++ii) { const int tk = chunk * 128 + wave * 16 + ib + ii; qa[ii] = *(const u32x4*)(h + (size_t)tk * D + lane * 16); qb[ii] = *(const u32x4*)(h + (size_t)tk * D + lane * 16 + 8); }
#pragma unroll
          for (int ii = 0; ii < 4; ++ii) {
            const int tok = chunk * 128 + wave * 16 + ib + ii;
            const u32x4 q0 = qa[ii], q1 = qb[ii];
            float x[16]; { f32x4 a, b, c, d; unpack8(q0, a, b); unpack8(q1, c, d);
#pragma unroll
                for (int e = 0; e < 4; ++e) { x[e] = a[e]; x[4 + e] = b[e]; x[8 + e] = c[e]; x[12 + e] = d[e]; } }
            float ss = 0.f, dt[8];
#pragma unroll
            for (int e = 0; e < 8; ++e) dt[e] = 0.f;
#pragma unroll
            for (int kk = 0; kk < 16; ++kk) { ss += x[kk] * x[kk];
#pragma unroll
                for (int e = 0; e < 8; ++e) dt[e] += x[kk] * wr_[kk][e]; }
            ss = wave_sum(ss);
#pragma unroll
            for (int e = 0; e < 8; ++e) dt[e] = wave_sum(dt[e]);
            const float r = __builtin_amdgcn_rsqf(ss * (1.f / D) + RMS_EPS);
            float v1 = -3.0e38f, v2 = -3.0e38f; int e1 = 0, e2 = 0;
#pragma unroll
            for (int e = 0; e < 8; ++e) { const float lg = dt[e] * r + rb[e]; if (lg > v1) { v2 = v1; e2 = e1; v1 = lg; e1 = e; } else if (lg > v2) { v2 = lg; e2 = e; } }
            const float w1 = 1.0f / (1.0f + __expf(v2 - v1)), w2 = 1.0f - w1;
            if (lane == 0) { toke[tok] = (unsigned)e1 | ((unsigned)e2 << 8); tokw[2 * tok] = w1; tokw[2 * tok + 1] = w2; tokr[tok] = r;
                atomicAdd((int*)&cnt[e1], 1); atomicAdd((int*)&cnt[e2], 1); }
          }
        }
        __syncthreads();
        if (tid < 8) wgcnt[chunk * 8 + tid] = cnt[tid];
    }
    __syncthreads();
}
template <bool F8>
__device__ __forceinline__ void assign_phase(const Frame& F) {
    const bf16_t* h = wsp<bf16_t>(F, WS_H); bf16_t* hs = wsp<bf16_t>(F, WS_HS);
    const unsigned* toke = (const unsigned*)(F.ws + WS_META + MT_TOKE); const float* tokw = (const float*)(F.ws + WS_META + MT_TOKW); const float* tokr = (const float*)(F.ws + WS_META + MT_TOKR);
    int* tokslot = (int*)(F.ws + WS_META + MT_TOKSLOT); float* rscale = (float*)(F.ws + WS_META + MT_RSCALE); float* gwt = (float*)(F.ws + WS_META + MT_GWT);
    const int* wgcnt = (const int*)(F.ws + WS_META + MT_WGCNT); int* pexp = (int*)(F.ws + WS_META + MT_PEXP); unsigned* ctl = (unsigned*)(F.ws + WS_CTL);
    LAS int* cl = (LAS int*)(F.lds);
    LAS int* tot = (LAS int*)(F.lds + 8192);
    LAS int* sl = (LAS int*)(F.lds + 8192 + 256);
    const int tid = F.tid, lane = F.lane, wave = F.wave;
    for (int chunk = F.c; chunk < T / 128; chunk += F.G) {
        __syncthreads();
        if (tid < 16) tot[tid] = 0;
        __syncthreads();
        if (tid < 256) {
            const u32x4 c0 = *(const u32x4*)(wgcnt + tid * 8), c1 = *(const u32x4*)(wgcnt + tid * 8 + 4);
            const int my[8] = {(int)c0.x, (int)c0.y, (int)c0.z, (int)c0.w, (int)c1.x, (int)c1.y, (int)c1.z, (int)c1.w};
#pragma unroll
            for (int e = 0; e < 8; ++e) { int a = my[e], p = (tid < chunk) ? my[e] : 0;
#pragma unroll
                for (int o = 1; o < 64; o <<= 1) { a += __shfl_xor(a, o); p += __shfl_xor(p, o); }
                if (lane == 0) { atomicAdd((int*)&tot[e], a); atomicAdd((int*)&tot[8 + e], p); } }
        }
        __syncthreads();
        if (tid == 0) { int base = 0; for (int e = 0; e < 8; ++e) { tot[16 + e] = base; tot[24 + e] = base + tot[8 + e]; base += (tot[e] + 255) & ~255; }
            if (chunk == 0) { ctl[CW_PTOTAL] = (unsigned)(base >> 8); int pp = 0; for (int e = 0; e < 8; ++e) { ctl[CW_PBASE + e] = (unsigned)(tot[16 + e] >> 8); const int np = (tot[e] + 255) >> 8; for (int q = 0; q < np; ++q) pexp[pp++] = e; } } }
        __syncthreads();
        if (chunk == 0) {
            for (int e = 0; e < 8; ++e) { const int lo = tot[16 + e] + tot[e], hi = tot[16 + e] + ((tot[e] + 255) & ~255);
                for (int s = lo + tid; s < hi; s += 512) { rscale[s] = 0.f; gwt[s] = 0.f; } } }
        if (wave == 0) {
            for (int it = 0; it < 2; ++it) { const int li = it * 64 + lane, tok = chunk * 128 + li; const unsigned ee = toke[tok]; const int e1 = ee & 255, e2 = (ee >> 8) & 255; int s1 = 0, s2 = 0;
                const unsigned long long ltmask = (1ull << lane) - 1ull;
#pragma unroll
                for (int e = 0; e < 8; ++e) { const unsigned long long m1 = __ballot(e1 == e), m2 = __ballot(e2 == e); const int off = tot[24 + e];
                    if (e1 == e) s1 = off + __popcll(m1 & ltmask);
                    if (e2 == e) s2 = off + __popcll(m1) + __popcll(m2 & ltmask);
                    __builtin_amdgcn_s_waitcnt(0);
                    if (lane == 0) tot[24 + e] = off + __popcll(m1) + __popcll(m2);
                    __builtin_amdgcn_s_waitcnt(0); }
                sl[li * 2] = s1; sl[li * 2 + 1] = s2; tokslot[2 * tok] = s1; tokslot[2 * tok + 1] = s2;
                const float r = tokr[tok]; rscale[s1] = r; rscale[s2] = r; gwt[s1] = tokw[2 * tok]; gwt[s2] = tokw[2 * tok + 1]; }
        }
        __syncthreads();
        for (int q = wave; q < 256; q += 8) { const int li = q >> 1, tok = chunk * 128 + li, s = sl[q];
            const u32x4 a = *(const u32x4*)(h + (size_t)tok * D + lane * 16), b = *(const u32x4*)(h + (size_t)tok * D + lane * 16 + 8);
            if (F8) { f32x4 x0, x1, x2, x3; unpack8(a, x0, x1); unpack8(b, x2, x3); u32x4 o8; o8.x = pk4_fp8(x0[0], x0[1], x0[2], x0[3]); o8.y = pk4_fp8(x1[0], x1[1], x1[2], x1[3]); o8.z = pk4_fp8(x2[0], x2[1], x2[2], x2[3]); o8.w = pk4_fp8(x3[0], x3[1], x3[2], x3[3]);
                *(u32x4*)((unsigned char*)hs + (size_t)s * D + lane * 16) = o8; }
            else { *(u32x4*)(hs + (size_t)s * D + lane * 16) = a; *(u32x4*)(hs + (size_t)s * D + lane * 16 + 8) = b; } }
    }
    __syncthreads();
}
__device__ __forceinline__ void combine_phase(const Frame& F, bool final_) {
    bf16_t* h = wsp<bf16_t>(F, WS_H); const bf16_t* ye = wsp<bf16_t>(F, WS_YE); const float* part = wsp<float>(F, WS_MPART); const int* tokslot = (const int*)(F.ws + WS_META + MT_TOKSLOT); float* st = wsp<float>(F, WS_STATS);
    const int gw = F.c * 8 + F.wave, NGW = F.G * 8, lane = F.lane;
    for (int tok = gw; tok < T; tok += NGW) {
        const int s1 = __builtin_amdgcn_readfirstlane(tokslot[2 * tok]), s2 = __builtin_amdgcn_readfirstlane(tokslot[2 * tok + 1]);
        f32x4 x[4], y[4], z[4];
        unpack8(*(const u32x4*)(h + (size_t)tok * D + lane * 16), x[0], x[1]); unpack8(*(const u32x4*)(h + (size_t)tok * D + lane * 16 + 8), x[2], x[3]);
        if (s1 < 2 * T) { unpack8(*(const u32x4*)(ye + (size_t)s1 * D + lane * 16), y[0], y[1]); unpack8(*(const u32x4*)(ye + (size_t)s1 * D + lane * 16 + 8), y[2], y[3]); }
        else { const f32x4* p = (const f32x4*)(part + (size_t)(s1 - 2 * T) * D + lane * 16);
#pragma unroll
            for (int q = 0; q < 4; ++q) y[q] = (p[q] + p[q + (size_t)MOE_TAIL_ROWS * D / 4]) + (p[q + (size_t)2 * MOE_TAIL_ROWS * D / 4] + p[q + (size_t)3 * MOE_TAIL_ROWS * D / 4]); }
        if (s2 < 2 * T) { unpack8(*(const u32x4*)(ye + (size_t)s2 * D + lane * 16), z[0], z[1]); unpack8(*(const u32x4*)(ye + (size_t)s2 * D + lane * 16 + 8), z[2], z[3]); }
        else { const f32x4* p = (const f32x4*)(part + (size_t)(s2 - 2 * T) * D + lane * 16);
#pragma unroll
            for (int q = 0; q < 4; ++q) z[q] = (p[q] + p[q + (size_t)MOE_TAIL_ROWS * D / 4]) + (p[q + (size_t)2 * MOE_TAIL_ROWS * D / 4] + p[q + (size_t)3 * MOE_TAIL_ROWS * D / 4]); }
        float ss = 0.f;
#pragma unroll
        for (int q = 0; q < 4; ++q) { x[q] = x[q] + y[q] + z[q]; ss += (x[q][0] * x[q][0] + x[q][1] * x[q][1]) + (x[q][2] * x[q][2] + x[q][3] * x[q][3]); }
        ss = wave_sum(ss);
        if (final_) { const float r = __builtin_amdgcn_rsqf(ss * (1.f / D) + RMS_EPS); const f32x4* gp = (const f32x4*)(F.in[I_FINALG] + lane * 16); f32x4* op = (f32x4*)(F.out + (size_t)tok * D + lane * 16);
#pragma unroll
            for (int q = 0; q < 4; ++q) op[q] = x[q] * r * gp[q]; }
        else { *(u32x4*)(h + (size_t)tok * D + lane * 16) = pack8(x[0], x[1]); *(u32x4*)(h + (size_t)tok * D + lane * 16 + 8) = pack8(x[2], x[3]);
            if (F8_GATES) { u32x4 o8; o8.x = pk4_fp8(x[0][0], x[0][1], x[0][2], x[0][3]); o8.y = pk4_fp8(x[1][0], x[1][1], x[1][2], x[1][3]); o8.z = pk4_fp8(x[2][0], x[2][1], x[2][2], x[2][3]); o8.w = pk4_fp8(x[3][0], x[3][1], x[3][2], x[3][3]); *(u32x4*)(F.ws + WS_H8 + (size_t)tok * D + lane * 16) = o8; }
            if (lane < 4) st[(size_t)tok * 4 + lane] = (lane == 0) ? ss : 0.f; }
    }
}

struct SchedKV {
    int G, c; const char* memn; const char* wkv;
    __device__ __forceinline__ bool next(int i, Unit& u) const { const int L = i * G + c; if (L >= 256) return false; const int layer = L >> 6, r = L & 63; const char* w = wkv + (size_t)layer * 2 * D * D * 2;
        if (r < 32) { u.pm = r >> 2; u.pn = r & 3; u.tag = layer * 2; u.A = memn + (size_t)u.pm * 256 * D * 2; u.B = w + (size_t)u.pn * 256 * D * 2; }
        else { const int q = r - 32; u.pm = q >> 3; u.pn = q & 7; u.tag = layer * 2 + 1; u.A = w + (size_t)(D + u.pm * 256) * D * 2; u.B = memn + (size_t)u.pn * 256 * D * 2; }
        return true; }
    __device__ __forceinline__ void a_ready(const Unit&) const {}
    __device__ __forceinline__ void done(const Unit&) const {}
};
struct SchedMoe {
    pg8::StaticOrder o; const char* A; const char* B; size_t sA, sB, sE; int pb1, pb2, pb3, pb4, pb5, pb6, pb7;
    __device__ __forceinline__ void load_bases(const unsigned* ctl) {
        pb1 = __builtin_amdgcn_readfirstlane((int)ctl[CW_PBASE + 1]); pb2 = __builtin_amdgcn_readfirstlane((int)ctl[CW_PBASE + 2]); pb3 = __builtin_amdgcn_readfirstlane((int)ctl[CW_PBASE + 3]); pb4 = __builtin_amdgcn_readfirstlane((int)ctl[CW_PBASE + 4]);
        pb5 = __builtin_amdgcn_readfirstlane((int)ctl[CW_PBASE + 5]); pb6 = __builtin_amdgcn_readfirstlane((int)ctl[CW_PBASE + 6]); pb7 = __builtin_amdgcn_readfirstlane((int)ctl[CW_PBASE + 7]); }
    __device__ __forceinline__ bool next(int i, Unit& u) const { int pm, pn; if (!o.next(i, pm, pn)) return false;
        const int e = (pm >= pb1) + (pm >= pb2) + (pm >= pb3) + (pm >= pb4) + (pm >= pb5) + (pm >= pb6) + (pm >= pb7);
        u.pm = pm; u.pn = pn; u.tag = 0; u.A = A + (size_t)pm * sA; u.B = B + (size_t)e * sE + (size_t)pn * sB; return true; }
    __device__ __forceinline__ void a_ready(const Unit&) const {}
    __device__ __forceinline__ void done(const Unit&) const {}
};

struct SchedZ {
    pg8::StaticOrder o; const char* ys; const char* wglu; size_t sA, sB;
    __device__ __forceinline__ bool next(int i, Unit& u) const { const int gi = i >> 1, sub = i & 1; int pm, pn; if (!o.next(gi, pm, pn)) return false;
        u.pm = pm; u.pn = 2 * pn + sub; u.tag = 0; u.A = ys + (size_t)pm * sA; u.B = wglu + (size_t)u.pn * sB; return true; }
    __device__ __forceinline__ void a_ready(const Unit&) const {}
    __device__ __forceinline__ void done(const Unit&) const {}
};
struct SchedMoeD {
    pg8::StaticOrder o; const char* A; const char* B; size_t sA, sB, sE; int pb1, pb2, pb3, pb4, pb5, pb6, pb7, ptot;
    __device__ __forceinline__ void load_bases(const unsigned* ctl) {
        pb1 = __builtin_amdgcn_readfirstlane((int)ctl[CW_PBASE + 1]); pb2 = __builtin_amdgcn_readfirstlane((int)ctl[CW_PBASE + 2]); pb3 = __builtin_amdgcn_readfirstlane((int)ctl[CW_PBASE + 3]); pb4 = __builtin_amdgcn_readfirstlane((int)ctl[CW_PBASE + 4]);
        pb5 = __builtin_amdgcn_readfirstlane((int)ctl[CW_PBASE + 5]); pb6 = __builtin_amdgcn_readfirstlane((int)ctl[CW_PBASE + 6]); pb7 = __builtin_amdgcn_readfirstlane((int)ctl[CW_PBASE + 7]); }
    __device__ __forceinline__ bool next(int i, Unit& u) const { int pm, pn, kq = -1;
        if (!o.next(i, pm, pn)) { const long q = (long)i * o.G + o.c - o.nwg; if (q >= (long)(ptot - MOE_FULL_PANELS) * 16) return false; pm = MOE_FULL_PANELS + (int)(q >> 4); pn = ((int)q >> 2) & 3; kq = (int)q & 3; }
        const int e = (pm >= pb1) + (pm >= pb2) + (pm >= pb3) + (pm >= pb4) + (pm >= pb5) + (pm >= pb6) + (pm >= pb7);
        const int koff = kq <= 0 ? 0 : (kq == 1 ? 8 : (kq == 2 ? 16 : 22));
        u.pm = pm; u.pn = pn; u.tag = kq + 1; u.A = A + (size_t)pm * sA + koff * 128; u.B = B + (size_t)e * sE + (size_t)pn * sB + koff * 128; return true; }
    __device__ __forceinline__ int nt_of(const Unit& u, int nt) const { return u.tag == 0 ? nt : (u.tag <= 2 ? 8 : 6); }
    __device__ __forceinline__ void a_ready(const Unit&) const {}
    __device__ __forceinline__ void done(const Unit&) const {}
};
template <> struct pg8::SchedVarK<SchedMoeD> { static constexpr bool v = true; };

__device__ __forceinline__ void xcd_barrier_bg(const XcdBarrier& b, const Frame& F) {
    volatile LAS unsigned* MISC = (volatile LAS unsigned*)(F.lds + LDS_MISC);
    const unsigned want = MISC[MI_SEQ] + 1u;
    asm volatile("s_waitcnt vmcnt(0)" ::: "memory");
    __syncthreads();
    const unsigned limit = MISC[MI_THR + 2];
    if (F.wave == 0) {
        if (F.tid == 0) {
            unsigned* bar = b.bar;
            __builtin_amdgcn_s_waitcnt(0);
            unsigned nloc = b.st[0], nx = b.st[1];
            if (nloc == 0u) { xcd_barrier_complete(bar, b.x, nloc, nx); b.st[0] = nloc; b.st[1] = nx; }
            const unsigned old = xb_add(&bar[XB_XSUB(b.x)], 1u);
            const unsigned gen = old / nloc;
            if (old + 1u == (gen + 1u) * nloc) {
                __builtin_amdgcn_fence(__ATOMIC_RELEASE, "agent");
                asm volatile("s_waitcnt vmcnt(0)" ::: "memory");
                const unsigned og = xb_add(&bar[XB_TOP], 1u);
                const unsigned tg = og / nx;
                if (og + 1u == (tg + 1u) * nx) xb_add(&bar[XB_TOPGEN], 1u);
                else XB_SPIN(xb_ld(&bar[XB_TOPGEN]) == tg, bar);
                __builtin_amdgcn_fence(__ATOMIC_ACQUIRE, "agent");
                xb_add(&bar[XB_XGEN(b.x)], 1u);
                asm volatile("s_waitcnt vmcnt(0)" ::: "memory");
            } else {
                XB_SPIN(xb_ld(&bar[XB_XGEN(b.x)]) == gen, bar);
                __builtin_amdgcn_fence(__ATOMIC_ACQUIRE, "agent");
                asm volatile("s_waitcnt vmcnt(0)" ::: "memory");
            }
            MISC[MI_SEQ] = want;
        }
    } else {
        while (MISC[MI_SEQ] != want) { if (!bg_try(F, limit)) break; }
    }
    __syncthreads();
}

constexpr int NPH_LAYER = 13, PH_LAYER0 = 2, NPHASES = PH_LAYER0 + DEPTH * NPH_LAYER;
extern __shared__ __attribute__((aligned(16))) unsigned char lds_raw[];
struct PA { unsigned char* ws; const float* const* in; float* out; int layer; int wave; };
__device__ __forceinline__ unsigned long long uni64(unsigned long long v) { const unsigned lo = __builtin_amdgcn_readfirstlane((unsigned)v), hi = __builtin_amdgcn_readfirstlane((unsigned)(v >> 32)); return ((unsigned long long)hi << 32) | lo; }
__device__ __forceinline__ Frame mkframe(const PA a) {
    Frame P; P.lds = (LAS unsigned char*)lds_raw; P.tid = a.wave * 64 + (int)__builtin_amdgcn_mbcnt_hi(~0u, __builtin_amdgcn_mbcnt_lo(~0u, 0u)); asm volatile("" : "+v"(P.tid));     P.lane = P.tid & 63; P.wave = __builtin_amdgcn_readfirstlane(P.tid >> 6); P.c = blockIdx.x; P.G = gridDim.x;
    { typedef __attribute__((address_space(4))) const char* kptr_t; kptr_t kp = (kptr_t)__builtin_amdgcn_kernarg_segment_ptr(); asm volatile("" : "+s"(kp));
      P.ws = *(unsigned char* const __attribute__((address_space(4)))*)(kp + __builtin_offsetof(Args, ws)); (void)a.ws; }
    P.in = a.in; P.out = a.out; return P;
}
#define ST_A (wsp<float>(P, WS_STATS))
#define ST_B (wsp<float>(P, WS_STATS) + (size_t)T * 16)
#define ST_C (wsp<float>(P, WS_STATS) + (size_t)T * 32)
#define H_ (wsp<bf16_t>(P, WS_H))
#define PH_HEAD const Frame P = mkframe(a); const int layer = a.layer, c = P.c, G = P.G, jj = layer >> 1; LAS unsigned char* lds = P.lds; (void)layer; (void)c; (void)G; (void)jj; (void)lds;

__device__ __forceinline__ void ph_prologue(const PA a) { PH_HEAD prologue(P); }
__device__ __forceinline__ void ph_kv(const PA a) { PH_HEAD
    SchedKV S{G, c, (const char*)wsp<bf16_t>(P, WS_MEMN), (const char*)wsp<bf16_t>(P, WS_WKV)};
    EpiPlain E{wsp<bf16_t>(P, WS_KMAT), wsp<bf16_t>(P, WS_VT), D, NMEM, (size_t)NMEM * D, (size_t)D * NMEM};
    pg8::gemm_phase<EpiPlain, SchedKV, false, true>(lds, D, D, D, S, E, (const char*)P.ws, P.tid);
}
__device__ __forceinline__ void ph_inproj(const PA a) { PH_HEAD
    pg8::SchedStd S; S.o.init(T / 256, (F8_GATES ? (F8_IN_S ? 1024 : 1536) : INC) / 256, G, c); S.A = (const char*)H_; S.B = (const char*)(wsp<bf16_t>(P, WS_WIN) + (size_t)layer * INC * D); S.sA = (size_t)256 * D * 2; S.sB = (size_t)256 * D * 2;
    EpiInproj E{ST_A, wsp<bf16_t>(P, WS_UCONV), wsp<bf16_t>(P, WS_XU), wsp<bf16_t>(P, WS_GATES)};
    pg8::gemm_phase<EpiInproj, pg8::SchedStd, true, true>(lds, D, D, D, S, E, (const char*)P.ws, P.tid);
}
__device__ __forceinline__ void ph_inproj_gates(const PA a) { PH_HEAD
    pg8::SchedStd S; S.o.init(T / 256, (F8_IN_S ? 2560 : 2048) / 256, G, c); S.A = (const char*)wsp<unsigned char>(P, WS_H8); S.B = (const char*)(wsp<bf16_t>(P, WS_WIN) + (size_t)layer * INC * D + (size_t)1536 * D); S.sA = (size_t)256 * D; S.sB = (size_t)256 * D;
    EpiGates E{ST_A, wsp<bf16_t>(P, WS_GATES), 1.0f / F8_WGU_SCALE, wsp<bf16_t>(P, WS_XU)};
    pg8::gemm_phase<EpiGates, pg8::SchedStd, true, true, true>(lds, D, D, D, S, E, (const char*)P.ws, P.tid);
}
__device__ __forceinline__ void ph_conv(const PA a) { PH_HEAD conv_phase(P, layer); }
__device__ __forceinline__ void ph_ssm1(const PA a) { PH_HEAD
    if (c < BATCH * NG) {
        const int unit = c, g = (unit & 7) * 4 + ((unit >> 3) & 3), b = unit >> 5, ug = b * NG + g;
        bf16_t* xu = wsp<bf16_t>(P, WS_XU) + (size_t)ug * 256 * 384;
        pg8::SchedOne S; S.u0.pm = 0; S.u0.pn = 0; S.u0.tag = 0; S.u0.A = (const char*)xu; S.u0.B = (const char*)(wsp<bf16_t>(P, WS_WST) + (size_t)(layer * NG + g) * 256 * 256);
        EpiSsm1 E{wsp<float>(P, WS_A16) + (size_t)(layer * NG + g) * 128, xu};
        pg8::gemm_phase<EpiSsm1, pg8::SchedOne, false, true>(lds, 256, 384, 256, S, E, (const char*)P.ws, P.tid);
        VM_WAIT(); __syncthreads(); __builtin_amdgcn_fence(__ATOMIC_ACQUIRE, "agent"); VM_WAIT(); __syncthreads();
    }
}
__device__ __forceinline__ void ph_ssm2(const PA a) { PH_HEAD
    if (c < BATCH * NG) {
        const int unit = c, g = (unit & 7) * 4 + ((unit >> 3) & 3), b = unit >> 5, ug = b * NG + g;
        bf16_t* xu = wsp<bf16_t>(P, WS_XU) + (size_t)ug * 256 * 384;
        pg8::SchedOne S; S.u0.pm = 0; S.u0.pn = 0; S.u0.tag = 0; S.u0.A = (const char*)xu; S.u0.B = (const char*)(wsp<bf16_t>(P, WS_TW) + (size_t)(layer * NG + g) * 256 * 384);
        EpiSsm2 E{wsp<bf16_t>(P, WS_YS), b, g};
        pg8::gemm_phase<EpiSsm2, pg8::SchedOne, false, true>(lds, 384, 384, 384, S, E, (const char*)P.ws, P.tid);
        __syncthreads();
    }
}
__device__ __forceinline__ void ph_z8(const PA a) { PH_HEAD
    SchedZ S; S.o.init(T / 256, D / 256, G, c); S.ys = (const char*)wsp<bf16_t>(P, WS_YS); S.wglu = (const char*)(wsp<bf16_t>(P, WS_WGLU) + (size_t)layer * 2 * D * SW); S.sA = (size_t)256 * SW; S.sB = (size_t)256 * SW;
    EpiZ E{wsp<bf16_t>(P, WS_GATES), wsp<bf16_t>(P, WS_MB), 1.0f / (F8_YS_SCALE * F8_WGLU_SCALE)};
    pg8::gemm_phase<EpiZ, SchedZ, true, true, true>(lds, SW, SW, SW, S, E, (const char*)P.ws, P.tid);
    VM_WAIT(); __syncthreads();
}
__device__ __forceinline__ void ph_pw(const PA a) { PH_HEAD
    pg8::SchedStd S; S.o.init(T / 256, D / 256, G, c); S.A = (const char*)wsp<bf16_t>(P, WS_UC); S.B = (const char*)(wsp<bf16_t>(P, WS_WPW) + (size_t)layer * D * CW); S.sA = (size_t)256 * CW * 2; S.sB = (size_t)256 * CW * 2;
    EpiPw E{wsp<bf16_t>(P, WS_GATES), wsp<bf16_t>(P, WS_MB), wsp<bf16_t>(P, WS_MERGED)};
    pg8::gemm_phase<EpiPw, pg8::SchedStd, true, true>(lds, CW, CW, CW, S, E, (const char*)P.ws, P.tid);
}
__device__ __forceinline__ void ph_zpw(const PA a) { PH_HEAD
    SchedZPW S; S.o.init(T / 256, D / 256, G, c); S.ys = (const char*)wsp<bf16_t>(P, WS_YS); S.uc = (const char*)wsp<bf16_t>(P, WS_UC);
    S.wglu = (const char*)(wsp<bf16_t>(P, WS_WGLU) + (size_t)layer * 2 * D * SW); S.wpw = (const char*)(wsp<bf16_t>(P, WS_WPW) + (size_t)layer * D * CW);
    EpiZPW E{EpiZ{wsp<bf16_t>(P, WS_GATES), wsp<bf16_t>(P, WS_MB)}, EpiPw{wsp<bf16_t>(P, WS_GATES), wsp<bf16_t>(P, WS_MB), wsp<bf16_t>(P, WS_MERGED)}};
    pg8::gemm_phase<EpiZPW, SchedZPW, true, true>(lds, SW, SW, SW, S, E, (const char*)P.ws, P.tid);
}
template <bool H8OUT> __device__ __forceinline__ void ph_res_out(const PA a) { PH_HEAD
    pg8::SchedStd S; S.o.init(T / 256, D / 256, G, c); S.A = (const char*)wsp<bf16_t>(P, WS_MERGED); S.B = (const char*)(wsp<bf16_t>(P, WS_WOUT) + (size_t)layer * D * D); S.sA = (size_t)256 * D * 2; S.sB = (size_t)256 * D * 2;
    EpiRes<H8OUT, false> E{H_, ST_B, H_, wsp<unsigned char>(P, WS_H8), lds};
    pg8::gemm_phase<EpiRes<H8OUT, false>, pg8::SchedStd, true, true>(lds, D, D, D, S, E, (const char*)P.ws, P.tid);
}
template <bool H8OUT> __device__ __forceinline__ void ph_res_o(const PA a) { PH_HEAD
    constexpr bool F8 = F8_QO != 0; constexpr int ES = F8 ? 1 : 2;
    pg8::SchedStd S; S.o.init(T / 256, D / 256, G, c); S.A = (const char*)wsp<bf16_t>(P, WS_AO); S.B = (const char*)(wsp<bf16_t>(P, WS_WO) + (size_t)layer * D * D); S.sA = (size_t)256 * D * ES; S.sB = (size_t)256 * D * ES;
    EpiRes<H8OUT, F8> E{H_, ST_C, H_, wsp<unsigned char>(P, WS_H8), lds};
    pg8::gemm_phase<EpiRes<H8OUT, F8>, pg8::SchedStd, true, true, F8>(lds, D, D, D, S, E, (const char*)P.ws, P.tid);
}
struct SchedQ {
    int G, c; const char* h; const char* wq; int es;
    __device__ __forceinline__ bool next(int i, Unit& u) const { const int L = i * G + c; if (L >= BATCH * HEADS * (SEQ / 256)) return false; const int bh = L & 31, qt = L >> 5, b = bh >> 2, hd = bh & 3;
        u.pm = b * 16 + qt; u.pn = hd; u.tag = 0; u.A = h + (size_t)u.pm * 256 * D * es; u.B = wq + (size_t)hd * 256 * D * es; return true; }
    __device__ __forceinline__ void a_ready(const Unit&) const {}
    __device__ __forceinline__ void done(const Unit&) const {}
};
__device__ __forceinline__ void ph_q(const PA a) { PH_HEAD
    constexpr bool F8 = F8_QO != 0;
    SchedQ S{G, c, F8 ? (const char*)wsp<unsigned char>(P, WS_H8) : (const char*)H_, (const char*)(wsp<bf16_t>(P, WS_WQ) + (size_t)layer * D * D), F8 ? 1 : 2};
    EpiQ E{ST_B, wsp<bf16_t>(P, WS_Q), F8 ? 1.0f / F8_WQ_SCALE : 1.0f};
    pg8::gemm_phase<EpiQ, SchedQ, true, true, F8>(lds, D, D, D, S, E, (const char*)P.ws, P.tid);
    VM_WAIT(); __syncthreads();
}
__device__ __forceinline__ void ph_attn(const PA a) { PH_HEAD attn_phase(P, layer); }
template <bool F8> __device__ __forceinline__ void ph_fgu(const PA a) { PH_HEAD
    constexpr int ES = F8 ? 1 : 2;
    pg8::SchedStd S; S.o.init(T / 256, 2 * DFF / 256, G, c); S.A = F8 ? (const char*)wsp<unsigned char>(P, WS_H8) : (const char*)H_; S.B = (const char*)(wsp<bf16_t>(P, WS_WFGU) + (size_t)jj * 2 * DFF * D); S.sA = (size_t)256 * D * ES; S.sB = (size_t)256 * D * ES;
    EpiGU<false, F8> E{ST_C, nullptr, wsp<bf16_t>(P, WS_ACT), DFF};
    pg8::gemm_phase<EpiGU<false, F8>, pg8::SchedStd, true, true, F8>(lds, D, D, D, S, E, (const char*)P.ws, P.tid);
}
template <bool F8> __device__ __forceinline__ void ph_fdown(const PA a, const bool dry = false) { PH_HEAD
    constexpr int ES = F8 ? 1 : 2;
    pg8::SchedStd S; S.o.init(T / 256, D / 256, G, c); S.A = (const char*)wsp<bf16_t>(P, WS_ACT); S.B = (const char*)(wsp<bf16_t>(P, WS_WFD) + (size_t)jj * D * DFF); S.sA = (size_t)256 * DFF * ES; S.sB = (size_t)256 * DFF * ES;
    EpiRes<(F8_GATES != 0), F8> E{H_, dry ? wsp<float>(P, WS_UCONV) : ST_A, dry ? wsp<bf16_t>(P, WS_Q) : H_, wsp<unsigned char>(P, WS_H8), lds};
    pg8::gemm_phase<EpiRes<(F8_GATES != 0), F8>, pg8::SchedStd, true, true, F8>(lds, DFF, DFF, DFF, S, E, (const char*)P.ws, P.tid);
}
__device__ __forceinline__ void ph_router(const PA a) { PH_HEAD router_phase(P, layer, jj); }
template <bool F8> __device__ __forceinline__ void ph_assign(const PA a) { PH_HEAD assign_phase<F8>(P); }
template <bool F8> __device__ __forceinline__ void ph_mgu(const PA a) { PH_HEAD
    constexpr int ES = F8 ? 1 : 2;
    const int ptot = (int)__hip_atomic_load((unsigned*)(P.ws + WS_CTL) + CW_PTOTAL, __ATOMIC_RELAXED, __HIP_MEMORY_SCOPE_AGENT);
    SchedMoe S; S.o.init(__builtin_amdgcn_readfirstlane(ptot), 2 * DFE / 256, G, c); S.A = (const char*)wsp<bf16_t>(P, WS_HS); S.B = (const char*)(wsp<bf16_t>(P, WS_WMGU) + (size_t)jj * NE * 2 * DFE * D);
    S.sA = (size_t)256 * D * ES; S.sB = (size_t)256 * D * ES; S.sE = (size_t)2 * DFE * D * ES; S.load_bases((const unsigned*)(P.ws + WS_CTL));
    EpiGU<true, F8> E{(const float*)(P.ws + WS_META + MT_RSCALE), (const float*)(P.ws + WS_META + MT_GWT), wsp<bf16_t>(P, WS_ACT), DFE};
    pg8::gemm_phase<EpiGU<true, F8>, SchedMoe, true, true, F8>(lds, D, D, D, S, E, (const char*)P.ws, P.tid);
}
template <bool F8> __device__ __forceinline__ void ph_mdown(const PA a) { PH_HEAD
    constexpr int ES = F8 ? 1 : 2;
    const int ptot = (int)__hip_atomic_load((unsigned*)(P.ws + WS_CTL) + CW_PTOTAL, __ATOMIC_RELAXED, __HIP_MEMORY_SCOPE_AGENT);
    static_assert(!F8 || DFE * ES / 128 == 28, "the K-split of the tail panels is laid out for 28 K-tiles (the bf16 instantiation is never run: F8_MOE_MASK covers both MoE layers)");
    SchedMoeD S; S.o.init(MOE_FULL_PANELS, D / 256, G, c); S.ptot = __builtin_amdgcn_readfirstlane(ptot); S.A = (const char*)wsp<bf16_t>(P, WS_ACT); S.B = (const char*)(wsp<bf16_t>(P, WS_WMD) + (size_t)jj * NE * D * DFE);
    S.sA = (size_t)256 * DFE * ES; S.sB = (size_t)256 * DFE * ES; S.sE = (size_t)D * DFE * ES; S.load_bases((const unsigned*)(P.ws + WS_CTL));
    EpiDown E{wsp<bf16_t>(P, WS_YE), wsp<float>(P, WS_MPART), F8 ? 1.0f / (F8_WD_SCALE * F8_ACT_SCALE) : 1.0f};
    pg8::gemm_phase<EpiDown, SchedMoeD, true, true, F8>(lds, DFE, DFE, DFE, S, E, (const char*)P.ws, P.tid);
}
__device__ __forceinline__ void ph_combine(const PA a) { PH_HEAD combine_phase(P, layer == DEPTH - 1); }

__global__ void __launch_bounds__(512, 2) fwd(Args args) {
    LAS unsigned char* lds = (LAS unsigned char*)lds_raw;
    volatile LAS unsigned* MISC = (volatile LAS unsigned*)(lds + LDS_MISC);
    if (threadIdx.x < 64) MISC[threadIdx.x] = 0u;
    __syncthreads();
    const int lo = args.ph_lo, hi = args.ph_hi;
    unsigned* barw = (unsigned*)(args.ws + WS_CTL) + CW_BAR;
    XcdBarrier bar; bar.bar = barw; bar.x = 0; bar.st = MISC + 8;
    if (hi - lo > 1) bar = xcd_barrier_post(barw, MISC + 8);
#ifndef PROBE_DUP
#define PROBE_DUP 0
#endif
#define DUPB(b) ((PROBE_DUP >> (b)) & 1)
#define IN(k) (lo <= (k) && (k) < hi)
#define SEAM(k) do { if (IN(k) && IN((k) + 1)) { if ((k) < PH_LAYER0 + 3 * NPH_LAYER - 1) { const Frame BF_ = mkframe(a); xcd_barrier_bg(bar, BF_); } else { const Frame BF_ = mkframe(a); xcd_barrier(bar, BF_.tid); } } } while (0)
#define SEAMX(k, kn) do { if (IN(k) && IN(kn)) { if ((k) < PH_LAYER0 + 3 * NPH_LAYER - 1) { const Frame BF_ = mkframe(a); xcd_barrier_bg(bar, BF_); } else { const Frame BF_ = mkframe(a); xcd_barrier(bar, BF_.tid); } } } while (0)
    PA a; a.ws = args.ws; a.in = args.in; a.out = args.out; a.layer = 0; a.wave = __builtin_amdgcn_readfirstlane((int)(threadIdx.x >> 6));
    if (IN(0)) { ph_prologue(a); if (DUPB(0)) ph_prologue(a); } SEAMX(0, 2);
#define LAYER_BODY(LYR) { \
        constexpr int layer = (LYR), pb = PH_LAYER0 + layer * NPH_LAYER; a.layer = layer; \
        if (IN(pb + 0)) { if (layer == 0) ph_kv(a); ph_inproj(a); if (F8_GATES) ph_inproj_gates(a); } SEAM(pb + 0); \
        if (IN(pb + 1)) { ph_conv(a); ph_ssm1(a); ph_ssm2(a); if (DUPB(3)) { ph_conv(a); ph_ssm1(a); ph_ssm2(a); } if (DUPB(11)) ph_conv(a); if (DUPB(12)) { ph_ssm1(a); ph_ssm2(a); } if (DUPB(13)) ph_ssm1(a); } SEAM(pb + 1); \
        if (IN(pb + 2)) { if (F8_Z) { ph_z8(a); ph_pw(a); } else { ph_zpw(a); if (DUPB(4)) ph_zpw(a); } } SEAMX(pb + 2, pb + 4); \
        if (IN(pb + 4)) { ph_res_out<(F8_QO != 0)>(a); } SEAM(pb + 4); \
        if (IN(pb + 5)) { ph_q(a); ph_attn(a); if (DUPB(5)) { ph_q(a); ph_attn(a); } } SEAMX(pb + 5, pb + 7); \
        if (IN(pb + 7)) { ph_res_o<F8_DENSE(layer)>(a); } SEAM(pb + 7); \
        if ((layer & 1) == 0) { \
            if (IN(pb + 8)) { ph_fgu<F8_DENSE(layer)>(a); } SEAM(pb + 8); \
            if (IN(pb + 9)) { ph_fdown<F8_DENSE(layer)>(a); if (layer < DEPTH - 1) { const Frame DF_ = mkframe(a); bg_drain(DF_, layer); } } do { if (IN(pb + 9) && IN(pb + 13)) { if ((pb + 12) < PH_LAYER0 + 3 * NPH_LAYER - 1) { const Frame BF_ = mkframe(a); xcd_barrier_bg(bar, BF_); } else { const Frame BF_ = mkframe(a); xcd_barrier(bar, BF_.tid); } } } while (0); \
        } else { \
            if (IN(pb + 8)) { ph_router(a); if (DUPB(8)) ph_router(a); } SEAM(pb + 8); \
            if (IN(pb + 9)) { ph_assign<F8_MOE(layer)>(a); } SEAM(pb + 9); \
            if (IN(pb + 10)) { ph_mgu<F8_MOE(layer)>(a); } SEAM(pb + 10); \
            if (IN(pb + 11)) { ph_mdown<F8_MOE(layer)>(a); } SEAM(pb + 11); \
            if (IN(pb + 12)) { ph_combine(a); if (layer < DEPTH - 1) { const Frame DF_ = mkframe(a); bg_drain(DF_, layer); } } SEAM(pb + 12); \
        } }
    LAYER_BODY(0) LAYER_BODY(1) LAYER_BODY(2) LAYER_BODY(3)
#undef LAYER_BODY
#undef IN
#undef SEAM
#undef SEAMX
}

extern "C" void kernel_launch(void* const* d_in, const int* in_sizes, int n_in, void* d_out, int out_size, void* d_ws, size_t ws_size, hipStream_t stream) {
    static int grid = 0;
    if (grid == 0) {
        if (n_in != 32 || out_size != T * D || ws_size < WS_END) { fprintf(stderr, "kernel_launch: unexpected problem (n_in %d out %d ws %zu need %zu)\n", n_in, out_size, ws_size, (size_t)WS_END); grid = -1; return; }
        int dev = 0, cus = 0, per_cu = 0;
        if (hipGetDevice(&dev) != hipSuccess || hipDeviceGetAttribute(&cus, hipDeviceAttributeMultiprocessorCount, dev) != hipSuccess) { grid = -1; return; }
        if (hipFuncSetAttribute((const void*)fwd, hipFuncAttributeMaxDynamicSharedMemorySize, LDS_BYTES) != hipSuccess) { fprintf(stderr, "kernel_launch: hipFuncSetAttribute failed\n"); grid = -1; return; }
        if (hipOccupancyMaxActiveBlocksPerMultiprocessor(&per_cu, (const void*)fwd, 512, LDS_BYTES) != hipSuccess || per_cu < 1) { fprintf(stderr, "kernel_launch: occupancy query says %d\n", per_cu); }
        (void)hipGetLastError();
        grid = cus < 256 ? cus : 256;
    }
    if (grid < 0) return;
    if (hipMemsetAsync((char*)d_ws + WS_CTL, 0, CTL_BYTES, stream) != hipSuccess) return;
    Args a{};
    for (int i = 0; i < 32; ++i) a.in[i] = (const float*)d_in[i];
    a.out = (float*)d_out; a.ws = (unsigned char*)d_ws;
#if MK_ONE_LAUNCH
    a.ph_lo = 0; a.ph_hi = NPHASES;
    hipLaunchKernelGGL(fwd, dim3(grid), dim3(512), LDS_BYTES, stream, a);
#else
    for (int p = 0; p < NPHASES; ++p) {
        if (p >= PH_LAYER0) { const int layer = (p - PH_LAYER0) / NPH_LAYER, k = (p - PH_LAYER0) % NPH_LAYER; if ((layer & 1) == 0 && k >= 10) continue; }
        a.ph_lo = p; a.ph_hi = p + 1;
        hipLaunchKernelGGL(fwd, dim3(grid), dim3(512), LDS_BYTES, stream, a);
    }
#endif
}
```
